# Optimizing an MI355X kernel written in HIP

```python
import jax, jax.numpy as jnp
from jax import lax
import numpy as np

D_MODEL = 1024
BATCH = 32
SEQ = 256
DEPTH = 2
DEC_BATCH = 8
DEC_SEQ = 4096
PAST_LEN = 512

GRID_W = 64
D_A = 512
CONV_A = 31
D_B = 512
CONV_B = 3
N_HEADS = 8
HEAD_DIM = 64
D_C = N_HEADS * HEAD_DIM
WIN_ROWS = 8
WIN_COLS = 16
Q_BLOCK_COLS = 16
K_BLOCK_COLS = 32
N_COL_BLOCKS = GRID_W // Q_BLOCK_COLS
D_FF = 2816
N_MOD = 9
N_IN = 2 * D_A + 3 * D_B + 3 * D_C + 3 * D_MODEL
CTX_Q_BLOCK = 128
EPS = 1e-6
NEG_INF = -1e30

kernel_name = "hybrid_conv_natten_prefix_dit_step"


def _rms(x, g):
    xf = x.astype(jnp.float32)
    y = xf * lax.rsqrt(jnp.mean(jnp.square(xf), axis=-1, keepdims=True) + EPS)
    return (y * g.astype(jnp.float32)).astype(x.dtype)


def _layer_norm(x, g, b):
    xf = x.astype(jnp.float32)
    mu = jnp.mean(xf, axis=-1, keepdims=True)
    xc = xf - mu
    y = xc * lax.rsqrt(jnp.mean(jnp.square(xc), axis=-1, keepdims=True) + EPS)
    return (y * g.astype(jnp.float32) + b.astype(jnp.float32)).astype(x.dtype)


def _swiglu(u, w_gate, w_up, w_down):
    return (jax.nn.silu(u @ w_gate) * (u @ w_up)) @ w_down


def _modulation(cvec, w_ada, b_ada):
    m = (jax.nn.silu(cvec) @ w_ada + b_ada).reshape(cvec.shape[0], N_MOD, D_MODEL)
    return [m[:, i][:, None, :] for i in range(N_MOD)]


def _dwconv(x, w, b=None):
    k = w.shape[0]
    y = lax.conv_general_dilated(
        x, w[:, None, :].astype(x.dtype), window_strides=(1,),
        padding=[(k // 2, k // 2)], dimension_numbers=('NWC', 'WIO', 'NWC'),
        feature_group_count=x.shape[-1])
    return y if b is None else y + b


def _project(u, w_in):
    sizes = [D_A, D_A, D_B, D_B, D_B, D_C, D_C, D_C, D_MODEL, D_MODEL]
    idx = [int(i) for i in np.cumsum(sizes)]
    return jnp.split(u @ w_in, idx, axis=-1)


def _heads(t):
    return t.reshape(*t.shape[:-1], N_HEADS, HEAD_DIM)


def _context_attention(q, k, v):
    b, t = q.shape[:2]
    scale = HEAD_DIM ** -0.5
    qb = q.reshape(b, t // CTX_Q_BLOCK, CTX_Q_BLOCK, N_HEADS, HEAD_DIM).transpose(1, 0, 2, 3, 4)

    def block(qi):
        s = jnp.einsum('bqhd,bkhd->bhqk', qi, k).astype(jnp.float32) * scale
        p = jax.nn.softmax(s, axis=-1).astype(v.dtype)
        return jnp.einsum('bhqk,bkhd->bqhd', p, v)

    o = lax.map(block, qb)
    return o.transpose(1, 0, 2, 3, 4).reshape(b, t, D_C)


def _neighbourhood_attention(q, k, v, k_ctx, v_ctx, rpb):
    b, t = q.shape[:2]
    rows = t // GRID_W
    kr = min(WIN_ROWS, rows)
    n_loc = kr * K_BLOCK_COLS
    scale = HEAD_DIM ** -0.5
    qg = q.reshape(b, rows, N_COL_BLOCKS, Q_BLOCK_COLS, N_HEADS, HEAD_DIM)
    kg = k.reshape(b, rows, GRID_W, N_HEADS, HEAD_DIM)
    vg = v.reshape(b, rows, GRID_W, N_HEADS, HEAD_DIM)
    q_cols = np.arange(GRID_W).reshape(N_COL_BLOCKS, Q_BLOCK_COLS)
    win_start = np.clip(q_cols - WIN_COLS // 2, 0, GRID_W - WIN_COLS)
    blk_start = np.clip(np.arange(N_COL_BLOCKS) * Q_BLOCK_COLS - WIN_COLS // 2, 0, GRID_W - K_BLOCK_COLS)
    k_cols = blk_start[:, None] + np.arange(K_BLOCK_COLS)
    kc = k_cols[:, None, :]
    col_valid = (kc >= win_start[..., None]) & (kc < win_start[..., None] + WIN_COLS)
    mask = jnp.asarray(np.broadcast_to(col_valid[:, :, None, :],
                                       (N_COL_BLOCKS, Q_BLOCK_COLS, kr, K_BLOCK_COLS))
                       .reshape(N_COL_BLOCKS, Q_BLOCK_COLS, n_loc))
    dc = np.clip(kc - q_cols[..., None], -(WIN_COLS - 1), WIN_COLS - 1) + WIN_COLS - 1
    col_bias = rpb[:, :, dc]

    def row(r):
        rs = jnp.clip(r - kr // 2, 0, rows - kr)
        k_rows = lax.dynamic_slice_in_dim(kg, rs, kr, axis=1)
        v_rows = lax.dynamic_slice_in_dim(vg, rs, kr, axis=1)
        k_loc = jnp.take(k_rows, k_cols, axis=2).transpose(0, 2, 1, 3, 4, 5).reshape(
            b, N_COL_BLOCKS, n_loc, N_HEADS, HEAD_DIM)
        v_loc = jnp.take(v_rows, k_cols, axis=2).transpose(0, 2, 1, 3, 4, 5).reshape(
            b, N_COL_BLOCKS, n_loc, N_HEADS, HEAD_DIM)
        dr = rs + jnp.arange(kr) - r + WIN_ROWS - 1
        bias = jnp.take(col_bias, dr, axis=1).transpose(0, 2, 3, 1, 4).reshape(
            N_HEADS, N_COL_BLOCKS, Q_BLOCK_COLS, n_loc)
        qr = lax.dynamic_index_in_dim(qg, r, axis=1, keepdims=False)
        s_loc = jnp.einsum('bjqhd,bjkhd->bhjqk', qr, k_loc).astype(jnp.float32) * scale \
            + bias.astype(jnp.float32)
        s_loc = jnp.where(mask, s_loc, NEG_INF)
        s_ctx = jnp.einsum('bjqhd,bphd->bhjqp', qr, k_ctx).astype(jnp.float32) * scale
        p = jax.nn.softmax(jnp.concatenate([s_loc, s_ctx], axis=-1), axis=-1).astype(v.dtype)
        o = jnp.einsum('bhjqk,bjkhd->bjqhd', p[..., :n_loc], v_loc) \
            + jnp.einsum('bhjqp,bphd->bjqhd', p[..., n_loc:], v_ctx)
        return o.reshape(b, GRID_W, N_HEADS, HEAD_DIM)

    o = lax.map(row, jnp.arange(rows))
    return o.transpose(1, 0, 2, 3, 4).reshape(b, t, D_C)


def _layer(x, mods, p, ctx_kv):
    sh1, sc1, g1, sh2, sc2, g2, sh3, sc3, g3 = mods
    u = _rms(x, p['g_ff1']) * (1 + sc1) + sh1
    x = x + 0.5 * g1 * _swiglu(u, p['w_ff1_gate'], p['w_ff1_up'], p['w_ff1_down'])

    u = _rms(x, p['g_mix']) * (1 + sc2) + sh2
    a_val, a_gate, b_g, c_g, h_b, q, k, v, ga, gb, gc = _project(u, p['w_in'])
    ha = _dwconv(a_val * jax.nn.sigmoid(a_gate), p['conv_a_w'], p['conv_a_b'])
    ya = jax.nn.silu(_layer_norm(ha, p['ln_a_g'], p['ln_a_b'])) @ p['w_a_out']
    yb = (b_g * _dwconv(c_g * h_b, p['conv_b_w'])) @ p['w_b_out']
    q = _rms(_heads(q), p['q_norm_g'])
    k = _rms(_heads(k), p['k_norm_g'])
    v = _heads(v)
    if ctx_kv is None:
        o = _context_attention(q, k, v)
        new_kv = (k, v)
    else:
        o = _neighbourhood_attention(q, k, v, ctx_kv[0], ctx_kv[1], p['rpb'])
        new_kv = None
    yc = o @ p['w_c_out']
    m = jax.nn.sigmoid(ga) * ya + jax.nn.sigmoid(gb) * yb + jax.nn.sigmoid(gc) * yc
    x = x + g2 * (m @ p['w_merge'])

    u = _rms(x, p['g_ff2']) * (1 + sc3) + sh3
    x = x + 0.5 * g3 * _swiglu(u, p['w_ff2_gate'], p['w_ff2_up'], p['w_ff2_down'])
    return x, new_kv


def setup_inputs(seed: int = 0) -> dict:
    key = jax.random.key(seed)
    ks = jax.random.split(key, 32)
    f32 = jnp.float32

    def nrm(k, shape, scale):
        return jax.random.normal(k, shape, f32) * scale

    L, D = DEPTH, D_MODEL
    return {
        "x_prompt": nrm(ks[0], (BATCH, SEQ, D), 1.0),
        "x_sample": nrm(ks[1], (DEC_BATCH, DEC_SEQ, D), 1.0),
        "cache_k": nrm(ks[2], (DEC_BATCH, DEPTH, PAST_LEN, N_HEADS, HEAD_DIM), 1.0),
        "cache_v": nrm(ks[3], (DEC_BATCH, DEPTH, PAST_LEN, N_HEADS, HEAD_DIM), 1.0),
        "c": nrm(ks[4], (DEC_BATCH, D), 1.0),
        "c_ctx": nrm(ks[5], (D,), 1.0),
        "w_ada": nrm(ks[6], (L, D, N_MOD * D), 0.5 * D ** -0.5),
        "b_ada": nrm(ks[7], (L, N_MOD * D), 0.02),
        "g_ff1": 1.0 + nrm(ks[8], (L, D), 0.02),
        "w_ff1_gate": nrm(ks[9], (L, D, D_FF), D ** -0.5),
        "w_ff1_up": nrm(ks[10], (L, D, D_FF), D ** -0.5),
        "w_ff1_down": nrm(ks[11], (L, D_FF, D), D_FF ** -0.5),
        "g_mix": 1.0 + nrm(ks[12], (L, D), 0.02),
        "w_in": nrm(ks[13], (L, D, N_IN), D ** -0.5),
        "conv_a_w": nrm(ks[14], (L, CONV_A, D_A), CONV_A ** -0.5),
        "conv_a_b": nrm(ks[15], (L, D_A), 0.02),
        "ln_a_g": 1.0 + nrm(ks[16], (L, D_A), 0.02),
        "ln_a_b": nrm(ks[17], (L, D_A), 0.02),
        "w_a_out": nrm(ks[18], (L, D_A, D), D_A ** -0.5),
        "conv_b_w": nrm(ks[19], (L, CONV_B, D_B), CONV_B ** -0.5),
        "w_b_out": nrm(ks[20], (L, D_B, D), D_B ** -0.5),
        "q_norm_g": 1.0 + nrm(ks[21], (L, HEAD_DIM), 0.02),
        "k_norm_g": 1.0 + nrm(ks[22], (L, HEAD_DIM), 0.02),
        "rpb": nrm(ks[23], (L, N_HEADS, 2 * WIN_ROWS - 1, 2 * WIN_COLS - 1), 0.1),
        "w_c_out": nrm(ks[24], (L, D_C, D), D_C ** -0.5),
        "w_merge": nrm(ks[25], (L, D, D), D ** -0.5),
        "g_ff2": 1.0 + nrm(ks[26], (L, D), 0.02),
        "w_ff2_gate": nrm(ks[27], (L, D, D_FF), D ** -0.5),
        "w_ff2_up": nrm(ks[28], (L, D, D_FF), D ** -0.5),
        "w_ff2_down": nrm(ks[29], (L, D_FF, D), D_FF ** -0.5),
    }


def reference(x_prompt, x_sample, cache_k, cache_v, c, c_ctx, w_ada, b_ada,
              g_ff1, w_ff1_gate, w_ff1_up, w_ff1_down, g_mix, w_in,
              conv_a_w, conv_a_b, ln_a_g, ln_a_b, w_a_out, conv_b_w, w_b_out,
              q_norm_g, k_norm_g, rpb, w_c_out, w_merge,
              g_ff2, w_ff2_gate, w_ff2_up, w_ff2_down):
    h_ctx = x_prompt
    h_lat = x_sample
    new_ks = []
    new_vs = []
    for l in range(DEPTH):
        p = {
            'g_ff1': g_ff1[l], 'w_ff1_gate': w_ff1_gate[l], 'w_ff1_up': w_ff1_up[l],
            'w_ff1_down': w_ff1_down[l], 'g_mix': g_mix[l], 'w_in': w_in[l],
            'conv_a_w': conv_a_w[l], 'conv_a_b': conv_a_b[l], 'ln_a_g': ln_a_g[l],
            'ln_a_b': ln_a_b[l], 'w_a_out': w_a_out[l], 'conv_b_w': conv_b_w[l],
            'w_b_out': w_b_out[l], 'q_norm_g': q_norm_g[l], 'k_norm_g': k_norm_g[l],
            'rpb': rpb[l], 'w_c_out': w_c_out[l], 'w_merge': w_merge[l],
            'g_ff2': g_ff2[l], 'w_ff2_gate': w_ff2_gate[l], 'w_ff2_up': w_ff2_up[l],
            'w_ff2_down': w_ff2_down[l],
        }
        mods_ctx = _modulation(c_ctx[None, :], w_ada[l], b_ada[l])
        mods_lat = _modulation(c, w_ada[l], b_ada[l])
        h_ctx, kv = _layer(h_ctx, mods_ctx, p, None)
        new_ks.append(kv[0])
        new_vs.append(kv[1])
        h_lat, _ = _layer(h_lat, mods_lat, p, (cache_k[:, l], cache_v[:, l]))
    new_k = jnp.stack(new_ks, axis=1)
    new_v = jnp.stack(new_vs, axis=1)
    return (h_ctx, h_lat, new_k, new_v)
```

```cpp
#include <hip/hip_runtime.h>
#include <hip/hip_cooperative_groups.h>
#include <cstdio>
#include <cstdint>
namespace cg = cooperative_groups;

#define LAS __attribute__((address_space(3)))
typedef unsigned short bf16_t;
typedef short bf16x8 __attribute__((ext_vector_type(8)));
typedef short s16x4 __attribute__((ext_vector_type(4)));
typedef float f32x4 __attribute__((ext_vector_type(4)));
typedef unsigned u32x4 __attribute__((ext_vector_type(4)));
typedef unsigned u32x2 __attribute__((ext_vector_type(2)));

constexpr int DM = 1024, NCTX = 8192, NLAT = 32768, MTOK = NCTX + NLAT;
constexpr int DFF = 2816, NIN = 7168, NMODV = 9, MODW = 9 * 1024;
constexpr int NWAVES = 8, NTHR = 512;
constexpr float EPS = 1e-6f;

constexpr size_t MiB = 1u << 20;
constexpr size_t WS_MODS = 1 * MiB;
constexpr size_t WS_W = 2 * MiB;
constexpr size_t W_GU1 = WS_W, W_D1 = W_GU1 + 11 * MiB, W_IN = W_D1 + 11 * MiB / 2, W_B = W_IN + 14 * MiB, W_C = W_B + MiB, W_A = W_C + MiB,
                 W_M = W_A + MiB, W_GU2 = W_M + 2 * MiB, W_D2 = W_GU2 + 11 * MiB;
constexpr size_t WS_U = 54 * MiB, WS_H = 134 * MiB;
constexpr size_t WS_BG = 134 * MiB, WS_Q = 174 * MiB, WS_AOUT = 214 * MiB, WS_GLU = 254 * MiB, WS_CH = 294 * MiB, WS_K = 334 * MiB, WS_V = 374 * MiB;
constexpr size_t WS_GS = 254 * MiB;
constexpr size_t GS_STRIDE = 80 * MiB / 2, BR_STRIDE = 40 * MiB / 2, WO_STRIDE = MiB / 2;
constexpr size_t WS_CK = 494 * MiB, WS_CV = 502 * MiB, WS_END = 510 * MiB;
static_assert(W_D2 + 11 * MiB / 2 <= WS_U, "weights fit");
constexpr int LDS_BYTES = 147456;
constexpr int FOLD_ROW0 = 128 * 256;
constexpr size_t WS_PART = 414 * MiB;

__device__ __forceinline__ unsigned f2bf(float f) { unsigned u = __builtin_bit_cast(unsigned, f); return (u + 0x7fffu + ((u >> 16) & 1u)) >> 16; }
__device__ __forceinline__ unsigned pk2(float lo, float hi) { return f2bf(lo) | (f2bf(hi) << 16); }
typedef float f32x2_t __attribute__((ext_vector_type(2))); typedef __bf16 bf16x2_t __attribute__((ext_vector_type(2)));
__device__ __forceinline__ unsigned cvt_pk_bf16(float lo, float hi) { f32x2_t v = {lo, hi}; bf16x2_t b = __builtin_convertvector(v, bf16x2_t); return __builtin_bit_cast(unsigned, b); }
__device__ __forceinline__ float bflo(unsigned w) { return __uint_as_float(w << 16); }
__device__ __forceinline__ float bfhi(unsigned w) { return __uint_as_float(w & 0xffff0000u); }
__device__ __forceinline__ float sigmoidf_(float x) { return __builtin_amdgcn_rcpf(1.f + __expf(-x)); }
__device__ __forceinline__ float siluf_(float x) { return x * sigmoidf_(x); }
__device__ __forceinline__ float wave_sum(float v) {
#pragma unroll
    for (int o = 1; o < 64; o <<= 1) v += __shfl_xor(v, o);
    return v;
}
__device__ __forceinline__ int opaque_zero() { int z; asm volatile("s_mov_b32 %0, 0" : "=s"(z)); return z; }
__device__ __forceinline__ int opaque_vzero() { int z; asm volatile("v_mov_b32 %0, 0" : "=v"(z)); return z; }
template <class T> __device__ __forceinline__ T* launder_ptr(T* p) { T* r; asm volatile("s_mov_b64 %0, %1" : "=s"(r) : "s"(p)); return r; }
#define LDS_WAIT() asm volatile("s_waitcnt lgkmcnt(0)" ::: "memory")

namespace pg8 {
#define PG8_LAS __attribute__((address_space(3)))
constexpr int BM = 256, BK = 64, HALF = 128, HTB = HALF * BK * 2, STAGE_BYTES = 8 * HTB, NXCD = 8, WGM = 8;
__device__ __forceinline__ int lds_byte(int r, int c) { const int st = (r >> 4) * 2 + (c >> 5), rr = r & 15, cc = c & 31, ob = rr * 64 + cc * 2; return st * 1024 + (ob ^ (((ob >> 9) & 1) << 5)); }
__device__ __forceinline__ void stage_rc(int b, int& R, int& C) { const int st = b / 1024, sb = b % 1024, swz = sb ^ (((sb >> 9) & 1) << 5); R = (st >> 1) * 16 + swz / 64; C = (st & 1) * 32 + (swz % 64) / 2; }
__device__ __forceinline__ int perm32(int rho) { const int n = rho >> 4, i = rho & 15; return 8 * (i >> 2) + 4 * n + (i & 3); }

struct Unit { int pm, pn, seg, kb, nkt, part, slot; };
struct Gemm { const bf16_t* A; const bf16_t* Bt; size_t segA, segB; int M, N, K; };

struct Order {
    int nM, nN, nwg, G, c, nseg, nt, split, nMf;
    __device__ void init(int M, int N, int K, int G_, int c_, int nseg_, int split_) { nM = M / BM; nN = N / BM; nwg = nM * nN; G = G_; c = c_; nseg = nseg_; nt = K / BK;
        split = (split_ && nseg_ == 1 && (nwg % G_) * 2 == G_ && (nt % 4) == 0 && G_ % 16 == 0 && ((G_ / 2) % nN) == 0) ? 1 : 0; nMf = split ? nM - (G_ / 2) / nN : nM; }
    __device__ bool next(int i, Unit& u) const {
        const int tile = i / nseg, seg = i - tile * nseg;
        u.seg = seg; u.kb = 0; u.nkt = nt; u.part = 0; u.slot = 0;
        const int nwf = nMf * nN;
        if (split && tile == nwf / G) { const int pair = (c >> 4) * 8 + (c & 7), half = (c >> 3) & 1;
            u.pm = nMf + pair / nN; u.pn = pair % nN; u.kb = half * (nt >> 1); u.nkt = nt >> 1; u.part = 1 + half; u.slot = pair; return true; }
        const long L = (long)tile * G + c; if (L >= nwf) return false;
        int wgid = (int)L; { const int q = nwf / NXCD, r = nwf % NXCD, xcd = wgid % NXCD, off = wgid / NXCD; wgid = (xcd < r ? xcd * (q + 1) : r * (q + 1) + (xcd - r) * q) + off; }
        const int nig = WGM * nN, gid = wgid / nig, fm = gid * WGM, gsz = (nMf - fm) < WGM ? (nMf - fm) : WGM;
        u.pm = fm + ((wgid % nig) % gsz); u.pn = (wgid % nig) / gsz; return true;
    }
};

template <class Epi, bool ALIGN_EPI, bool SP2>
__device__ __forceinline__ void gemm_phase(PG8_LAS unsigned char* lds, const Gemm g, const Order& S, const Epi& E) {
    const int tid = threadIdx.x + opaque_vzero(), wid = __builtin_amdgcn_readfirstlane(tid >> 6), lane = tid & 63, wr = wid >> 2, wc = wid & 3, fr = lane & 15, fq = lane >> 4;
    const int K = g.K;
    unsigned voffA[2], voffB[2];
#pragma unroll
    for (int i = 0; i < 2; ++i) { int R, C; stage_rc(tid * 16 + i * 8192, R, C); const int Rb = Epi::PERM ? ((R & ~31) + perm32(R & 31)) : R;
        voffA[i] = (unsigned)(R * K + C) * 2u; voffB[i] = (unsigned)(Rb * K + C) * 2u; }
    const size_t kstep = (size_t)(BK * 2);
    const size_t hstep = (size_t)HALF * K * 2;
    const size_t tstep = 2 * hstep;
    const unsigned ldsw = (unsigned)wid * 1024u;
    const int aoff = lds_byte(wr * 64 + fr, fq * 8), boff = lds_byte(wc * 32 + fr, fq * 8);
#define PG8_SA(b, h) (((b) * 2 + (h)) * HTB)
#define PG8_SB(b, h) ((4 + (b) * 2 + (h)) * HTB)
#define PG8_STAGE(bufoff, gbase, voff) do { _Pragma("unroll") for (int _i = 0; _i < 2; ++_i) \
        __builtin_amdgcn_global_load_lds((const unsigned*)((const char*)(gbase) + (voff)[_i]), (PG8_LAS unsigned*)(lds + (bufoff) + ldsw + _i * 8192), 16, 0, 0); } while (0)
#define PG8_LDA(dst, b, h) do { _Pragma("unroll") for (int m = 0; m < 4; ++m) _Pragma("unroll") for (int k = 0; k < 2; ++k) dst[m][k] = *(const PG8_LAS bf16x8*)(lds + PG8_SA(b, h) + aoff + m * 2048 + k * 1024); } while (0)
#define PG8_LDB(dst, b, h) do { _Pragma("unroll") for (int n = 0; n < 2; ++n) _Pragma("unroll") for (int k = 0; k < 2; ++k) dst[n][k] = *(const PG8_LAS bf16x8*)(lds + PG8_SB(b, h) + boff + n * 2048 + k * 1024); } while (0)
#define PG8_MMA(ai, bj, At, Bt) do { __builtin_amdgcn_s_setprio(1); _Pragma("unroll") for (int m = 0; m < 4; ++m) _Pragma("unroll") for (int n = 0; n < 2; ++n) _Pragma("unroll") for (int k = 0; k < 2; ++k) \
        acc[ai][bj][m][n] = __builtin_amdgcn_mfma_f32_16x16x32_bf16(Bt[n][k], At[m][k], acc[ai][bj][m][n], 0, 0, 0); __builtin_amdgcn_s_setprio(0); } while (0)
#define PG8_WAIT_V(n) asm volatile("s_waitcnt vmcnt(" #n ")" ::: "memory")
#define PG8_WAIT_L(n) asm volatile("s_waitcnt lgkmcnt(" #n ")" ::: "memory")
#define PG8_BAR __builtin_amdgcn_s_barrier()
#define PG8_SCHED __builtin_amdgcn_sched_barrier(0)
    Unit cur, nxt; int ui = 0;
    if (!S.next(0, cur)) return;
    f32x4 acc[2][2][4][2];
#pragma unroll
    for (int a = 0; a < 2; ++a)
#pragma unroll
        for (int b = 0; b < 2; ++b)
#pragma unroll
            for (int m = 0; m < 4; ++m)
#pragma unroll
                for (int n = 0; n < 2; ++n) acc[a][b][m][n] = (f32x4){0.f, 0.f, 0.f, 0.f};
    bf16x8 At[4][2], B0[2][2], B1[2][2];
    const char* cA = (const char*)(g.A + cur.seg * g.segA) + (size_t)cur.pm * tstep + (size_t)cur.kb * kstep; const char* cB = (const char*)(g.Bt + cur.seg * g.segB) + (size_t)cur.pn * tstep + (size_t)cur.kb * kstep;
    if constexpr (SP2) {
        PG8_STAGE(PG8_SB(0, 0), cB, voffB); PG8_STAGE(PG8_SB(0, 1), cB + hstep, voffB); PG8_STAGE(PG8_SA(0, 0), cA, voffA); PG8_STAGE(PG8_SA(0, 1), cA + hstep, voffA);
        if (wr == 1) PG8_BAR;
        PG8_WAIT_V(2); PG8_BAR;
        PG8_STAGE(PG8_SB(1, 0), cB + kstep, voffB); PG8_STAGE(PG8_SA(1, 0), cA + kstep, voffA); PG8_STAGE(PG8_SB(1, 1), cB + hstep + kstep, voffB);
        PG8_WAIT_V(6); PG8_BAR;
    } else {
        PG8_STAGE(PG8_SB(0, 0), cB, voffB); PG8_STAGE(PG8_SA(0, 0), cA, voffA); PG8_STAGE(PG8_SB(0, 1), cB + hstep, voffB); PG8_STAGE(PG8_SA(0, 1), cA + hstep, voffA);
        if (wr == 1) PG8_BAR;
        PG8_WAIT_V(4); PG8_BAR;
        PG8_STAGE(PG8_SB(1, 0), cB + kstep, voffB); PG8_STAGE(PG8_SA(1, 0), cA + kstep, voffA); PG8_STAGE(PG8_SB(1, 1), cB + hstep + kstep, voffB);
        PG8_WAIT_V(6); PG8_BAR;
    }
    for (;;) {
        const bool has_next = S.next(ui + 1, nxt);
        const char* nA = has_next ? (const char*)(g.A + nxt.seg * g.segA) + (size_t)nxt.pm * tstep + (size_t)nxt.kb * kstep : cA; const char* nB = has_next ? (const char*)(g.Bt + nxt.seg * g.segB) + (size_t)nxt.pn * tstep + (size_t)nxt.kb * kstep : cB;
        const int nt = cur.nkt;
        for (int t = 0; t < nt; t += 2) {
            const bool last = (t == nt - 2);
            const char* a1 = cA + (size_t)(t + 1) * kstep;
            const char* a2 = last ? nA : cA + (size_t)(t + 2) * kstep; const char* b2 = last ? nB : cB + (size_t)(t + 2) * kstep;
            const char* a3 = a2 + kstep; const char* b3 = b2 + kstep;
            if constexpr (SP2) {
            PG8_LDB(B0, 0, 0); PG8_LDB(B1, 0, 1); PG8_SCHED; PG8_LDA(At, 0, 0); PG8_STAGE(PG8_SA(1, 1), a1 + hstep, voffA);
            PG8_WAIT_V(8); PG8_WAIT_L(0); PG8_BAR; PG8_MMA(0, 0, At, B0); PG8_MMA(0, 1, At, B1); PG8_BAR; PG8_SCHED;
            PG8_LDA(At, 0, 1); PG8_STAGE(PG8_SB(0, 0), b2, voffB); PG8_STAGE(PG8_SB(0, 1), b2 + hstep, voffB); PG8_STAGE(PG8_SA(0, 0), a2, voffA);
            PG8_WAIT_V(8); PG8_WAIT_L(0); PG8_BAR; PG8_MMA(1, 0, At, B0); PG8_MMA(1, 1, At, B1); PG8_BAR; PG8_SCHED;
            PG8_LDB(B0, 1, 0); PG8_LDB(B1, 1, 1); PG8_SCHED; PG8_LDA(At, 1, 0); PG8_STAGE(PG8_SA(0, 1), a2 + hstep, voffA);
            PG8_WAIT_V(8); PG8_WAIT_L(0); PG8_BAR; PG8_MMA(0, 0, At, B0); PG8_MMA(0, 1, At, B1); PG8_BAR; PG8_SCHED;
            PG8_LDA(At, 1, 1); PG8_STAGE(PG8_SB(1, 0), b3, voffB); PG8_STAGE(PG8_SB(1, 1), b3 + hstep, voffB); PG8_STAGE(PG8_SA(1, 0), a3, voffA);
            PG8_WAIT_V(8); PG8_WAIT_L(0); PG8_BAR; PG8_MMA(1, 0, At, B0); PG8_MMA(1, 1, At, B1); PG8_BAR; PG8_SCHED;
            } else {
            PG8_LDB(B0, 0, 0); PG8_SCHED; PG8_LDA(At, 0, 0); PG8_STAGE(PG8_SA(1, 1), a1 + hstep, voffA);
            PG8_WAIT_L(8); PG8_BAR; PG8_WAIT_L(0); PG8_MMA(0, 0, At, B0); PG8_BAR; PG8_SCHED;
            PG8_LDB(B1, 0, 1); PG8_STAGE(PG8_SB(0, 0), b2, voffB);
            PG8_BAR; PG8_WAIT_L(0); PG8_MMA(0, 1, At, B1); PG8_BAR;
            PG8_LDA(At, 0, 1); PG8_STAGE(PG8_SA(0, 0), a2, voffA);
            PG8_BAR; PG8_WAIT_L(0); PG8_MMA(1, 0, At, B0); PG8_BAR; PG8_SCHED;
            PG8_STAGE(PG8_SB(0, 1), b2 + hstep, voffB);
            PG8_WAIT_V(6); PG8_BAR; PG8_MMA(1, 1, At, B1); PG8_BAR;
            PG8_LDB(B0, 1, 0); PG8_SCHED; PG8_LDA(At, 1, 0); PG8_STAGE(PG8_SA(0, 1), a2 + hstep, voffA);
            PG8_WAIT_L(8); PG8_BAR; PG8_WAIT_L(0); PG8_MMA(0, 0, At, B0); PG8_BAR; PG8_SCHED;
            PG8_LDB(B1, 1, 1); PG8_STAGE(PG8_SB(1, 0), b3, voffB);
            PG8_BAR; PG8_WAIT_L(0); PG8_MMA(0, 1, At, B1); PG8_BAR;
            PG8_LDA(At, 1, 1); PG8_STAGE(PG8_SA(1, 0), a3, voffA);
            PG8_BAR; PG8_WAIT_L(0); PG8_MMA(1, 0, At, B0); PG8_BAR; PG8_SCHED;
            PG8_STAGE(PG8_SB(1, 1), b3 + hstep, voffB);
            PG8_WAIT_V(6); PG8_BAR; PG8_MMA(1, 1, At, B1); PG8_BAR;
            }
        }
        if constexpr (ALIGN_EPI) { if (wr == 0) PG8_BAR; }
        E(acc, cur, wr, wc, fr, fq);
        if (!has_next) break;
#pragma unroll
        for (int a = 0; a < 2; ++a)
#pragma unroll
            for (int b = 0; b < 2; ++b)
#pragma unroll
                for (int m = 0; m < 4; ++m)
#pragma unroll
                    for (int n = 0; n < 2; ++n) acc[a][b][m][n] = (f32x4){0.f, 0.f, 0.f, 0.f};
        cur = nxt; cA = nA; cB = nB; ++ui;
        if constexpr (ALIGN_EPI) { if (wr == 1) PG8_BAR; }
    }
    PG8_WAIT_V(0);
    if constexpr (!ALIGN_EPI) { if (wr == 0) PG8_BAR; }
    PG8_BAR;
#undef PG8_SA
#undef PG8_SB
#undef PG8_STAGE
#undef PG8_LDA
#undef PG8_LDB
#undef PG8_MMA
#undef PG8_WAIT_V
#undef PG8_WAIT_L
#undef PG8_BAR
#undef PG8_SCHED
}

typedef f32x4 Acc[2][2][4][2];

__device__ __forceinline__ u32x4 pack8(const f32x4 a, const f32x4 b) {
    u32x4 w; w.x = cvt_pk_bf16(a[0], a[1]); w.y = cvt_pk_bf16(a[2], a[3]); w.z = cvt_pk_bf16(b[0], b[1]); w.w = cvt_pk_bf16(b[2], b[3]); return w;
}

struct EpiSwiGLU {
    static constexpr bool PERM = true;
    bf16_t* H;
    __device__ __forceinline__ void operator()(const Acc& acc, const Unit& u, int wr, int wc, int fr, int fq) const {
        const int row0 = u.pm * BM + wr * 64 + fr, col0 = u.pn * HALF + wc * 32 + 8 * fq;
#pragma unroll
        for (int ai = 0; ai < 2; ++ai)
#pragma unroll
            for (int m = 0; m < 4; ++m) {
                bf16_t* rowp = H + (size_t)(row0 + ai * HALF + m * 16) * DFF + col0;
                f32x4 h0, h1;
#pragma unroll
                for (int j = 0; j < 4; ++j) { h0[j] = siluf_(acc[ai][0][m][0][j]) * acc[ai][1][m][0][j]; h1[j] = siluf_(acc[ai][0][m][1][j]) * acc[ai][1][m][1][j]; }
                *(u32x4*)rowp = pack8(h0, h1);
                __builtin_amdgcn_sched_barrier(0);
            }
    }
};

struct EpiResid {
    static constexpr bool PERM = false;
    float* out; const float* gate; long long pdelta; int half;
    __device__ __forceinline__ void operator()(const Acc& acc, const Unit& u, int wr, int wc, int fr, int fq) const {
        const int v = u.pm < 32 ? 0 : 1 + ((u.pm - 32) >> 4);
        const float* gv = gate + (size_t)v * MODW;
        const int col0 = u.pn * BM + wc * 32 + 4 * fq;
        f32x4 g[2][2];
#pragma unroll
        for (int bj = 0; bj < 2; ++bj)
#pragma unroll
            for (int n = 0; n < 2; ++n) g[bj][n] = *(const f32x4*)(gv + col0 + bj * HALF + n * 16) * (half ? 0.5f : 1.0f);
        const bool p2 = u.part == 2;
        const long long boff = p2 ? pdelta + 4ll * ((long long)u.slot * (BM * BM) + wc * 32 + 4 * fq)
                                  : 4ll * ((long long)u.pm * BM * DM + col0);
        const int pitch = p2 ? BM : DM;
        float* base = (float*)((char*)out + boff);
#pragma unroll
        for (int ai = 0; ai < 2; ++ai)
#pragma unroll
            for (int m = 0; m < 4; ++m) {
                float* pr = base + (size_t)(ai * HALF + wr * 64 + m * 16 + fr) * pitch;
#pragma unroll
                for (int bj = 0; bj < 2; ++bj)
#pragma unroll
                    for (int n = 0; n < 2; ++n) {
                        f32x4 x = *(const f32x4*)(pr + bj * HALF + n * 16);
                        if (p2) x = (f32x4){0.f, 0.f, 0.f, 0.f};
                        *(f32x4*)(pr + bj * HALF + n * 16) = x + g[bj][n] * acc[ai][bj][m][n];
                    }
                __builtin_amdgcn_sched_barrier(0);
            }
    }
};

struct EpiWin {
    static constexpr bool PERM = true;
    bf16_t *GLU, *CH, *BG, *Q, *Kb, *Vb; const float *qg, *kg; float *newk, *newv; int layer;
    __device__ __forceinline__ void operator()(const Acc& acc, const Unit& u, int wr, int wc, int fr, int fq) const {
        const int row0 = u.pm * BM + wr * 64 + fr, cw = wc * 32 + 8 * fq, pn = u.pn;
        if (pn < 8) {
            bf16_t* O = (pn < 4 ? GLU : CH); const int col0 = (pn & 3) * HALF + cw;
#pragma unroll
            for (int ai = 0; ai < 2; ++ai)
#pragma unroll
                for (int m = 0; m < 4; ++m) {
                    f32x4 h0, h1;
                    if (pn < 4) {
#pragma unroll
                        for (int j = 0; j < 4; ++j) { h0[j] = acc[ai][0][m][0][j] * sigmoidf_(acc[ai][1][m][0][j]); h1[j] = acc[ai][0][m][1][j] * sigmoidf_(acc[ai][1][m][1][j]); }
                    } else { h0 = acc[ai][0][m][0] * acc[ai][1][m][0]; h1 = acc[ai][0][m][1] * acc[ai][1][m][1]; }
                    *(u32x4*)(O + (size_t)(row0 + ai * HALF + m * 16) * 512 + col0) = pack8(h0, h1);
                    __builtin_amdgcn_sched_barrier(0);
                }
        } else if (pn < 10 || pn >= 14) {
            bf16_t* O = (pn < 10 ? BG : Vb); const int colt = (pn < 10 ? pn - 8 : pn - 14) * BM + cw;
            const bool wnew = (pn >= 14) && (u.pm < 32);
#pragma unroll
            for (int ai = 0; ai < 2; ++ai)
#pragma unroll
                for (int m = 0; m < 4; ++m) {
                    const int row = row0 + ai * HALF + m * 16;
#pragma unroll
                    for (int bj = 0; bj < 2; ++bj) {
                        *(u32x4*)(O + (size_t)row * 512 + colt + bj * HALF) = pack8(acc[ai][bj][m][0], acc[ai][bj][m][1]);
                        if (wnew) { float* p = newv + ((size_t)(u.pm * 2 + layer) * 256 + (row - u.pm * BM)) * 512 + colt + bj * HALF;
                            *(f32x4*)p = acc[ai][bj][m][0]; *(f32x4*)(p + 4) = acc[ai][bj][m][1]; }
                    }
                    __builtin_amdgcn_sched_barrier(0);
                }
        } else {
            const bool isk = pn >= 12; bf16_t* O = isk ? Kb : Q; const float* gn = isk ? kg : qg;
            const int head = 4 * ((pn - 10) & 1) + wc; const bool wnew = isk && (u.pm < 32);
            f32x4 gv[2][2];
#pragma unroll
            for (int bj = 0; bj < 2; ++bj)
#pragma unroll
                for (int n = 0; n < 2; ++n) gv[bj][n] = *(const f32x4*)(gn + 32 * bj + 8 * fq + 4 * n);
#pragma unroll
            for (int ai = 0; ai < 2; ++ai)
#pragma unroll
                for (int m = 0; m < 4; ++m) {
                    const int row = row0 + ai * HALF + m * 16;
                    float ss = 0.f;
#pragma unroll
                    for (int bj = 0; bj < 2; ++bj)
#pragma unroll
                        for (int n = 0; n < 2; ++n) { const f32x4 x = acc[ai][bj][m][n]; ss += (x[0] * x[0] + x[1] * x[1]) + (x[2] * x[2] + x[3] * x[3]); }
                    ss += __shfl_xor(ss, 16); ss += __shfl_xor(ss, 32);
                    const float rinv = __builtin_amdgcn_rsqf(ss * (1.f / 64.f) + EPS);
#pragma unroll
                    for (int bj = 0; bj < 2; ++bj) {
                        const f32x4 y0 = acc[ai][bj][m][0] * rinv * gv[bj][0], y1 = acc[ai][bj][m][1] * rinv * gv[bj][1];
                        const int col = head * 64 + 32 * bj + 8 * fq;
                        *(u32x4*)(O + (size_t)row * 512 + col) = pack8(y0, y1);
                        if (wnew) { float* p = newk + ((size_t)(u.pm * 2 + layer) * 256 + (row - u.pm * BM)) * 512 + col; *(f32x4*)p = y0; *(f32x4*)(p + 4) = y1; }
                    }
                    __builtin_amdgcn_sched_barrier(0);
                }
        }
    }
};

struct EpiGates {
    static constexpr bool PERM = true;
    bf16_t* GS;
    __device__ __forceinline__ void operator()(const Acc& acc, const Unit& u, int wr, int wc, int fr, int fq) const {
        const int gi = u.pn >> 2; const int bi = gi == 0 ? 2 : gi - 1; bf16_t* O = GS + (size_t)bi * GS_STRIDE;
        const int row0 = u.pm * BM + wr * 64 + fr, col0 = (u.pn & 3) * BM + wc * 32 + 8 * fq;
#pragma unroll
        for (int ai = 0; ai < 2; ++ai)
#pragma unroll
            for (int m = 0; m < 4; ++m)
#pragma unroll
                for (int bj = 0; bj < 2; ++bj) {
                    f32x4 h0, h1;
#pragma unroll
                    for (int j = 0; j < 4; ++j) { h0[j] = sigmoidf_(acc[ai][bj][m][0][j]); h1[j] = sigmoidf_(acc[ai][bj][m][1][j]); }
                    *(u32x4*)(O + (size_t)(row0 + ai * HALF + m * 16) * DM + col0 + bj * HALF) = pack8(h0, h1);
                    __builtin_amdgcn_sched_barrier(0);
                }
    }
};

struct EpiM {
    static constexpr bool PERM = true;
    const bf16_t* GS; bf16_t* Mo;
    __device__ __forceinline__ void operator()(const Acc& acc, const Unit& u, int wr, int wc, int fr, int fq) const {
        const bf16_t* Gs = GS + (size_t)u.seg * GS_STRIDE;
        const int row0 = u.pm * BM + wr * 64 + fr, col0 = u.pn * BM + wc * 32 + 8 * fq;
#pragma unroll
        for (int ai = 0; ai < 2; ++ai)
#pragma unroll
            for (int m = 0; m < 4; ++m)
#pragma unroll
                for (int bj = 0; bj < 2; ++bj) {
                    const size_t off = (size_t)(row0 + ai * HALF + m * 16) * DM + col0 + bj * HALF;
                    const u32x4 gw = *(const u32x4*)(Gs + off);
                    f32x4 h0, h1;
                    h0[0] = bflo(gw.x) * acc[ai][bj][m][0][0]; h0[1] = bfhi(gw.x) * acc[ai][bj][m][0][1]; h0[2] = bflo(gw.y) * acc[ai][bj][m][0][2]; h0[3] = bfhi(gw.y) * acc[ai][bj][m][0][3];
                    h1[0] = bflo(gw.z) * acc[ai][bj][m][1][0]; h1[1] = bfhi(gw.z) * acc[ai][bj][m][1][1]; h1[2] = bflo(gw.w) * acc[ai][bj][m][1][2]; h1[3] = bfhi(gw.w) * acc[ai][bj][m][1][3];
                    if (u.seg != 0) { const u32x4 mw = *(const u32x4*)(Mo + off);
                        h0[0] += bflo(mw.x); h0[1] += bfhi(mw.x); h0[2] += bflo(mw.y); h0[3] += bfhi(mw.y);
                        h1[0] += bflo(mw.z); h1[1] += bfhi(mw.z); h1[2] += bflo(mw.w); h1[3] += bfhi(mw.w); }
                    *(u32x4*)(Mo + off) = pack8(h0, h1);
                    __builtin_amdgcn_sched_barrier(0);
                }
    }
};
}

struct Args { const float* in[32]; };
__device__ __forceinline__ const float* inp(const Args& a, int i) { return a.in[i + opaque_zero()]; }

__device__ __forceinline__ void cvt_block(const float* W, int N, int K, int k0, int n0, bf16_t* WT, int dst_row0, float* scr, int lane) {
#pragma unroll 8
    for (int i = 0; i < 32; ++i) { const int kk = 2 * i + (lane >> 5); scr[kk * 33 + (lane & 31)] = W[(size_t)(k0 + kk) * N + n0 + (lane & 31)]; }
    LDS_WAIT();
    const int c = lane & 7;
#pragma unroll
    for (int j = 0; j < 4; ++j) { const int n = (lane >> 3) + 8 * j; const float* s = scr + (8 * c) * 33 + n;
        u32x4 o; o.x = pk2(s[0 * 33], s[1 * 33]); o.y = pk2(s[2 * 33], s[3 * 33]); o.z = pk2(s[4 * 33], s[5 * 33]); o.w = pk2(s[6 * 33], s[7 * 33]);
        *(u32x4*)(WT + (size_t)(dst_row0 + n) * K + k0 + 8 * c) = o; }
    LDS_WAIT();
}
__device__ __forceinline__ int win_dst(int n) {
    if (n < 512) return 256 * (n >> 7) + (n & 127);
    if (n < 1024) { const int s = n - 512; return 256 * (s >> 7) + 128 + (s & 127); }
    if (n < 1536) return 2048 + (n - 1024);
    if (n < 2048) { const int s = n - 1536; return 1024 + 256 * (s >> 7) + (s & 127); }
    if (n < 2560) { const int s = n - 2048; return 1024 + 256 * (s >> 7) + 128 + (s & 127); }
    if (n < 3584) { const int base = n < 3072 ? 2560 : 3072; const int s = n - base, head = s >> 6, dim = s & 63;
        return base + 256 * (head >> 2) + 128 * (dim >> 5) + 32 * (head & 3) + (dim & 31); }
    return n;
}
__device__ __forceinline__ void convert_weights(const Args& a, int l, unsigned char* lds, int gw, int ngw, int wave, int lane) {
    float* scr = (float*)(lds + wave * 8448);
    unsigned char* ws = (unsigned char*)inp(a, 31);
    constexpr int I_GU = 16 * 88, I_D = 44 * 32, I_IN = 16 * 224, I_O = 8 * 32, I_M = 16 * 32;
    constexpr int NIT = 6 * I_GU + I_IN + 3 * I_O + I_M;
    static_assert(I_GU == I_D, "");
    for (int it = gw; it < NIT; it += ngw) {
        int r = it;
        if (r < 6 * I_GU) {
            const int which = r / I_GU; r -= which * I_GU;
            const int ff = which / 3, kind = which % 3;
            if (kind < 2) {
                const float* W = inp(a, (ff ? 27 : 9) + kind) + (size_t)l * DM * DFF;
                const int kb = r / 88, nb = r % 88, n0 = nb * 32;
                cvt_block(W, DFF, DM, kb * 64, n0, (bf16_t*)(ws + (ff ? W_GU2 : W_GU1)), 256 * (n0 >> 7) + 128 * kind + (n0 & 127), scr, lane);
            } else {
                const float* W = inp(a, ff ? 29 : 11) + (size_t)l * DFF * DM;
                const int kb = r / 32, nb = r % 32;
                cvt_block(W, DM, DFF, kb * 64, nb * 32, (bf16_t*)(ws + (ff ? W_D2 : W_D1)), nb * 32, scr, lane);
            }
            continue;
        }
        r -= 6 * I_GU;
        if (r < I_IN) { const int kb = r / 224, nb = r % 224; cvt_block(inp(a, 13) + (size_t)l * DM * NIN, NIN, DM, kb * 64, nb * 32, (bf16_t*)(ws + W_IN), win_dst(nb * 32), scr, lane); continue; }
        r -= I_IN;
        if (r < 3 * I_O) { const int which = r / I_O; r -= which * I_O; const int kb = r / 32, nb = r % 32;
            const float* W = inp(a, which == 0 ? 18 : (which == 1 ? 20 : 24)) + (size_t)l * 512 * DM;
            cvt_block(W, DM, 512, kb * 64, nb * 32, (bf16_t*)(ws + (which == 0 ? W_A : (which == 1 ? W_B : W_C))), nb * 32, scr, lane); continue; }
        r -= 3 * I_O;
        { const int kb = r / 32, nb = r % 32; cvt_block(inp(a, 25) + (size_t)l * DM * DM, DM, DM, kb * 64, nb * 32, (bf16_t*)(ws + W_M), nb * 32, scr, lane); }
    }
}

__device__ __forceinline__ void compute_mods(const Args& a, unsigned char* lds, int tid, int wave, int lane) {
    float* sT = (float*)lds;
    float* red = (float*)(lds + 49152);
    const float* c = inp(a, 4); const float* cctx = inp(a, 5);
    for (int k = tid; k < DM; k += NTHR) {
        sT[k * 12 + 0] = siluf_(cctx[k]);
#pragma unroll
        for (int v = 1; v < 9; ++v) sT[k * 12 + v] = siluf_(c[(v - 1) * DM + k]);
        sT[k * 12 + 9] = 0.f; sT[k * 12 + 10] = 0.f; sT[k * 12 + 11] = 0.f;
    }
    __syncthreads();
    float* mods = (float*)((unsigned char*)inp(a, 31) + WS_MODS);
    for (int unit = blockIdx.x; unit < 288; unit += gridDim.x) {
        const int l = unit / 144, cb = unit % 144, col = cb * 64 + lane;
        const float* W = inp(a, 6) + (size_t)l * DM * MODW + col;
        float acc[9];
#pragma unroll
        for (int v = 0; v < 9; ++v) acc[v] = 0.f;
#pragma unroll 8
        for (int kk = 0; kk < 128; ++kk) {
            const int k = wave * 128 + kk;
            const float w = W[(size_t)k * MODW];
            const f32x4 s0 = *(const f32x4*)(sT + k * 12), s1 = *(const f32x4*)(sT + k * 12 + 4), s2 = *(const f32x4*)(sT + k * 12 + 8);
            acc[0] += s0[0] * w; acc[1] += s0[1] * w; acc[2] += s0[2] * w; acc[3] += s0[3] * w;
            acc[4] += s1[0] * w; acc[5] += s1[1] * w; acc[6] += s1[2] * w; acc[7] += s1[3] * w; acc[8] += s2[0] * w;
        }
#pragma unroll
        for (int v = 0; v < 9; ++v) red[(wave * 9 + v) * 64 + lane] = acc[v];
        __syncthreads();
        for (int idx = tid; idx < 576; idx += NTHR) {
            const int v = idx >> 6, ln = idx & 63; float s = inp(a, 7)[(size_t)l * MODW + cb * 64 + ln];
#pragma unroll
            for (int w = 0; w < 8; ++w) s += red[(w * 9 + v) * 64 + ln];
            mods[((size_t)l * 9 + v) * MODW + cb * 64 + ln] = s;
        }
        __syncthreads();
    }
}

__device__ __forceinline__ void adaln_phase(const float* in0, const float* in1, const float* g, const float* modl, int ish, bf16_t* U, float* xcopy, const float* fold, int gw, int ngw, int lane) {
    for (int row = gw; row < MTOK; row += ngw) {
        const float* xr = (row < NCTX ? in0 : in1) + (size_t)row * DM;
        const int v = row < NCTX ? 0 : 1 + ((row - NCTX) >> 12);
        const float* sh = modl + (size_t)v * MODW + ish * DM; const float* sc = sh + DM;
        f32x4 x[4]; float ss = 0.f;
#pragma unroll
        for (int j = 0; j < 4; ++j) { x[j] = *(const f32x4*)(xr + 256 * j + 4 * lane);
            if (fold && row >= FOLD_ROW0) x[j] += *(const f32x4*)(fold + ((size_t)(((row - FOLD_ROW0) >> 8) * 4 + j) * 256 + (row & 255)) * 256 + 4 * lane);
            if (xcopy && (!fold || row >= FOLD_ROW0)) *(f32x4*)(xcopy + (size_t)row * DM + 256 * j + 4 * lane) = x[j]; ss += (x[j][0] * x[j][0] + x[j][1] * x[j][1]) + (x[j][2] * x[j][2] + x[j][3] * x[j][3]); }
        const float rinv = __builtin_amdgcn_rsqf(wave_sum(ss) * (1.f / DM) + EPS);
#pragma unroll
        for (int j = 0; j < 4; ++j) {
            const int c = 256 * j + 4 * lane;
            const f32x4 gg = *(const f32x4*)(g + c), s1 = *(const f32x4*)(sc + c), s0 = *(const f32x4*)(sh + c);
            const f32x4 y = x[j] * rinv * gg * (s1 + 1.f) + s0;
            u32x2 w; w.x = pk2(y[0], y[1]); w.y = pk2(y[2], y[3]);
            *(u32x2*)(U + (size_t)row * DM + c) = w;
        }
    }
}

namespace att {
constexpr int PITCH = 272, KS_OFF = 0, VS_OFF = 64 * PITCH, RPB_OFF = 2 * 64 * PITCH;
typedef short v4i16_t __attribute__((ext_vector_type(4)));
__device__ __forceinline__ s16x4 vtr(const LAS char* p) { return __builtin_bit_cast(s16x4, __builtin_amdgcn_ds_read_tr16_b64_v4i16((LAS v4i16_t*)p)); }

struct TileSrc { const bf16_t* k; const bf16_t* v; };

template <bool LOCAL>
__device__ __forceinline__ void tile_compute(const LAS char* ldsb, const bf16x8 (&qf)[2], f32x4 (&O)[4], float& mrun, float& lrun,
                                             int hl, int koff, int fr, int fq, int lane, const float* rpbrow, const int (&dci)[8], unsigned vmask) {
    constexpr int NMT = LOCAL ? 2 : 4;
    f32x4 s[NMT];
#pragma unroll
    for (int mt = 0; mt < NMT; ++mt) {
        s[mt] = (f32x4){0.f, 0.f, 0.f, 0.f};
#pragma unroll
        for (int ks = 0; ks < 2; ++ks) {
            const bf16x8 kf = *(const LAS bf16x8*)(ldsb + KS_OFF + (koff + 16 * mt + fr) * PITCH + hl * 128 + ks * 64 + fq * 16);
            s[mt] = __builtin_amdgcn_mfma_f32_16x16x32_bf16(kf, qf[ks], s[mt], 0, 0, 0);
        }
    }
    float tmax = -1e30f;
#pragma unroll
    for (int mt = 0; mt < NMT; ++mt)
#pragma unroll
        for (int j = 0; j < 4; ++j) {
            float v = s[mt][j] * 0.125f;
            if (LOCAL) { v += rpbrow[dci[mt * 4 + j]]; if (!((vmask >> (mt * 4 + j)) & 1u)) v = -1e30f; }
            s[mt][j] = v; tmax = fmaxf(tmax, v);
        }
    tmax = fmaxf(tmax, __shfl_xor(tmax, 16)); tmax = fmaxf(tmax, __shfl_xor(tmax, 32));
    const float mnew = fmaxf(mrun, tmax), alpha = __expf(mrun - mnew);
    float psum = 0.f;
#pragma unroll
    for (int mt = 0; mt < NMT; ++mt)
#pragma unroll
        for (int j = 0; j < 4; ++j) { const float p = __expf(s[mt][j] - mnew); s[mt][j] = p; psum += p; }
    lrun = lrun * alpha + psum; mrun = mnew;
#pragma unroll
    for (int dt = 0; dt < 4; ++dt) O[dt] = O[dt] * alpha;
    const int g = lane >> 4, q = (lane & 15) >> 2, p4 = lane & 3;
#pragma unroll
    for (int kk = 0; kk < NMT / 2; ++kk) {
        bf16x8 pb;
        { const u32x4 w = pg8::pack8(s[2 * kk], s[2 * kk + 1]); pb = __builtin_bit_cast(bf16x8, w); }
#pragma unroll
        for (int dt = 0; dt < 4; ++dt) {
            const LAS char* vb = ldsb + VS_OFF + hl * 128 + 32 * dt + 8 * p4;
            const s16x4 v0 = vtr(vb + (koff + 32 * kk + 4 * g + q) * PITCH);
            const s16x4 v1 = vtr(vb + (koff + 32 * kk + 16 + 4 * g + q) * PITCH);
            bf16x8 vf; vf[0] = v0[0]; vf[1] = v0[1]; vf[2] = v0[2]; vf[3] = v0[3]; vf[4] = v1[0]; vf[5] = v1[1]; vf[6] = v1[2]; vf[7] = v1[3];
            O[dt] = __builtin_amdgcn_mfma_f32_16x16x32_bf16(vf, pb, O[dt], 0, 0, 0);
        }
    }
}

template <bool LATENT>
__device__ __forceinline__ void unit(unsigned char* lds, bf16_t* QO, const bf16_t* Kb, const bf16_t* Vb, const bf16_t* CK, const bf16_t* CV, const float* rpb_l,
                                     int qrow0  , int keyrow0  , int hp, int r  ,
                                     int tid, int wave, int lane) {
    const LAS char* ldsb = (const LAS char*)(LAS unsigned char*)lds;
    const int hl = wave >> 2, J = wave & 3, fr = lane & 15, fq = lane >> 4;
    const int rs = LATENT ? min(max(r - 4, 0), 56) : 0;
    constexpr int NT = LATENT ? 16 : 4;
    int dci[8]; unsigned vmask = 0u; int koff = 0;
    if (LATENT) {
        const int qc = 16 * J + fr, wstart = min(max(qc - 8, 0), 48);
        koff = min(max(16 * J - 8, 0), 32);
#pragma unroll
        for (int mt = 0; mt < 2; ++mt)
#pragma unroll
            for (int j = 0; j < 4; ++j) { const int kc = koff + 16 * mt + 4 * fq + j;
                dci[mt * 4 + j] = min(max(kc - qc, -15), 15) + 15;
                if (kc >= wstart && kc < wstart + 16) vmask |= 1u << (mt * 4 + j); }
        float* tb = (float*)(lds + RPB_OFF);
        for (int i = tid; i < 2 * 15 * 32; i += NTHR) { const int h2 = i / 480, rem = i % 480, dr = rem >> 5, dc = rem & 31;
            tb[i] = dc < 31 ? rpb_l[((2 * hp + h2) * 15 + dr) * 31 + dc] : 0.f; }
    } else {
#pragma unroll
        for (int i = 0; i < 8; ++i) dci[i] = 0;
    }
    bf16x8 qf[2];
    { const bf16_t* qp = QO + (size_t)(qrow0 + 16 * J + fr) * 512 + (2 * hp + hl) * 64 + 8 * fq;
      qf[0] = *(const bf16x8*)qp; qf[1] = *(const bf16x8*)(qp + 32); }
    f32x4 O[4];
#pragma unroll
    for (int dt = 0; dt < 4; ++dt) O[dt] = (f32x4){0.f, 0.f, 0.f, 0.f};
    float mrun = -1e30f, lrun = 0.f;
    const int key0 = tid >> 4, part = tid & 15;
    u32x4 kreg[2], vreg[2];
    auto tsrc = [&](int t) -> TileSrc {
        TileSrc s;
        if (LATENT) {
            if (t < 8) { s.k = CK + (size_t)(t * 64) * 512 + hp * 128; s.v = CV + (size_t)(t * 64) * 512 + hp * 128; }
            else { const size_t ro = (size_t)(keyrow0 + (rs + t - 8) * 64) * 512 + hp * 128; s.k = Kb + ro; s.v = Vb + ro; }
        } else { const size_t ro = (size_t)(keyrow0 + t * 64) * 512 + hp * 128; s.k = Kb + ro; s.v = Vb + ro; }
        return s;
    };
    { const TileSrc s0 = tsrc(0);
#pragma unroll
      for (int i = 0; i < 2; ++i) { const size_t o = (size_t)(key0 + 32 * i) * 512 + part * 8; kreg[i] = *(const u32x4*)(s0.k + o); vreg[i] = *(const u32x4*)(s0.v + o); } }
    for (int t = 0; t < NT; ++t) {
        __syncthreads();
#pragma unroll
        for (int i = 0; i < 2; ++i) { const int lo = (key0 + 32 * i) * PITCH + part * 16;
            *(u32x4*)(lds + KS_OFF + lo) = kreg[i]; *(u32x4*)(lds + VS_OFF + lo) = vreg[i]; }
        __syncthreads();
        if (t + 1 < NT) { const TileSrc s1 = tsrc(t + 1);
#pragma unroll
            for (int i = 0; i < 2; ++i) { const size_t o = (size_t)(key0 + 32 * i) * 512 + part * 8; kreg[i] = *(const u32x4*)(s1.k + o); vreg[i] = *(const u32x4*)(s1.v + o); } }
        if (LATENT && t >= 8) {
            const int dr = (rs + t - 8) - r + 7;
            const float* rpbrow = (const float*)(lds + RPB_OFF) + (hl * 15 + dr) * 32;
            tile_compute<true>(ldsb, qf, O, mrun, lrun, hl, koff, fr, fq, lane, rpbrow, dci, vmask);
        } else {
            tile_compute<false>(ldsb, qf, O, mrun, lrun, hl, 0, fr, fq, lane, nullptr, dci, 0u);
        }
    }
    lrun += __shfl_xor(lrun, 16); lrun += __shfl_xor(lrun, 32);
    const float linv = 1.f / lrun;
    bf16_t* op = QO + (size_t)(qrow0 + 16 * J + fr) * 512 + (2 * hp + hl) * 64 + 4 * fq;
#pragma unroll
    for (int dt = 0; dt < 4; ++dt) { u32x2 w; w.x = cvt_pk_bf16(O[dt][0] * linv, O[dt][1] * linv); w.y = cvt_pk_bf16(O[dt][2] * linv, O[dt][3] * linv); *(u32x2*)(op + 16 * dt) = w; }
    __syncthreads();
}
}

__device__ __forceinline__ void conva_unit(unsigned char* lds, const bf16_t* GLU, bf16_t* AOUT, const float* cw, const float* cb, const float* lg, const float* lb,
                                           int rowbase, int len, int t0, int tid, int wave, int lane) {
    bf16_t* in_s = (bf16_t*)lds;
    float* hs = (float*)(lds + 62 * 512 * 2);
    for (int idx = tid; idx < 62 * 64; idx += NTHR) {
        const int i = idx >> 6, ch = idx & 63, p = t0 - 15 + i;
        u32x4 v = (u32x4){0u, 0u, 0u, 0u};
        if (p >= 0 && p < len) v = *(const u32x4*)(GLU + (size_t)(rowbase + p) * 512 + ch * 8);
        *(u32x4*)(in_s + i * 512 + ch * 8) = v;
    }
    float w[31];
#pragma unroll
    for (int j = 0; j < 31; ++j) w[j] = cw[j * 512 + tid];
    const float bias = cb[tid];
    __syncthreads();
    float col[62];
#pragma unroll
    for (int i = 0; i < 62; ++i) col[i] = __uint_as_float((unsigned)in_s[i * 512 + tid] << 16);
#pragma unroll
    for (int tt = 0; tt < 32; ++tt) {
        float acc = bias;
#pragma unroll
        for (int j = 0; j < 31; ++j) acc += col[tt + j] * w[j];
        hs[tt * 512 + tid] = acc;
    }
    __syncthreads();
#pragma unroll
    for (int q = 0; q < 4; ++q) {
        const int tt = wave * 4 + q;
        const f32x4 a = *(const f32x4*)(hs + tt * 512 + lane * 8), b = *(const f32x4*)(hs + tt * 512 + lane * 8 + 4);
        const float mean = wave_sum((a[0] + a[1]) + (a[2] + a[3]) + (b[0] + b[1]) + (b[2] + b[3])) * (1.f / 512.f);
        const f32x4 da = a - mean, db = b - mean;
        const float var = wave_sum((da[0] * da[0] + da[1] * da[1]) + (da[2] * da[2] + da[3] * da[3]) + (db[0] * db[0] + db[1] * db[1]) + (db[2] * db[2] + db[3] * db[3])) * (1.f / 512.f);
        const float rstd = __builtin_amdgcn_rsqf(var + EPS);
        const f32x4 g0 = *(const f32x4*)(lg + lane * 8), g1 = *(const f32x4*)(lg + lane * 8 + 4), b0 = *(const f32x4*)(lb + lane * 8), b1 = *(const f32x4*)(lb + lane * 8 + 4);
        f32x4 y0 = da * rstd * g0 + b0, y1 = db * rstd * g1 + b1;
#pragma unroll
        for (int j = 0; j < 4; ++j) { y0[j] = siluf_(y0[j]); y1[j] = siluf_(y1[j]); }
        *(u32x4*)(AOUT + (size_t)(rowbase + t0 + tt) * 512 + lane * 8) = pg8::pack8(y0, y1);
    }
    __syncthreads();
}

__device__ __forceinline__ void convb_phase(bf16_t* BG, const bf16_t* CH, const float* w3, int gtid, int nthreads) {
    for (int idx = gtid; idx < MTOK * 64; idx += nthreads) {
        const int row = idx >> 6, ch = idx & 63;
        int pos, len; if (row < NCTX) { pos = row & 255; len = 256; } else { pos = (row - NCTX) & 4095; len = 4096; }
        const u32x4 z = (u32x4){0u, 0u, 0u, 0u};
        const u32x4 c1 = *(const u32x4*)(CH + (size_t)row * 512 + ch * 8);
        const u32x4 c0 = pos > 0 ? *(const u32x4*)(CH + (size_t)(row - 1) * 512 + ch * 8) : z;
        const u32x4 c2 = pos < len - 1 ? *(const u32x4*)(CH + (size_t)(row + 1) * 512 + ch * 8) : z;
        const u32x4 bg = *(const u32x4*)(BG + (size_t)row * 512 + ch * 8);
        f32x4 wa[3], wb[3];
#pragma unroll
        for (int j = 0; j < 3; ++j) { wa[j] = *(const f32x4*)(w3 + j * 512 + ch * 8); wb[j] = *(const f32x4*)(w3 + j * 512 + ch * 8 + 4); }
        f32x4 y0, y1;
#define CB_(o, k, W, c0w, c1w, c2w, bgw, F) o[k] = F(bgw) * (F(c0w) * W[0][k] + F(c1w) * W[1][k] + F(c2w) * W[2][k])
        CB_(y0, 0, wa, c0.x, c1.x, c2.x, bg.x, bflo); CB_(y0, 1, wa, c0.x, c1.x, c2.x, bg.x, bfhi);
        CB_(y0, 2, wa, c0.y, c1.y, c2.y, bg.y, bflo); CB_(y0, 3, wa, c0.y, c1.y, c2.y, bg.y, bfhi);
        CB_(y1, 0, wb, c0.z, c1.z, c2.z, bg.z, bflo); CB_(y1, 1, wb, c0.z, c1.z, c2.z, bg.z, bfhi);
        CB_(y1, 2, wb, c0.w, c1.w, c2.w, bg.w, bflo); CB_(y1, 3, wb, c0.w, c1.w, c2.w, bg.w, bfhi);
#undef CB_
        *(u32x4*)(BG + (size_t)row * 512 + ch * 8) = pg8::pack8(y0, y1);
    }
}

#ifndef PHASE_MASK
#define PHASE_MASK 0xFFFFF
#endif
#define PH_ON(n) ((PHASE_MASK >> (n)) & 1)
#ifndef LAST_PHASE
#define LAST_PHASE 99
#endif
#define PHX(n) if (l * 12 + (n) <= LAST_PHASE)

__global__ void __launch_bounds__(NTHR, 2) fwd_megakernel(Args a) {
    extern __shared__ __attribute__((aligned(16))) unsigned char lds[];
    cg::grid_group grid = cg::this_grid();
    const int G = gridDim.x, bx = blockIdx.x;
    PG8_LAS unsigned char* ldsg = (PG8_LAS unsigned char*)lds;
    unsigned bar_epoch = 0;
    grid.sync();
#define GSYNC() do { asm volatile("s_waitcnt vmcnt(0) lgkmcnt(0)" ::: "memory"); __syncthreads(); ++bar_epoch; \
        if (threadIdx.x == 0) { unsigned* ctr_ = (unsigned*)inp(a, 31); \
            __builtin_amdgcn_fence(__ATOMIC_RELEASE, "agent"); asm volatile("s_waitcnt vmcnt(0)" ::: "memory"); \
            __hip_atomic_fetch_add(ctr_, 1u, __ATOMIC_RELAXED, __HIP_MEMORY_SCOPE_AGENT); \
            const unsigned want_ = bar_epoch * gridDim.x; unsigned spins_ = 0; \
            while (__hip_atomic_load(ctr_, __ATOMIC_RELAXED, __HIP_MEMORY_SCOPE_AGENT) < want_ && ++spins_ < (1u << 24)) __builtin_amdgcn_s_sleep(2); \
            __builtin_amdgcn_fence(__ATOMIC_ACQUIRE, "agent"); asm volatile("s_waitcnt vmcnt(0)" ::: "memory"); } \
        __syncthreads(); } while (0)
#define TIDS const int tid = threadIdx.x + opaque_vzero(), lane = tid & 63, wave = __builtin_amdgcn_readfirstlane(tid >> 6); \
             const int gw = bx * NWAVES + wave, ngw = G * NWAVES, gtid = bx * NTHR + tid, nthreads = G * NTHR; (void)gw; (void)ngw; (void)gtid; (void)nthreads; (void)lane;
#define BASES const int z_ = opaque_zero(); unsigned char* ws = (unsigned char*)inp(a, 31); float* out = (float*)inp(a, 30); const int lp = l + z_; const int bxp = bx + z_, Gp = G + z_; (void)bxp; (void)Gp; \
              const float* modl = (const float*)(ws + WS_MODS) + (size_t)lp * 9 * MODW; (void)modl; (void)out;

    {
        TIDS
#if PH_ON(0)
        compute_mods(a, lds, tid, wave, lane);
#endif
        unsigned char* ws = (unsigned char*)inp(a, 31);
        bf16_t* CK = (bf16_t*)(ws + WS_CK); bf16_t* CV = (bf16_t*)(ws + WS_CV);
        for (int i = gtid; i < 2 * 524288; i += nthreads) {
            const int which = i >= 524288; const int j = which ? i - 524288 : i;
            const float* src = inp(a, which ? 3 : 2) + (size_t)j * 8; bf16_t* dst = (which ? CV : CK) + (size_t)j * 8;
            const f32x4 x0 = *(const f32x4*)src, x1 = *(const f32x4*)(src + 4);
            u32x4 w; w.x = pk2(x0[0], x0[1]); w.y = pk2(x0[2], x0[3]); w.z = pk2(x1[0], x1[1]); w.w = pk2(x1[2], x1[3]);
            *(u32x4*)dst = w;
        }
    }
    GSYNC();

    for (int l = 0; l < 2; ++l) {
        PHX(1) {
            TIDS BASES
#if PH_ON(1)
            convert_weights(a, lp, lds, gw, ngw, wave, lane);
#endif
#if PH_ON(2)
            const float* xin0 = lp == 0 ? inp(a, 0) : out;
            const float* xin1 = lp == 0 ? inp(a, 1) - (size_t)NCTX * DM : out;
            adaln_phase(xin0, xin1, inp(a, 8) + lp * DM, modl, 0, (bf16_t*)(ws + WS_U), out, lp == 0 ? nullptr : (const float*)(ws + WS_PART), gw, ngw, lane);
#endif
        }
        GSYNC();
#if PH_ON(3)
        PHX(2) { BASES
          pg8::Gemm g{(const bf16_t*)(ws + WS_U), (const bf16_t*)(ws + W_GU1), 0, 0, MTOK, 2 * DFF, DM}; pg8::Order S; S.init(MTOK, 2 * DFF, DM, Gp, bxp, 1, 0);
          pg8::EpiSwiGLU E{(bf16_t*)(ws + WS_H)}; pg8::gemm_phase<pg8::EpiSwiGLU, true, true>(ldsg, g, S, E); }
#endif
        GSYNC();
#if PH_ON(4)
        PHX(3) { BASES
          pg8::Gemm g{(const bf16_t*)(ws + WS_H), (const bf16_t*)(ws + W_D1), 0, 0, MTOK, DM, DFF}; pg8::Order S; S.init(MTOK, DM, DFF, Gp, bxp, 1, 1);
          pg8::EpiResid E{out, modl + 2 * DM, (long long)((unsigned long long)(ws + WS_PART) - (unsigned long long)out), 1}; pg8::gemm_phase<pg8::EpiResid, true, true>(ldsg, g, S, E); }
#endif
        GSYNC();
#if PH_ON(14)
        PHX(4) { TIDS BASES
          adaln_phase(out, out, inp(a, 12) + lp * DM, modl, 3, (bf16_t*)(ws + WS_U), out, (const float*)(ws + WS_PART), gw, ngw, lane); }
#endif
        GSYNC();
#if PH_ON(5)
        PHX(5) { BASES
          float* newk = out + (size_t)MTOK * DM; float* newv = newk + (size_t)32 * 2 * 256 * 512;
          pg8::Gemm g{(const bf16_t*)(ws + WS_U), (const bf16_t*)(ws + W_IN), 0, 0, MTOK, 4096, DM}; pg8::Order S; S.init(MTOK, 4096, DM, Gp, bxp, 1, 0);
          pg8::EpiWin E{(bf16_t*)(ws + WS_GLU), (bf16_t*)(ws + WS_CH), (bf16_t*)(ws + WS_BG), (bf16_t*)(ws + WS_Q), (bf16_t*)(ws + WS_K), (bf16_t*)(ws + WS_V),
                        inp(a, 21) + lp * 64, inp(a, 22) + lp * 64, newk, newv, lp};
          pg8::gemm_phase<pg8::EpiWin, true, true>(ldsg, g, S, E); }
#endif
        GSYNC();
        PHX(6) {
            TIDS BASES
            bf16_t* Q = (bf16_t*)(ws + WS_Q); const bf16_t* Kb = (const bf16_t*)(ws + WS_K); const bf16_t* Vb = (const bf16_t*)(ws + WS_V);
#if PH_ON(11)
            {
            const bf16_t* CK = (const bf16_t*)(ws + WS_CK); const bf16_t* CV = (const bf16_t*)(ws + WS_CV);
            const float* rpb_l = inp(a, 23) + (size_t)lp * 8 * 15 * 31;
            for (int u = bxp; u < 2048; u += Gp) {
                const int b = u >> 8, hp = (u >> 6) & 3, r = u & 63;
                const size_t co = (size_t)((b * 2 + lp) * 512) * 512;
                att::unit<true>(lds, Q, Kb, Vb, CK + co, CV + co, rpb_l, NCTX + b * 4096 + r * 64, NCTX + b * 4096, hp, r, tid, wave, lane);
            }
            for (int u = bxp; u < 512; u += Gp) {
                const int b = u >> 4, hp = (u >> 2) & 3, qb = u & 3;
                att::unit<false>(lds, Q, Kb, Vb, nullptr, nullptr, nullptr, b * 256 + qb * 64, b * 256, hp, 0, tid, wave, lane);
            }
            }
#endif
#if PH_ON(12)
            {
            const float* cw = inp(a, 14) + (size_t)lp * 31 * 512; const float* cb = inp(a, 15) + lp * 512; const float* lg = inp(a, 16) + lp * 512; const float* lb = inp(a, 17) + lp * 512;
            for (int u = bxp; u < 1280; u += Gp) {
                int rowbase, len, t0;
                if (u < 256) { rowbase = (u >> 3) * 256; len = 256; t0 = (u & 7) * 32; }
                else { const int v = u - 256; rowbase = NCTX + (v >> 7) * 4096; len = 4096; t0 = (v & 127) * 32; }
                conva_unit(lds, (const bf16_t*)(ws + WS_GLU), (bf16_t*)(ws + WS_AOUT), cw, cb, lg, lb, rowbase, len, t0, tid, wave, lane);
            }
            }
#endif
#if PH_ON(13)
            convb_phase((bf16_t*)(ws + WS_BG), (const bf16_t*)(ws + WS_CH), inp(a, 19) + (size_t)lp * 3 * 512, gtid, nthreads);
#endif
        }
        GSYNC();
#if PH_ON(6)
        PHX(7) { BASES
          const bf16_t* Wg = (const bf16_t*)(ws + W_IN) + (size_t)4096 * DM;
          pg8::Gemm g{(const bf16_t*)(ws + WS_U), Wg, 0, 0, MTOK, 3072, DM}; pg8::Order S; S.init(MTOK, 3072, DM, Gp, bxp, 1, 0);
          pg8::EpiGates E{(bf16_t*)(ws + WS_GS)}; pg8::gemm_phase<pg8::EpiGates, true, true>(ldsg, g, S, E); }
#endif
        GSYNC();
#if PH_ON(7)
        PHX(8) { BASES
          pg8::Gemm g{(const bf16_t*)(ws + WS_BG), (const bf16_t*)(ws + W_B), BR_STRIDE, WO_STRIDE, MTOK, DM, 512}; pg8::Order S; S.init(MTOK, DM, 512, Gp, bxp, 3, 0);
          pg8::EpiM E{(const bf16_t*)(ws + WS_GS), (bf16_t*)(ws + WS_U)}; pg8::gemm_phase<pg8::EpiM, true, true>(ldsg, g, S, E); }
#endif
        GSYNC();
#if PH_ON(8)
        PHX(9) { BASES
          pg8::Gemm g{(const bf16_t*)(ws + WS_U), (const bf16_t*)(ws + W_M), 0, 0, MTOK, DM, DM}; pg8::Order S; S.init(MTOK, DM, DM, Gp, bxp, 1, 1);
          pg8::EpiResid E{out, modl + 5 * DM, (long long)((unsigned long long)(ws + WS_PART) - (unsigned long long)out), 0}; pg8::gemm_phase<pg8::EpiResid, true, true>(ldsg, g, S, E); }
#endif
        GSYNC();
#if PH_ON(14)
        PHX(10) { TIDS BASES
          adaln_phase(out, out, inp(a, 26) + lp * DM, modl, 6, (bf16_t*)(ws + WS_U), out, (const float*)(ws + WS_PART), gw, ngw, lane); }
#endif
        GSYNC();
#if PH_ON(9)
        PHX(11) { BASES
          pg8::Gemm g{(const bf16_t*)(ws + WS_U), (const bf16_t*)(ws + W_GU2), 0, 0, MTOK, 2 * DFF, DM}; pg8::Order S; S.init(MTOK, 2 * DFF, DM, Gp, bxp, 1, 0);
          pg8::EpiSwiGLU E{(bf16_t*)(ws + WS_H)}; pg8::gemm_phase<pg8::EpiSwiGLU, true, true>(ldsg, g, S, E); }
#endif
        GSYNC();
#if PH_ON(10)
        PHX(12) { BASES
          pg8::Gemm g{(const bf16_t*)(ws + WS_H), (const bf16_t*)(ws + W_D2), 0, 0, MTOK, DM, DFF}; pg8::Order S; S.init(MTOK, DM, DFF, Gp, bxp, 1, 1);
          pg8::EpiResid E{out, modl + 8 * DM, (long long)((unsigned long long)(ws + WS_PART) - (unsigned long long)out), 1}; pg8::gemm_phase<pg8::EpiResid, true, true>(ldsg, g, S, E); }
#endif
        GSYNC();
    }
    { const int l = 1; TIDS BASES
      const float* fold = (const float*)(ws + WS_PART);
      for (int idx = gtid; idx < (MTOK - FOLD_ROW0) * 256; idx += nthreads) {
          const int row = FOLD_ROW0 + (idx >> 8), c4 = idx & 255, j = c4 >> 6, ln = c4 & 63;
          float* o = out + (size_t)row * DM + 256 * j + 4 * ln;
          *(f32x4*)o = *(const f32x4*)o + *(const f32x4*)(fold + ((size_t)(((row - FOLD_ROW0) >> 8) * 4 + j) * 256 + (row & 255)) * 256 + 4 * ln);
      } }
}

extern "C" void kernel_launch(void* const* d_in, const int* in_sizes, int n_in, void* d_out, int out_size, void* d_ws, size_t ws_size, hipStream_t stream) {
    static int grid = 0;
    if (grid == 0) {
        if (n_in != 30 || ws_size < WS_END) { fprintf(stderr, "kernel_launch: unexpected inputs (n_in %d, ws %zu)\n", n_in, ws_size); grid = -1; return; }
        int dev = 0, cus = 0, per_cu = 0;
        hipGetDevice(&dev);
        hipDeviceGetAttribute(&cus, hipDeviceAttributeMultiprocessorCount, dev);
        hipFuncSetAttribute((const void*)fwd_megakernel, hipFuncAttributeMaxDynamicSharedMemorySize, LDS_BYTES);
        hipOccupancyMaxActiveBlocksPerMultiprocessor(&per_cu, (const void*)fwd_megakernel, NTHR, LDS_BYTES);
        if (per_cu < 1) per_cu = 1;
        (void)hipGetLastError();
        grid = cus;
        if (grid > 256) grid = 256;
    }
    if (grid < 0) return;
    Args a{};
    for (int i = 0; i < 30; ++i) a.in[i] = (const float*)d_in[i];
    a.in[30] = (const float*)d_out; a.in[31] = (const float*)d_ws;
    (void)hipMemsetAsync(d_ws, 0, 256, stream);
    void* args[] = {&a};
    hipError_t e = hipLaunchCooperativeKernel((const void*)fwd_megakernel, dim3(grid), dim3(NTHR), args, LDS_BYTES, stream);
    if (e != hipSuccess) fprintf(stderr, "cooperative launch failed: %s (grid %d)\n", hipGetErrorString(e), grid);
}
```

```cpp
#include <hip/hip_runtime.h>
#include <hip/hip_cooperative_groups.h>
#include <cstdio>
#include <cstdint>
namespace cg = cooperative_groups;

#define LAS __attribute__((address_space(3)))
typedef unsigned short bf16_t;
typedef short bf16x8 __attribute__((ext_vector_type(8)));
typedef short s16x4 __attribute__((ext_vector_type(4)));
typedef float f32x4 __attribute__((ext_vector_type(4)));
typedef unsigned u32x4 __attribute__((ext_vector_type(4)));
typedef unsigned u32x2 __attribute__((ext_vector_type(2)));

constexpr int DM = 1024, NCTX = 8192, NLAT = 32768, MTOK = NCTX + NLAT;
constexpr int DFF = 2816, NIN = 7168, NMODV = 9, MODW = 9 * 1024;
constexpr int NWAVES = 8, NTHR = 512;
constexpr float EPS = 1e-6f;

constexpr size_t MiB = 1u << 20;
constexpr size_t WS_MODS = 1 * MiB;
constexpr size_t WS_W = 2 * MiB;
constexpr size_t W_GU1 = WS_W, W_D1 = W_GU1 + 11 * MiB, W_IN = W_D1 + 11 * MiB / 2, W_B = W_IN + 14 * MiB, W_C = W_B + MiB, W_A = W_C + MiB,
                 W_M = W_A + MiB, W_GU2 = W_M + 2 * MiB, W_D2 = W_GU2 + 11 * MiB;
constexpr size_t WS_U = 54 * MiB, WS_H = 134 * MiB;
constexpr size_t WS_BG = 134 * MiB, WS_Q = 174 * MiB, WS_AOUT = 214 * MiB, WS_GLU = 254 * MiB, WS_CH = 294 * MiB, WS_K = 334 * MiB, WS_V = 374 * MiB;
constexpr size_t WS_GS = 254 * MiB;
constexpr size_t GS_STRIDE = 80 * MiB / 2, BR_STRIDE = 40 * MiB / 2, WO_STRIDE = MiB / 2;
constexpr size_t WS_CK = 494 * MiB, WS_CV = 502 * MiB, WS_END = 510 * MiB;
static_assert(W_D2 + 11 * MiB / 2 <= WS_U, "weights fit");
constexpr int LDS_BYTES = 147456;

__device__ __forceinline__ unsigned f2bf(float f) { unsigned u = __builtin_bit_cast(unsigned, f); return (u + 0x7fffu + ((u >> 16) & 1u)) >> 16; }
__device__ __forceinline__ unsigned pk2(float lo, float hi) { return f2bf(lo) | (f2bf(hi) << 16); }
typedef float f32x2_t __attribute__((ext_vector_type(2))); typedef __bf16 bf16x2_t __attribute__((ext_vector_type(2)));
__device__ __forceinline__ unsigned cvt_pk_bf16(float lo, float hi) { f32x2_t v = {lo, hi}; bf16x2_t b = __builtin_convertvector(v, bf16x2_t); return __builtin_bit_cast(unsigned, b); }
__device__ __forceinline__ float bflo(unsigned w) { return __uint_as_float(w << 16); }
__device__ __forceinline__ float bfhi(unsigned w) { return __uint_as_float(w & 0xffff0000u); }
__device__ __forceinline__ float sigmoidf_(float x) { return __builtin_amdgcn_rcpf(1.f + __expf(-x)); }
__device__ __forceinline__ float siluf_(float x) { return x * sigmoidf_(x); }
__device__ __forceinline__ float wave_sum(float v) {
#pragma unroll
    for (int o = 1; o < 64; o <<= 1) v += __shfl_xor(v, o);
    return v;
}
__device__ __forceinline__ int opaque_zero() { int z; asm volatile("s_mov_b32 %0, 0" : "=s"(z)); return z; }
__device__ __forceinline__ int opaque_vzero() { int z; asm volatile("v_mov_b32 %0, 0" : "=v"(z)); return z; }
template <class T> __device__ __forceinline__ T* launder_ptr(T* p) { T* r; asm volatile("s_mov_b64 %0, %1" : "=s"(r) : "s"(p)); return r; }
#define LDS_WAIT() asm volatile("s_waitcnt lgkmcnt(0)" ::: "memory")

namespace pg8 {
#define PG8_LAS __attribute__((address_space(3)))
constexpr int BM = 256, BK = 64, HALF = 128, HTB = HALF * BK * 2, STAGE_BYTES = 8 * HTB, NXCD = 8, WGM = 8;
__device__ __forceinline__ int lds_byte(int r, int c) { const int st = (r >> 4) * 2 + (c >> 5), rr = r & 15, cc = c & 31, ob = rr * 64 + cc * 2; return st * 1024 + (ob ^ (((ob >> 9) & 1) << 5)); }
__device__ __forceinline__ void stage_rc(int b, int& R, int& C) { const int st = b / 1024, sb = b % 1024, swz = sb ^ (((sb >> 9) & 1) << 5); R = (st >> 1) * 16 + swz / 64; C = (st & 1) * 32 + (swz % 64) / 2; }
__device__ __forceinline__ int perm32(int rho) { const int n = rho >> 4, i = rho & 15; return 8 * (i >> 2) + 4 * n + (i & 3); }

struct Unit { int pm, pn, seg; };
struct Gemm { const bf16_t* A; const bf16_t* Bt; size_t segA, segB; int M, N, K; };

struct Order {
    int nM, nN, nwg, G, c, nseg;
    __device__ void init(int M, int N, int G_, int c_, int nseg_) { nM = M / BM; nN = N / BM; nwg = nM * nN; G = G_; c = c_; nseg = nseg_; }
    __device__ bool next(int i, Unit& u) const {
        const int tile = i / nseg, seg = i - tile * nseg;
        const long L = (long)tile * G + c; if (L >= nwg) return false;
        int wgid = (int)L; { const int q = nwg / NXCD, r = nwg % NXCD, xcd = wgid % NXCD, off = wgid / NXCD; wgid = (xcd < r ? xcd * (q + 1) : r * (q + 1) + (xcd - r) * q) + off; }
        const int nig = WGM * nN, gid = wgid / nig, fm = gid * WGM, gsz = (nM - fm) < WGM ? (nM - fm) : WGM;
        u.pm = fm + ((wgid % nig) % gsz); u.pn = (wgid % nig) / gsz; u.seg = seg; return true;
    }
};

template <class Epi, bool ALIGN_EPI, bool SP2>
__device__ __forceinline__ void gemm_phase(PG8_LAS unsigned char* lds, const Gemm g, const Order& S, const Epi& E) {
    const int tid = threadIdx.x + opaque_vzero(), wid = __builtin_amdgcn_readfirstlane(tid >> 6), lane = tid & 63, wr = wid >> 2, wc = wid & 3, fr = lane & 15, fq = lane >> 4;
    const int K = g.K, nt = K / BK;
    unsigned voffA[2], voffB[2];
#pragma unroll
    for (int i = 0; i < 2; ++i) { int R, C; stage_rc(tid * 16 + i * 8192, R, C); const int Rb = Epi::PERM ? ((R & ~31) + perm32(R & 31)) : R;
        voffA[i] = (unsigned)(R * K + C) * 2u; voffB[i] = (unsigned)(Rb * K + C) * 2u; }
    const size_t kstep = (size_t)(BK * 2);
    const size_t hstep = (size_t)HALF * K * 2;
    const size_t tstep = 2 * hstep;
    const unsigned ldsw = (unsigned)wid * 1024u;
    const int aoff = lds_byte(wr * 64 + fr, fq * 8), boff = lds_byte(wc * 32 + fr, fq * 8);
#define PG8_SA(b, h) (((b) * 2 + (h)) * HTB)
#define PG8_SB(b, h) ((4 + (b) * 2 + (h)) * HTB)
#define PG8_STAGE(bufoff, gbase, voff) do { _Pragma("unroll") for (int _i = 0; _i < 2; ++_i) \
        __builtin_amdgcn_global_load_lds((const unsigned*)((const char*)(gbase) + (voff)[_i]), (PG8_LAS unsigned*)(lds + (bufoff) + ldsw + _i * 8192), 16, 0, 0); } while (0)
#define PG8_LDA(dst, b, h) do { _Pragma("unroll") for (int m = 0; m < 4; ++m) _Pragma("unroll") for (int k = 0; k < 2; ++k) dst[m][k] = *(const PG8_LAS bf16x8*)(lds + PG8_SA(b, h) + aoff + m * 2048 + k * 1024); } while (0)
#define PG8_LDB(dst, b, h) do { _Pragma("unroll") for (int n = 0; n < 2; ++n) _Pragma("unroll") for (int k = 0; k < 2; ++k) dst[n][k] = *(const PG8_LAS bf16x8*)(lds + PG8_SB(b, h) + boff + n * 2048 + k * 1024); } while (0)
#define PG8_MMA(ai, bj, At, Bt) do { __builtin_amdgcn_s_setprio(1); _Pragma("unroll") for (int m = 0; m < 4; ++m) _Pragma("unroll") for (int n = 0; n < 2; ++n) _Pragma("unroll") for (int k = 0; k < 2; ++k) \
        acc[ai][bj][m][n] = __builtin_amdgcn_mfma_f32_16x16x32_bf16(Bt[n][k], At[m][k], acc[ai][bj][m][n], 0, 0, 0); __builtin_amdgcn_s_setprio(0); } while (0)
#define PG8_WAIT_V(n) asm volatile("s_waitcnt vmcnt(" #n ")" ::: "memory")
#define PG8_WAIT_L(n) asm volatile("s_waitcnt lgkmcnt(" #n ")" ::: "memory")
#define PG8_BAR __builtin_amdgcn_s_barrier()
#define PG8_SCHED __builtin_amdgcn_sched_barrier(0)
    Unit cur, nxt; int ui = 0;
    if (!S.next(0, cur)) return;
    f32x4 acc[2][2][4][2];
#pragma unroll
    for (int a = 0; a < 2; ++a)
#pragma unroll
        for (int b = 0; b < 2; ++b)
#pragma unroll
            for (int m = 0; m < 4; ++m)
#pragma unroll
                for (int n = 0; n < 2; ++n) acc[a][b][m][n] = (f32x4){0.f, 0.f, 0.f, 0.f};
    bf16x8 At[4][2], B0[2][2], B1[2][2];
    const char* cA = (const char*)(g.A + cur.seg * g.segA) + (size_t)cur.pm * tstep; const char* cB = (const char*)(g.Bt + cur.seg * g.segB) + (size_t)cur.pn * tstep;
    if constexpr (SP2) {
        PG8_STAGE(PG8_SB(0, 0), cB, voffB); PG8_STAGE(PG8_SB(0, 1), cB + hstep, voffB); PG8_STAGE(PG8_SA(0, 0), cA, voffA); PG8_STAGE(PG8_SA(0, 1), cA + hstep, voffA);
        if (wr == 1) PG8_BAR;
        PG8_WAIT_V(2); PG8_BAR;
        PG8_STAGE(PG8_SB(1, 0), cB + kstep, voffB); PG8_STAGE(PG8_SA(1, 0), cA + kstep, voffA); PG8_STAGE(PG8_SB(1, 1), cB + hstep + kstep, voffB);
        PG8_WAIT_V(6); PG8_BAR;
    } else {
        PG8_STAGE(PG8_SB(0, 0), cB, voffB); PG8_STAGE(PG8_SA(0, 0), cA, voffA); PG8_STAGE(PG8_SB(0, 1), cB + hstep, voffB); PG8_STAGE(PG8_SA(0, 1), cA + hstep, voffA);
        if (wr == 1) PG8_BAR;
        PG8_WAIT_V(4); PG8_BAR;
        PG8_STAGE(PG8_SB(1, 0), cB + kstep, voffB); PG8_STAGE(PG8_SA(1, 0), cA + kstep, voffA); PG8_STAGE(PG8_SB(1, 1), cB + hstep + kstep, voffB);
        PG8_WAIT_V(6); PG8_BAR;
    }
    for (;;) {
        const bool has_next = S.next(ui + 1, nxt);
        const char* nA = has_next ? (const char*)(g.A + nxt.seg * g.segA) + (size_t)nxt.pm * tstep : cA; const char* nB = has_next ? (const char*)(g.Bt + nxt.seg * g.segB) + (size_t)nxt.pn * tstep : cB;
        for (int t = 0; t < nt; t += 2) {
            const bool last = (t == nt - 2);
            const char* a1 = cA + (size_t)(t + 1) * kstep;
            const char* a2 = last ? nA : cA + (size_t)(t + 2) * kstep; const char* b2 = last ? nB : cB + (size_t)(t + 2) * kstep;
            const char* a3 = a2 + kstep; const char* b3 = b2 + kstep;
            if constexpr (SP2) {
            PG8_LDB(B0, 0, 0); PG8_LDB(B1, 0, 1); PG8_SCHED; PG8_LDA(At, 0, 0); PG8_STAGE(PG8_SA(1, 1), a1 + hstep, voffA);
            PG8_WAIT_V(8); PG8_WAIT_L(0); PG8_BAR; PG8_MMA(0, 0, At, B0); PG8_MMA(0, 1, At, B1); PG8_BAR; PG8_SCHED;
            PG8_LDA(At, 0, 1); PG8_STAGE(PG8_SB(0, 0), b2, voffB); PG8_STAGE(PG8_SB(0, 1), b2 + hstep, voffB); PG8_STAGE(PG8_SA(0, 0), a2, voffA);
            PG8_WAIT_V(8); PG8_WAIT_L(0); PG8_BAR; PG8_MMA(1, 0, At, B0); PG8_MMA(1, 1, At, B1); PG8_BAR; PG8_SCHED;
            PG8_LDB(B0, 1, 0); PG8_LDB(B1, 1, 1); PG8_SCHED; PG8_LDA(At, 1, 0); PG8_STAGE(PG8_SA(0, 1), a2 + hstep, voffA);
            PG8_WAIT_V(8); PG8_WAIT_L(0); PG8_BAR; PG8_MMA(0, 0, At, B0); PG8_MMA(0, 1, At, B1); PG8_BAR; PG8_SCHED;
            PG8_LDA(At, 1, 1); PG8_STAGE(PG8_SB(1, 0), b3, voffB); PG8_STAGE(PG8_SB(1, 1), b3 + hstep, voffB); PG8_STAGE(PG8_SA(1, 0), a3, voffA);
            PG8_WAIT_V(8); PG8_WAIT_L(0); PG8_BAR; PG8_MMA(1, 0, At, B0); PG8_MMA(1, 1, At, B1); PG8_BAR; PG8_SCHED;
            } else {
            PG8_LDB(B0, 0, 0); PG8_SCHED; PG8_LDA(At, 0, 0); PG8_STAGE(PG8_SA(1, 1), a1 + hstep, voffA);
            PG8_WAIT_L(8); PG8_BAR; PG8_WAIT_L(0); PG8_MMA(0, 0, At, B0); PG8_BAR; PG8_SCHED;
            PG8_LDB(B1, 0, 1); PG8_STAGE(PG8_SB(0, 0), b2, voffB);
            PG8_BAR; PG8_WAIT_L(0); PG8_MMA(0, 1, At, B1); PG8_BAR;
            PG8_LDA(At, 0, 1); PG8_STAGE(PG8_SA(0, 0), a2, voffA);
            PG8_BAR; PG8_WAIT_L(0); PG8_MMA(1, 0, At, B0); PG8_BAR; PG8_SCHED;
            PG8_STAGE(PG8_SB(0, 1), b2 + hstep, voffB);
            PG8_WAIT_V(6); PG8_BAR; PG8_MMA(1, 1, At, B1); PG8_BAR;
            PG8_LDB(B0, 1, 0); PG8_SCHED; PG8_LDA(At, 1, 0); PG8_STAGE(PG8_SA(0, 1), a2 + hstep, voffA);
            PG8_WAIT_L(8); PG8_BAR; PG8_WAIT_L(0); PG8_MMA(0, 0, At, B0); PG8_BAR; PG8_SCHED;
            PG8_LDB(B1, 1, 1); PG8_STAGE(PG8_SB(1, 0), b3, voffB);
            PG8_BAR; PG8_WAIT_L(0); PG8_MMA(0, 1, At, B1); PG8_BAR;
            PG8_LDA(At, 1, 1); PG8_STAGE(PG8_SA(1, 0), a3, voffA);
            PG8_BAR; PG8_WAIT_L(0); PG8_MMA(1, 0, At, B0); PG8_BAR; PG8_SCHED;
            PG8_STAGE(PG8_SB(1, 1), b3 + hstep, voffB);
            PG8_WAIT_V(6); PG8_BAR; PG8_MMA(1, 1, At, B1); PG8_BAR;
            }
        }
        if constexpr (ALIGN_EPI) { if (wr == 0) PG8_BAR; }
        E(acc, cur, wr, wc, fr, fq);
        if (!has_next) break;
#pragma unroll
        for (int a = 0; a < 2; ++a)
#pragma unroll
            for (int b = 0; b < 2; ++b)
#pragma unroll
                for (int m = 0; m < 4; ++m)
#pragma unroll
                    for (int n = 0; n < 2; ++n) acc[a][b][m][n] = (f32x4){0.f, 0.f, 0.f, 0.f};
        cur = nxt; cA = nA; cB = nB; ++ui;
        if constexpr (ALIGN_EPI) { if (wr == 1) PG8_BAR; }
    }
    PG8_WAIT_V(0);
    if constexpr (!ALIGN_EPI) { if (wr == 0) PG8_BAR; }
    PG8_BAR;
#undef PG8_SA
#undef PG8_SB
#undef PG8_STAGE
#undef PG8_LDA
#undef PG8_LDB
#undef PG8_MMA
#undef PG8_WAIT_V
#undef PG8_WAIT_L
#undef PG8_BAR
#undef PG8_SCHED
}

typedef f32x4 Acc[2][2][4][2];

__device__ __forceinline__ u32x4 pack8(const f32x4 a, const f32x4 b) {
    u32x4 w; w.x = cvt_pk_bf16(a[0], a[1]); w.y = cvt_pk_bf16(a[2], a[3]); w.z = cvt_pk_bf16(b[0], b[1]); w.w = cvt_pk_bf16(b[2], b[3]); return w;
}

struct EpiSwiGLU {
    static constexpr bool PERM = true;
    bf16_t* H;
    __device__ __forceinline__ void operator()(const Acc& acc, const Unit& u, int wr, int wc, int fr, int fq) const {
        const int row0 = u.pm * BM + wr * 64 + fr, col0 = u.pn * HALF + wc * 32 + 8 * fq;
#pragma unroll
        for (int ai = 0; ai < 2; ++ai)
#pragma unroll
            for (int m = 0; m < 4; ++m) {
                bf16_t* rowp = H + (size_t)(row0 + ai * HALF + m * 16) * DFF + col0;
                f32x4 h0, h1;
#pragma unroll
                for (int j = 0; j < 4; ++j) { h0[j] = siluf_(acc[ai][0][m][0][j]) * acc[ai][1][m][0][j]; h1[j] = siluf_(acc[ai][0][m][1][j]) * acc[ai][1][m][1][j]; }
                *(u32x4*)rowp = pack8(h0, h1);
                __builtin_amdgcn_sched_barrier(0);
            }
    }
};

struct EpiResid {
    static constexpr bool PERM = false;
    const float* in0; const float* in1; float* out; const float* gate; float coef;
    __device__ __forceinline__ void operator()(const Acc& acc, const Unit& u, int wr, int wc, int fr, int fq) const {
        const int v = u.pm < 32 ? 0 : 1 + ((u.pm - 32) >> 4);
        const float* gv = gate + (size_t)v * MODW;
        const float* in = u.pm < 32 ? in0 : in1;
        const int col0 = u.pn * BM + wc * 32 + 4 * fq;
        f32x4 g[2][2];
#pragma unroll
        for (int bj = 0; bj < 2; ++bj)
#pragma unroll
            for (int n = 0; n < 2; ++n) g[bj][n] = *(const f32x4*)(gv + col0 + bj * HALF + n * 16) * coef;
#pragma unroll
        for (int ai = 0; ai < 2; ++ai) {
            f32x4 x[4][2][2];
#pragma unroll
            for (int m = 0; m < 4; ++m) {
                const size_t off = (size_t)(u.pm * BM + ai * HALF + wr * 64 + m * 16 + fr) * DM + col0;
#pragma unroll
                for (int bj = 0; bj < 2; ++bj)
#pragma unroll
                    for (int n = 0; n < 2; ++n) x[m][bj][n] = *(const f32x4*)(in + off + bj * HALF + n * 16);
            }
            __builtin_amdgcn_sched_barrier(0);
#pragma unroll
            for (int m = 0; m < 4; ++m) {
                const size_t off = (size_t)(u.pm * BM + ai * HALF + wr * 64 + m * 16 + fr) * DM + col0;
#pragma unroll
                for (int bj = 0; bj < 2; ++bj)
#pragma unroll
                    for (int n = 0; n < 2; ++n) *(f32x4*)(out + off + bj * HALF + n * 16) = x[m][bj][n] + g[bj][n] * acc[ai][bj][m][n];
            }
            __builtin_amdgcn_sched_barrier(0);
        }
    }
};

struct EpiWin {
    static constexpr bool PERM = true;
    bf16_t *GLU, *CH, *BG, *Q, *Kb, *Vb; const float *qg, *kg; float *newk, *newv; int layer;
    __device__ __forceinline__ void operator()(const Acc& acc, const Unit& u, int wr, int wc, int fr, int fq) const {
        const int row0 = u.pm * BM + wr * 64 + fr, cw = wc * 32 + 8 * fq, pn = u.pn;
        if (pn < 8) {
            bf16_t* O = (pn < 4 ? GLU : CH); const int col0 = (pn & 3) * HALF + cw;
#pragma unroll
            for (int ai = 0; ai < 2; ++ai)
#pragma unroll
                for (int m = 0; m < 4; ++m) {
                    f32x4 h0, h1;
                    if (pn < 4) {
#pragma unroll
                        for (int j = 0; j < 4; ++j) { h0[j] = acc[ai][0][m][0][j] * sigmoidf_(acc[ai][1][m][0][j]); h1[j] = acc[ai][0][m][1][j] * sigmoidf_(acc[ai][1][m][1][j]); }
                    } else { h0 = acc[ai][0][m][0] * acc[ai][1][m][0]; h1 = acc[ai][0][m][1] * acc[ai][1][m][1]; }
                    *(u32x4*)(O + (size_t)(row0 + ai * HALF + m * 16) * 512 + col0) = pack8(h0, h1);
                    __builtin_amdgcn_sched_barrier(0);
                }
        } else if (pn < 10 || pn >= 14) {
            bf16_t* O = (pn < 10 ? BG : Vb); const int colt = (pn < 10 ? pn - 8 : pn - 14) * BM + cw;
            const bool wnew = (pn >= 14) && (u.pm < 32);
#pragma unroll
            for (int ai = 0; ai < 2; ++ai)
#pragma unroll
                for (int m = 0; m < 4; ++m) {
                    const int row = row0 + ai * HALF + m * 16;
#pragma unroll
                    for (int bj = 0; bj < 2; ++bj) {
                        *(u32x4*)(O + (size_t)row * 512 + colt + bj * HALF) = pack8(acc[ai][bj][m][0], acc[ai][bj][m][1]);
                        if (wnew) { float* p = newv + ((size_t)(u.pm * 2 + layer) * 256 + (row - u.pm * BM)) * 512 + colt + bj * HALF;
                            *(f32x4*)p = acc[ai][bj][m][0]; *(f32x4*)(p + 4) = acc[ai][bj][m][1]; }
                    }
                    __builtin_amdgcn_sched_barrier(0);
                }
        } else {
            const bool isk = pn >= 12; bf16_t* O = isk ? Kb : Q; const float* gn = isk ? kg : qg;
            const int head = 4 * ((pn - 10) & 1) + wc; const bool wnew = isk && (u.pm < 32);
            f32x4 gv[2][2];
#pragma unroll
            for (int bj = 0; bj < 2; ++bj)
#pragma unroll
                for (int n = 0; n < 2; ++n) gv[bj][n] = *(const f32x4*)(gn + 32 * bj + 8 * fq + 4 * n);
#pragma unroll
            for (int ai = 0; ai < 2; ++ai)
#pragma unroll
                for (int m = 0; m < 4; ++m) {
                    const int row = row0 + ai * HALF + m * 16;
                    float ss = 0.f;
#pragma unroll
                    for (int bj = 0; bj < 2; ++bj)
#pragma unroll
                        for (int n = 0; n < 2; ++n) { const f32x4 x = acc[ai][bj][m][n]; ss += (x[0] * x[0] + x[1] * x[1]) + (x[2] * x[2] + x[3] * x[3]); }
                    ss += __shfl_xor(ss, 16); ss += __shfl_xor(ss, 32);
                    const float rinv = __builtin_amdgcn_rsqf(ss * (1.f / 64.f) + EPS);
#pragma unroll
                    for (int bj = 0; bj < 2; ++bj) {
                        const f32x4 y0 = acc[ai][bj][m][0] * rinv * gv[bj][0], y1 = acc[ai][bj][m][1] * rinv * gv[bj][1];
                        const int col = head * 64 + 32 * bj + 8 * fq;
                        *(u32x4*)(O + (size_t)row * 512 + col) = pack8(y0, y1);
                        if (wnew) { float* p = newk + ((size_t)(u.pm * 2 + layer) * 256 + (row - u.pm * BM)) * 512 + col; *(f32x4*)p = y0; *(f32x4*)(p + 4) = y1; }
                    }
                    __builtin_amdgcn_sched_barrier(0);
                }
        }
    }
};

struct EpiGates {
    static constexpr bool PERM = true;
    bf16_t* GS;
    __device__ __forceinline__ void operator()(const Acc& acc, const Unit& u, int wr, int wc, int fr, int fq) const {
        const int gi = u.pn >> 2; const int bi = gi == 0 ? 2 : gi - 1; bf16_t* O = GS + (size_t)bi * GS_STRIDE;
        const int row0 = u.pm * BM + wr * 64 + fr, col0 = (u.pn & 3) * BM + wc * 32 + 8 * fq;
#pragma unroll
        for (int ai = 0; ai < 2; ++ai)
#pragma unroll
            for (int m = 0; m < 4; ++m)
#pragma unroll
                for (int bj = 0; bj < 2; ++bj) {
                    f32x4 h0, h1;
#pragma unroll
                    for (int j = 0; j < 4; ++j) { h0[j] = sigmoidf_(acc[ai][bj][m][0][j]); h1[j] = sigmoidf_(acc[ai][bj][m][1][j]); }
                    *(u32x4*)(O + (size_t)(row0 + ai * HALF + m * 16) * DM + col0 + bj * HALF) = pack8(h0, h1);
                    __builtin_amdgcn_sched_barrier(0);
                }
    }
};

struct EpiM {
    static constexpr bool PERM = true;
    const bf16_t* GS; bf16_t* Mo;
    __device__ __forceinline__ void operator()(const Acc& acc, const Unit& u, int wr, int wc, int fr, int fq) const {
        const bf16_t* Gs = GS + (size_t)u.seg * GS_STRIDE;
        const int row0 = u.pm * BM + wr * 64 + fr, col0 = u.pn * BM + wc * 32 + 8 * fq;
#pragma unroll
        for (int ai = 0; ai < 2; ++ai) {
            u32x4 gw[4][2], mw[4][2];
#pragma unroll
            for (int m = 0; m < 4; ++m)
#pragma unroll
                for (int bj = 0; bj < 2; ++bj) {
                    const size_t off = (size_t)(row0 + ai * HALF + m * 16) * DM + col0 + bj * HALF;
                    gw[m][bj] = *(const u32x4*)(Gs + off);
                    mw[m][bj] = (u32x4){0u, 0u, 0u, 0u};
                    if (u.seg != 0) mw[m][bj] = *(const u32x4*)(Mo + off);
                }
            __builtin_amdgcn_sched_barrier(0);
#pragma unroll
            for (int m = 0; m < 4; ++m)
#pragma unroll
                for (int bj = 0; bj < 2; ++bj) {
                    const size_t off = (size_t)(row0 + ai * HALF + m * 16) * DM + col0 + bj * HALF;
                    const u32x4 g4 = gw[m][bj], m4 = mw[m][bj];
                    f32x4 h0, h1;
                    h0[0] = bflo(g4.x) * acc[ai][bj][m][0][0] + bflo(m4.x); h0[1] = bfhi(g4.x) * acc[ai][bj][m][0][1] + bfhi(m4.x);
                    h0[2] = bflo(g4.y) * acc[ai][bj][m][0][2] + bflo(m4.y); h0[3] = bfhi(g4.y) * acc[ai][bj][m][0][3] + bfhi(m4.y);
                    h1[0] = bflo(g4.z) * acc[ai][bj][m][1][0] + bflo(m4.z); h1[1] = bfhi(g4.z) * acc[ai][bj][m][1][1] + bfhi(m4.z);
                    h1[2] = bflo(g4.w) * acc[ai][bj][m][1][2] + bflo(m4.w); h1[3] = bfhi(g4.w) * acc[ai][bj][m][1][3] + bfhi(m4.w);
                    *(u32x4*)(Mo + off) = pack8(h0, h1);
                }
            __builtin_amdgcn_sched_barrier(0);
        }
    }
};
}

struct Args { const float* in[32]; };
__device__ __forceinline__ const float* inp(const Args& a, int i) { return a.in[i + opaque_zero()]; }

__device__ __forceinline__ void cvt_block(const float* W, int N, int K, int k0, int n0, bf16_t* WT, int dst_row0, float* scr, int lane) {
#pragma unroll 8
    for (int i = 0; i < 32; ++i) { const int kk = 2 * i + (lane >> 5); scr[kk * 33 + (lane & 31)] = W[(size_t)(k0 + kk) * N + n0 + (lane & 31)]; }
    LDS_WAIT();
    const int c = lane & 7;
#pragma unroll
    for (int j = 0; j < 4; ++j) { const int n = (lane >> 3) + 8 * j; const float* s = scr + (8 * c) * 33 + n;
        u32x4 o; o.x = pk2(s[0 * 33], s[1 * 33]); o.y = pk2(s[2 * 33], s[3 * 33]); o.z = pk2(s[4 * 33], s[5 * 33]); o.w = pk2(s[6 * 33], s[7 * 33]);
        *(u32x4*)(WT + (size_t)(dst_row0 + n) * K + k0 + 8 * c) = o; }
    LDS_WAIT();
}
__device__ __forceinline__ int win_dst(int n) {
    if (n < 512) return 256 * (n >> 7) + (n & 127);
    if (n < 1024) { const int s = n - 512; return 256 * (s >> 7) + 128 + (s & 127); }
    if (n < 1536) return 2048 + (n - 1024);
    if (n < 2048) { const int s = n - 1536; return 1024 + 256 * (s >> 7) + (s & 127); }
    if (n < 2560) { const int s = n - 2048; return 1024 + 256 * (s >> 7) + 128 + (s & 127); }
    if (n < 3584) { const int base = n < 3072 ? 2560 : 3072; const int s = n - base, head = s >> 6, dim = s & 63;
        return base + 256 * (head >> 2) + 128 * (dim >> 5) + 32 * (head & 3) + (dim & 31); }
    return n;
}
__device__ __forceinline__ void convert_weights(const Args& a, int l, unsigned char* lds, int gw, int ngw, int wave, int lane) {
    float* scr = (float*)(lds + wave * 8448);
    unsigned char* ws = (unsigned char*)inp(a, 31);
    constexpr int I_GU = 16 * 88, I_D = 44 * 32, I_IN = 16 * 224, I_O = 8 * 32, I_M = 16 * 32;
    constexpr int NIT = 6 * I_GU + I_IN + 3 * I_O + I_M;
    static_assert(I_GU == I_D, "");
    for (int it = gw; it < NIT; it += ngw) {
        int r = it;
        if (r < 6 * I_GU) {
            const int which = r / I_GU; r -= which * I_GU;
            const int ff = which / 3, kind = which % 3;
            if (kind < 2) {
                const float* W = inp(a, (ff ? 27 : 9) + kind) + (size_t)l * DM * DFF;
                const int kb = r / 88, nb = r % 88, n0 = nb * 32;
                cvt_block(W, DFF, DM, kb * 64, n0, (bf16_t*)(ws + (ff ? W_GU2 : W_GU1)), 256 * (n0 >> 7) + 128 * kind + (n0 & 127), scr, lane);
            } else {
                const float* W = inp(a, ff ? 29 : 11) + (size_t)l * DFF * DM;
                const int kb = r / 32, nb = r % 32;
                cvt_block(W, DM, DFF, kb * 64, nb * 32, (bf16_t*)(ws + (ff ? W_D2 : W_D1)), nb * 32, scr, lane);
            }
            continue;
        }
        r -= 6 * I_GU;
        if (r < I_IN) { const int kb = r / 224, nb = r % 224; cvt_block(inp(a, 13) + (size_t)l * DM * NIN, NIN, DM, kb * 64, nb * 32, (bf16_t*)(ws + W_IN), win_dst(nb * 32), scr, lane); continue; }
        r -= I_IN;
        if (r < 3 * I_O) { const int which = r / I_O; r -= which * I_O; const int kb = r / 32, nb = r % 32;
            const float* W = inp(a, which == 0 ? 18 : (which == 1 ? 20 : 24)) + (size_t)l * 512 * DM;
            cvt_block(W, DM, 512, kb * 64, nb * 32, (bf16_t*)(ws + (which == 0 ? W_A : (which == 1 ? W_B : W_C))), nb * 32, scr, lane); continue; }
        r -= 3 * I_O;
        { const int kb = r / 32, nb = r % 32; cvt_block(inp(a, 25) + (size_t)l * DM * DM, DM, DM, kb * 64, nb * 32, (bf16_t*)(ws + W_M), nb * 32, scr, lane); }
    }
}

__device__ __forceinline__ void compute_mods(const Args& a, unsigned char* lds, int tid, int wave, int lane) {
    float* sT = (float*)lds;
    float* red = (float*)(lds + 49152);
    const float* c = inp(a, 4); const float* cctx = inp(a, 5);
    for (int k = tid; k < DM; k += NTHR) {
        sT[k * 12 + 0] = siluf_(cctx[k]);
#pragma unroll
        for (int v = 1; v < 9; ++v) sT[k * 12 + v] = siluf_(c[(v - 1) * DM + k]);
        sT[k * 12 + 9] = 0.f; sT[k * 12 + 10] = 0.f; sT[k * 12 + 11] = 0.f;
    }
    __syncthreads();
    float* mods = (float*)((unsigned char*)inp(a, 31) + WS_MODS);
    for (int unit = blockIdx.x; unit < 288; unit += gridDim.x) {
        const int l = unit / 144, cb = unit % 144, col = cb * 64 + lane;
        const float* W = inp(a, 6) + (size_t)l * DM * MODW + col;
        float acc[9];
#pragma unroll
        for (int v = 0; v < 9; ++v) acc[v] = 0.f;
#pragma unroll 8
        for (int kk = 0; kk < 128; ++kk) {
            const int k = wave * 128 + kk;
            const float w = W[(size_t)k * MODW];
            const f32x4 s0 = *(const f32x4*)(sT + k * 12), s1 = *(const f32x4*)(sT + k * 12 + 4), s2 = *(const f32x4*)(sT + k * 12 + 8);
            acc[0] += s0[0] * w; acc[1] += s0[1] * w; acc[2] += s0[2] * w; acc[3] += s0[3] * w;
            acc[4] += s1[0] * w; acc[5] += s1[1] * w; acc[6] += s1[2] * w; acc[7] += s1[3] * w; acc[8] += s2[0] * w;
        }
#pragma unroll
        for (int v = 0; v < 9; ++v) red[(wave * 9 + v) * 64 + lane] = acc[v];
        __syncthreads();
        for (int idx = tid; idx < 576; idx += NTHR) {
            const int v = idx >> 6, ln = idx & 63; float s = inp(a, 7)[(size_t)l * MODW + cb * 64 + ln];
#pragma unroll
            for (int w = 0; w < 8; ++w) s += red[(w * 9 + v) * 64 + ln];
            mods[((size_t)l * 9 + v) * MODW + cb * 64 + ln] = s;
        }
        __syncthreads();
    }
}

__device__ __forceinline__ void adaln_phase(const float* in0, const float* in1, const float* g, const float* modl, int ish, bf16_t* U, int gw, int ngw, int lane) {
    for (int row = gw; row < MTOK; row += ngw) {
        const float* xr = (row < NCTX ? in0 : in1) + (size_t)row * DM;
        const int v = row < NCTX ? 0 : 1 + ((row - NCTX) >> 12);
        const float* sh = modl + (size_t)v * MODW + ish * DM; const float* sc = sh + DM;
        f32x4 x[4]; float ss = 0.f;
#pragma unroll
        for (int j = 0; j < 4; ++j) { x[j] = *(const f32x4*)(xr + 256 * j + 4 * lane); ss += (x[j][0] * x[j][0] + x[j][1] * x[j][1]) + (x[j][2] * x[j][2] + x[j][3] * x[j][3]); }
        const float rinv = __builtin_amdgcn_rsqf(wave_sum(ss) * (1.f / DM) + EPS);
#pragma unroll
        for (int j = 0; j < 4; ++j) {
            const int c = 256 * j + 4 * lane;
            const f32x4 gg = *(const f32x4*)(g + c), s1 = *(const f32x4*)(sc + c), s0 = *(const f32x4*)(sh + c);
            const f32x4 y = x[j] * rinv * gg * (s1 + 1.f) + s0;
            u32x2 w; w.x = pk2(y[0], y[1]); w.y = pk2(y[2], y[3]);
            *(u32x2*)(U + (size_t)row * DM + c) = w;
        }
    }
}

namespace att {
constexpr int TK = 128, PITCH = 272, KS_OFF = 0, VS_OFF = TK * PITCH, RPB_OFF = 2 * TK * PITCH;
typedef short v4i16_t __attribute__((ext_vector_type(4)));
__device__ __forceinline__ s16x4 vtr(const LAS char* p) { return __builtin_bit_cast(s16x4, __builtin_amdgcn_ds_read_tr16_b64_v4i16((LAS v4i16_t*)p)); }

struct TileSrc { const bf16_t* k; const bf16_t* v; };

template <bool LOCAL>
__device__ __forceinline__ void tile_compute(const LAS char* ldsb, const bf16x8 (&qf)[2], f32x4 (&O)[4], float& mrun, float& lrun,
                                             int hl, int koff, int fr, int fq, int lane, const float* rpbrow, const int (&dci)[8], unsigned vmask) {
    constexpr int NMT = LOCAL ? 4 : 8;
#define ATT_KEYOFF(mt) (LOCAL ? (((mt) >> 1) * 64 + koff + 16 * ((mt) & 1)) : 16 * (mt))
    f32x4 s[NMT];
#pragma unroll
    for (int mt = 0; mt < NMT; ++mt) {
        s[mt] = (f32x4){0.f, 0.f, 0.f, 0.f};
#pragma unroll
        for (int ks = 0; ks < 2; ++ks) {
            const bf16x8 kf = *(const LAS bf16x8*)(ldsb + KS_OFF + (ATT_KEYOFF(mt) + fr) * PITCH + hl * 128 + ks * 64 + fq * 16);
            s[mt] = __builtin_amdgcn_mfma_f32_16x16x32_bf16(kf, qf[ks], s[mt], 0, 0, 0);
        }
    }
    float tmax = -1e30f;
#pragma unroll
    for (int mt = 0; mt < NMT; ++mt)
#pragma unroll
        for (int j = 0; j < 4; ++j) {
            float v = s[mt][j] * 0.125f;
            if (LOCAL) { v += rpbrow[(mt >> 1) * 32 + dci[(mt & 1) * 4 + j]]; if (!((vmask >> ((mt & 1) * 4 + j)) & 1u)) v = -1e30f; }
            s[mt][j] = v; tmax = fmaxf(tmax, v);
        }
    tmax = fmaxf(tmax, __shfl_xor(tmax, 16)); tmax = fmaxf(tmax, __shfl_xor(tmax, 32));
    const float mnew = fmaxf(mrun, tmax), alpha = __expf(mrun - mnew);
    float psum = 0.f;
#pragma unroll
    for (int mt = 0; mt < NMT; ++mt)
#pragma unroll
        for (int j = 0; j < 4; ++j) { const float p = __expf(s[mt][j] - mnew); s[mt][j] = p; psum += p; }
    lrun = lrun * alpha + psum; mrun = mnew;
#pragma unroll
    for (int dt = 0; dt < 4; ++dt) O[dt] = O[dt] * alpha;
    const int g = lane >> 4, q = (lane & 15) >> 2, p4 = lane & 3;
#pragma unroll
    for (int kk = 0; kk < NMT / 2; ++kk) {
        bf16x8 pb;
        { const u32x4 w = pg8::pack8(s[2 * kk], s[2 * kk + 1]); pb = __builtin_bit_cast(bf16x8, w); }
#pragma unroll
        for (int dt = 0; dt < 4; ++dt) {
            const LAS char* vb = ldsb + VS_OFF + hl * 128 + 32 * dt + 8 * p4;
            const s16x4 v0 = vtr(vb + (ATT_KEYOFF(2 * kk) + 4 * g + q) * PITCH);
            const s16x4 v1 = vtr(vb + (ATT_KEYOFF(2 * kk + 1) + 4 * g + q) * PITCH);
            bf16x8 vf; vf[0] = v0[0]; vf[1] = v0[1]; vf[2] = v0[2]; vf[3] = v0[3]; vf[4] = v1[0]; vf[5] = v1[1]; vf[6] = v1[2]; vf[7] = v1[3];
            O[dt] = __builtin_amdgcn_mfma_f32_16x16x32_bf16(vf, pb, O[dt], 0, 0, 0);
        }
    }
#undef ATT_KEYOFF
}

template <bool LATENT>
__device__ __forceinline__ void unit(unsigned char* lds, bf16_t* QO, const bf16_t* Kb, const bf16_t* Vb, const bf16_t* CK, const bf16_t* CV, const float* rpb_l,
                                     int qrow0  , int keyrow0  , int hp, int r  ,
                                     int tid, int wave, int lane) {
    const LAS char* ldsb = (const LAS char*)(LAS unsigned char*)lds;
    const int hl = wave >> 2, J = wave & 3, fr = lane & 15, fq = lane >> 4;
    const int rs = LATENT ? min(max(r - 4, 0), 56) : 0;
    constexpr int NT = LATENT ? 8 : 2;
    int dci[8]; unsigned vmask = 0u; int koff = 0;
    if (LATENT) {
        const int qc = 16 * J + fr, wstart = min(max(qc - 8, 0), 48);
        koff = min(max(16 * J - 8, 0), 32);
#pragma unroll
        for (int mt = 0; mt < 2; ++mt)
#pragma unroll
            for (int j = 0; j < 4; ++j) { const int kc = koff + 16 * mt + 4 * fq + j;
                dci[mt * 4 + j] = min(max(kc - qc, -15), 15) + 15;
                if (kc >= wstart && kc < wstart + 16) vmask |= 1u << (mt * 4 + j); }
        float* tb = (float*)(lds + RPB_OFF);
        for (int i = tid; i < 2 * 15 * 32; i += NTHR) { const int h2 = i / 480, rem = i % 480, dr = rem >> 5, dc = rem & 31;
            tb[i] = dc < 31 ? rpb_l[((2 * hp + h2) * 15 + dr) * 31 + dc] : 0.f; }
    } else {
#pragma unroll
        for (int i = 0; i < 8; ++i) dci[i] = 0;
    }
    bf16x8 qf[2];
    { const bf16_t* qp = QO + (size_t)(qrow0 + 16 * J + fr) * 512 + (2 * hp + hl) * 64 + 8 * fq;
      qf[0] = *(const bf16x8*)qp; qf[1] = *(const bf16x8*)(qp + 32); }
    f32x4 O[4];
#pragma unroll
    for (int dt = 0; dt < 4; ++dt) O[dt] = (f32x4){0.f, 0.f, 0.f, 0.f};
    float mrun = -1e30f, lrun = 0.f;
    const int key0 = tid >> 4, part = tid & 15;
    u32x4 kreg[4], vreg[4];
    auto tsrc = [&](int t) -> TileSrc {
        TileSrc s;
        if (LATENT) {
            if (t < 4) { s.k = CK + (size_t)(t * TK) * 512 + hp * 128; s.v = CV + (size_t)(t * TK) * 512 + hp * 128; }
            else { const size_t ro = (size_t)(keyrow0 + (rs + 2 * (t - 4)) * 64) * 512 + hp * 128; s.k = Kb + ro; s.v = Vb + ro; }
        } else { const size_t ro = (size_t)(keyrow0 + t * TK) * 512 + hp * 128; s.k = Kb + ro; s.v = Vb + ro; }
        return s;
    };
    { const TileSrc s0 = tsrc(0);
#pragma unroll
      for (int i = 0; i < 4; ++i) { const size_t o = (size_t)(key0 + 32 * i) * 512 + part * 8; kreg[i] = *(const u32x4*)(s0.k + o); vreg[i] = *(const u32x4*)(s0.v + o); } }
    for (int t = 0; t < NT; ++t) {
        __syncthreads();
#pragma unroll
        for (int i = 0; i < 4; ++i) { const int lo = (key0 + 32 * i) * PITCH + part * 16;
            *(u32x4*)(lds + KS_OFF + lo) = kreg[i]; *(u32x4*)(lds + VS_OFF + lo) = vreg[i]; }
        __syncthreads();
        if (t + 1 < NT) { const TileSrc s1 = tsrc(t + 1);
#pragma unroll
            for (int i = 0; i < 4; ++i) { const size_t o = (size_t)(key0 + 32 * i) * 512 + part * 8; kreg[i] = *(const u32x4*)(s1.k + o); vreg[i] = *(const u32x4*)(s1.v + o); } }
        if (LATENT && t >= 4) {
            const int dr = (rs + 2 * (t - 4)) - r + 7;
            const float* rpbrow = (const float*)(lds + RPB_OFF) + (hl * 15 + dr) * 32;
            tile_compute<true>(ldsb, qf, O, mrun, lrun, hl, koff, fr, fq, lane, rpbrow, dci, vmask);
        } else {
            tile_compute<false>(ldsb, qf, O, mrun, lrun, hl, 0, fr, fq, lane, nullptr, dci, 0u);
        }
    }
    lrun += __shfl_xor(lrun, 16); lrun += __shfl_xor(lrun, 32);
    const float linv = 1.f / lrun;
    bf16_t* op = QO + (size_t)(qrow0 + 16 * J + fr) * 512 + (2 * hp + hl) * 64 + 4 * fq;
#pragma unroll
    for (int dt = 0; dt < 4; ++dt) { u32x2 w; w.x = cvt_pk_bf16(O[dt][0] * linv, O[dt][1] * linv); w.y = cvt_pk_bf16(O[dt][2] * linv, O[dt][3] * linv); *(u32x2*)(op + 16 * dt) = w; }
    __syncthreads();
}
}

__device__ __forceinline__ void conva_unit(unsigned char* lds, const bf16_t* GLU, bf16_t* AOUT, const float* cw, const float* cb, const float* lg, const float* lb,
                                           int rowbase, int len, int t0, int tid, int wave, int lane) {
    bf16_t* in_s = (bf16_t*)lds;
    float* hs = (float*)(lds + 62 * 512 * 2);
    for (int idx = tid; idx < 62 * 64; idx += NTHR) {
        const int i = idx >> 6, ch = idx & 63, p = t0 - 15 + i;
        u32x4 v = (u32x4){0u, 0u, 0u, 0u};
        if (p >= 0 && p < len) v = *(const u32x4*)(GLU + (size_t)(rowbase + p) * 512 + ch * 8);
        *(u32x4*)(in_s + i * 512 + ch * 8) = v;
    }
    float w[31];
#pragma unroll
    for (int j = 0; j < 31; ++j) w[j] = cw[j * 512 + tid];
    const float bias = cb[tid];
    __syncthreads();
    float col[62];
#pragma unroll
    for (int i = 0; i < 62; ++i) col[i] = __uint_as_float((unsigned)in_s[i * 512 + tid] << 16);
#pragma unroll
    for (int tt = 0; tt < 32; ++tt) {
        float acc = bias;
#pragma unroll
        for (int j = 0; j < 31; ++j) acc += col[tt + j] * w[j];
        hs[tt * 512 + tid] = acc;
    }
    __syncthreads();
#pragma unroll
    for (int q = 0; q < 4; ++q) {
        const int tt = wave * 4 + q;
        const f32x4 a = *(const f32x4*)(hs + tt * 512 + lane * 8), b = *(const f32x4*)(hs + tt * 512 + lane * 8 + 4);
        const float mean = wave_sum((a[0] + a[1]) + (a[2] + a[3]) + (b[0] + b[1]) + (b[2] + b[3])) * (1.f / 512.f);
        const f32x4 da = a - mean, db = b - mean;
        const float var = wave_sum((da[0] * da[0] + da[1] * da[1]) + (da[2] * da[2] + da[3] * da[3]) + (db[0] * db[0] + db[1] * db[1]) + (db[2] * db[2] + db[3] * db[3])) * (1.f / 512.f);
        const float rstd = __builtin_amdgcn_rsqf(var + EPS);
        const f32x4 g0 = *(const f32x4*)(lg + lane * 8), g1 = *(const f32x4*)(lg + lane * 8 + 4), b0 = *(const f32x4*)(lb + lane * 8), b1 = *(const f32x4*)(lb + lane * 8 + 4);
        f32x4 y0 = da * rstd * g0 + b0, y1 = db * rstd * g1 + b1;
#pragma unroll
        for (int j = 0; j < 4; ++j) { y0[j] = siluf_(y0[j]); y1[j] = siluf_(y1[j]); }
        *(u32x4*)(AOUT + (size_t)(rowbase + t0 + tt) * 512 + lane * 8) = pg8::pack8(y0, y1);
    }
    __syncthreads();
}

__device__ __forceinline__ void convb_phase(bf16_t* BG, const bf16_t* CH, const float* w3, int gtid, int nthreads) {
    for (int idx = gtid; idx < MTOK * 64; idx += nthreads) {
        const int row = idx >> 6, ch = idx & 63;
        int pos, len; if (row < NCTX) { pos = row & 255; len = 256; } else { pos = (row - NCTX) & 4095; len = 4096; }
        const u32x4 z = (u32x4){0u, 0u, 0u, 0u};
        const u32x4 c1 = *(const u32x4*)(CH + (size_t)row * 512 + ch * 8);
        const u32x4 c0 = pos > 0 ? *(const u32x4*)(CH + (size_t)(row - 1) * 512 + ch * 8) : z;
        const u32x4 c2 = pos < len - 1 ? *(const u32x4*)(CH + (size_t)(row + 1) * 512 + ch * 8) : z;
        const u32x4 bg = *(const u32x4*)(BG + (size_t)row * 512 + ch * 8);
        f32x4 wa[3], wb[3];
#pragma unroll
        for (int j = 0; j < 3; ++j) { wa[j] = *(const f32x4*)(w3 + j * 512 + ch * 8); wb[j] = *(const f32x4*)(w3 + j * 512 + ch * 8 + 4); }
        f32x4 y0, y1;
#define CB_(o, k, W, c0w, c1w, c2w, bgw, F) o[k] = F(bgw) * (F(c0w) * W[0][k] + F(c1w) * W[1][k] + F(c2w) * W[2][k])
        CB_(y0, 0, wa, c0.x, c1.x, c2.x, bg.x, bflo); CB_(y0, 1, wa, c0.x, c1.x, c2.x, bg.x, bfhi);
        CB_(y0, 2, wa, c0.y, c1.y, c2.y, bg.y, bflo); CB_(y0, 3, wa, c0.y, c1.y, c2.y, bg.y, bfhi);
        CB_(y1, 0, wb, c0.z, c1.z, c2.z, bg.z, bflo); CB_(y1, 1, wb, c0.z, c1.z, c2.z, bg.z, bfhi);
        CB_(y1, 2, wb, c0.w, c1.w, c2.w, bg.w, bflo); CB_(y1, 3, wb, c0.w, c1.w, c2.w, bg.w, bfhi);
#undef CB_
        *(u32x4*)(BG + (size_t)row * 512 + ch * 8) = pg8::pack8(y0, y1);
    }
}

#ifndef PHASE_MASK
#define PHASE_MASK 0xFFFFF
#endif
#define PH_ON(n) ((PHASE_MASK >> (n)) & 1)
#ifndef LAST_PHASE
#define LAST_PHASE 99
#endif
#define PHX(n) if (l * 12 + (n) <= LAST_PHASE)

__global__ void __launch_bounds__(NTHR, 2) fwd_megakernel(Args a) {
    extern __shared__ __attribute__((aligned(16))) unsigned char lds[];
    cg::grid_group grid = cg::this_grid();
    const int G = gridDim.x, bx = blockIdx.x;
    PG8_LAS unsigned char* ldsg = (PG8_LAS unsigned char*)lds;
    unsigned bar_epoch = 0;
    grid.sync();
#define GSYNC() do { asm volatile("s_waitcnt vmcnt(0) lgkmcnt(0)" ::: "memory"); __syncthreads(); ++bar_epoch; \
        if (threadIdx.x == 0) { unsigned* ctr_ = (unsigned*)inp(a, 31); \
            __builtin_amdgcn_fence(__ATOMIC_RELEASE, "agent"); asm volatile("s_waitcnt vmcnt(0)" ::: "memory"); \
            __hip_atomic_fetch_add(ctr_, 1u, __ATOMIC_RELAXED, __HIP_MEMORY_SCOPE_AGENT); \
            const unsigned want_ = bar_epoch * gridDim.x; unsigned spins_ = 0; \
            while (__hip_atomic_load(ctr_, __ATOMIC_RELAXED, __HIP_MEMORY_SCOPE_AGENT) < want_ && ++spins_ < (1u << 24)) __builtin_amdgcn_s_sleep(2); \
            __builtin_amdgcn_fence(__ATOMIC_ACQUIRE, "agent"); asm volatile("s_waitcnt vmcnt(0)" ::: "memory"); } \
        __syncthreads(); } while (0)
#define TIDS const int tid = threadIdx.x + opaque_vzero(), lane = tid & 63, wave = __builtin_amdgcn_readfirstlane(tid >> 6); \
             const int gw = bx * NWAVES + wave, ngw = G * NWAVES, gtid = bx * NTHR + tid, nthreads = G * NTHR; (void)gw; (void)ngw; (void)gtid; (void)nthreads; (void)lane;
#define BASES const int z_ = opaque_zero(); unsigned char* ws = (unsigned char*)inp(a, 31); float* out = (float*)inp(a, 30); const int lp = l + z_; const int bxp = bx + z_, Gp = G + z_; (void)bxp; (void)Gp; \
              const float* modl = (const float*)(ws + WS_MODS) + (size_t)lp * 9 * MODW; (void)modl; (void)out;

    {
        TIDS
#if PH_ON(0)
        compute_mods(a, lds, tid, wave, lane);
#endif
        unsigned char* ws = (unsigned char*)inp(a, 31);
        bf16_t* CK = (bf16_t*)(ws + WS_CK); bf16_t* CV = (bf16_t*)(ws + WS_CV);
        for (int i = gtid; i < 2 * 524288; i += nthreads) {
            const int which = i >= 524288; const int j = which ? i - 524288 : i;
            const float* src = inp(a, which ? 3 : 2) + (size_t)j * 8; bf16_t* dst = (which ? CV : CK) + (size_t)j * 8;
            const f32x4 x0 = *(const f32x4*)src, x1 = *(const f32x4*)(src + 4);
            u32x4 w; w.x = pk2(x0[0], x0[1]); w.y = pk2(x0[2], x0[3]); w.z = pk2(x1[0], x1[1]); w.w = pk2(x1[2], x1[3]);
            *(u32x4*)dst = w;
        }
    }
    GSYNC();

    for (int l = 0; l < 2; ++l) {
        PHX(1) {
            TIDS BASES
#if PH_ON(1)
            convert_weights(a, lp, lds, gw, ngw, wave, lane);
#endif
#if PH_ON(2)
            const float* xin0 = lp == 0 ? inp(a, 0) : out;
            const float* xin1 = lp == 0 ? inp(a, 1) - (size_t)NCTX * DM : out;
            adaln_phase(xin0, xin1, inp(a, 8) + lp * DM, modl, 0, (bf16_t*)(ws + WS_U), gw, ngw, lane);
#endif
        }
        GSYNC();
#if PH_ON(3)
        PHX(2) { BASES
          pg8::Gemm g{(const bf16_t*)(ws + WS_U), (const bf16_t*)(ws + W_GU1), 0, 0, MTOK, 2 * DFF, DM}; pg8::Order S; S.init(MTOK, 2 * DFF, Gp, bxp, 1);
          pg8::EpiSwiGLU E{(bf16_t*)(ws + WS_H)}; pg8::gemm_phase<pg8::EpiSwiGLU, true, true>(ldsg, g, S, E); }
#endif
        GSYNC();
#if PH_ON(4)
        PHX(3) { BASES
          const float* xin0 = lp == 0 ? inp(a, 0) : out;
          const float* xin1 = lp == 0 ? inp(a, 1) - (size_t)NCTX * DM : out;
          pg8::Gemm g{(const bf16_t*)(ws + WS_H), (const bf16_t*)(ws + W_D1), 0, 0, MTOK, DM, DFF}; pg8::Order S; S.init(MTOK, DM, Gp, bxp, 1);
          pg8::EpiResid E{xin0, xin1, out, modl + 2 * DM, 0.5f}; pg8::gemm_phase<pg8::EpiResid, true, true>(ldsg, g, S, E); }
#endif
        GSYNC();
#if PH_ON(14)
        PHX(4) { TIDS BASES
          adaln_phase(out, out, inp(a, 12) + lp * DM, modl, 3, (bf16_t*)(ws + WS_U), gw, ngw, lane); }
#endif
        GSYNC();
#if PH_ON(5)
        PHX(5) { BASES
          float* newk = out + (size_t)MTOK * DM; float* newv = newk + (size_t)32 * 2 * 256 * 512;
          pg8::Gemm g{(const bf16_t*)(ws + WS_U), (const bf16_t*)(ws + W_IN), 0, 0, MTOK, 4096, DM}; pg8::Order S; S.init(MTOK, 4096, Gp, bxp, 1);
          pg8::EpiWin E{(bf16_t*)(ws + WS_GLU), (bf16_t*)(ws + WS_CH), (bf16_t*)(ws + WS_BG), (bf16_t*)(ws + WS_Q), (bf16_t*)(ws + WS_K), (bf16_t*)(ws + WS_V),
                        inp(a, 21) + lp * 64, inp(a, 22) + lp * 64, newk, newv, lp};
          pg8::gemm_phase<pg8::EpiWin, true, true>(ldsg, g, S, E); }
#endif
        GSYNC();
        PHX(6) {
            TIDS BASES
            bf16_t* Q = (bf16_t*)(ws + WS_Q); const bf16_t* Kb = (const bf16_t*)(ws + WS_K); const bf16_t* Vb = (const bf16_t*)(ws + WS_V);
#if PH_ON(11)
            {
            const bf16_t* CK = (const bf16_t*)(ws + WS_CK); const bf16_t* CV = (const bf16_t*)(ws + WS_CV);
            const float* rpb_l = inp(a, 23) + (size_t)lp * 8 * 15 * 31;
            for (int u = bxp; u < 2048; u += Gp) {
                const int b = u >> 8, hp = (u >> 6) & 3, r = u & 63;
                const size_t co = (size_t)((b * 2 + lp) * 512) * 512;
                att::unit<true>(lds, Q, Kb, Vb, CK + co, CV + co, rpb_l, NCTX + b * 4096 + r * 64, NCTX + b * 4096, hp, r, tid, wave, lane);
            }
            for (int u = bxp; u < 512; u += Gp) {
                const int b = u >> 4, hp = (u >> 2) & 3, qb = u & 3;
                att::unit<false>(lds, Q, Kb, Vb, nullptr, nullptr, nullptr, b * 256 + qb * 64, b * 256, hp, 0, tid, wave, lane);
            }
            }
#endif
#if PH_ON(12)
            {
            const float* cw = inp(a, 14) + (size_t)lp * 31 * 512; const float* cb = inp(a, 15) + lp * 512; const float* lg = inp(a, 16) + lp * 512; const float* lb = inp(a, 17) + lp * 512;
            for (int u = bxp; u < 1280; u += Gp) {
                int rowbase, len, t0;
                if (u < 256) { rowbase = (u >> 3) * 256; len = 256; t0 = (u & 7) * 32; }
                else { const int v = u - 256; rowbase = NCTX + (v >> 7) * 4096; len = 4096; t0 = (v & 127) * 32; }
                conva_unit(lds, (const bf16_t*)(ws + WS_GLU), (bf16_t*)(ws + WS_AOUT), cw, cb, lg, lb, rowbase, len, t0, tid, wave, lane);
            }
            }
#endif
#if PH_ON(13)
            convb_phase((bf16_t*)(ws + WS_BG), (const bf16_t*)(ws + WS_CH), inp(a, 19) + (size_t)lp * 3 * 512, gtid, nthreads);
#endif
        }
        GSYNC();
#if PH_ON(6)
        PHX(7) { BASES
          const bf16_t* Wg = (const bf16_t*)(ws + W_IN) + (size_t)4096 * DM;
          pg8::Gemm g{(const bf16_t*)(ws + WS_U), Wg, 0, 0, MTOK, 3072, DM}; pg8::Order S; S.init(MTOK, 3072, Gp, bxp, 1);
          pg8::EpiGates E{(bf16_t*)(ws + WS_GS)}; pg8::gemm_phase<pg8::EpiGates, true, true>(ldsg, g, S, E); }
#endif
        GSYNC();
#if PH_ON(7)
        PHX(8) { BASES
          pg8::Gemm g{(const bf16_t*)(ws + WS_BG), (const bf16_t*)(ws + W_B), BR_STRIDE, WO_STRIDE, MTOK, DM, 512}; pg8::Order S; S.init(MTOK, DM, Gp, bxp, 3);
          pg8::EpiM E{(const bf16_t*)(ws + WS_GS), (bf16_t*)(ws + WS_U)}; pg8::gemm_phase<pg8::EpiM, true, true>(ldsg, g, S, E); }
#endif
        GSYNC();
#if PH_ON(8)
        PHX(9) { BASES
          pg8::Gemm g{(const bf16_t*)(ws + WS_U), (const bf16_t*)(ws + W_M), 0, 0, MTOK, DM, DM}; pg8::Order S; S.init(MTOK, DM, Gp, bxp, 1);
          pg8::EpiResid E{out, out, out, modl + 5 * DM, 1.0f}; pg8::gemm_phase<pg8::EpiResid, true, true>(ldsg, g, S, E); }
#endif
        GSYNC();
#if PH_ON(14)
        PHX(10) { TIDS BASES
          adaln_phase(out, out, inp(a, 26) + lp * DM, modl, 6, (bf16_t*)(ws + WS_U), gw, ngw, lane); }
#endif
        GSYNC();
#if PH_ON(9)
        PHX(11) { BASES
          pg8::Gemm g{(const bf16_t*)(ws + WS_U), (const bf16_t*)(ws + W_GU2), 0, 0, MTOK, 2 * DFF, DM}; pg8::Order S; S.init(MTOK, 2 * DFF, Gp, bxp, 1);
          pg8::EpiSwiGLU E{(bf16_t*)(ws + WS_H)}; pg8::gemm_phase<pg8::EpiSwiGLU, true, true>(ldsg, g, S, E); }
#endif
        GSYNC();
#if PH_ON(10)
        PHX(12) { BASES
          pg8::Gemm g{(const bf16_t*)(ws + WS_H), (const bf16_t*)(ws + W_D2), 0, 0, MTOK, DM, DFF}; pg8::Order S; S.init(MTOK, DM, Gp, bxp, 1);
          pg8::EpiResid E{out, out, out, modl + 8 * DM, 0.5f}; pg8::gemm_phase<pg8::EpiResid, true, true>(ldsg, g, S, E); }
#endif
        if (l == 0) GSYNC();
    }
}

extern "C" void kernel_launch(void* const* d_in, const int* in_sizes, int n_in, void* d_out, int out_size, void* d_ws, size_t ws_size, hipStream_t stream) {
    static int grid = 0;
    if (grid == 0) {
        if (n_in != 30 || ws_size < WS_END) { fprintf(stderr, "kernel_launch: unexpected inputs (n_in %d, ws %zu)\n", n_in, ws_size); grid = -1; return; }
        int dev = 0, cus = 0, per_cu = 0;
        hipGetDevice(&dev);
        hipDeviceGetAttribute(&cus, hipDeviceAttributeMultiprocessorCount, dev);
        hipFuncSetAttribute((const void*)fwd_megakernel, hipFuncAttributeMaxDynamicSharedMemorySize, LDS_BYTES);
        hipOccupancyMaxActiveBlocksPerMultiprocessor(&per_cu, (const void*)fwd_megakernel, NTHR, LDS_BYTES);
        if (per_cu < 1) per_cu = 1;
        (void)hipGetLastError();
        grid = cus;
        if (grid > 256) grid = 256;
    }
    if (grid < 0) return;
    Args a{};
    for (int i = 0; i < 30; ++i) a.in[i] = (const float*)d_in[i];
    a.in[30] = (const float*)d_out; a.in[31] = (const float*)d_ws;
    (void)hipMemsetAsync(d_ws, 0, 256, stream);
    void* args[] = {&a};
    hipError_t e = hipLaunchCooperativeKernel((const void*)fwd_megakernel, dim3(grid), dim3(NTHR), args, LDS_BYTES, stream);
    if (e != hipSuccess) fprintf(stderr, "cooperative launch failed: %s (grid %d)\n", hipGetErrorString(e), grid);
}
```

```cpp
#include <hip/hip_runtime.h>
#include <hip/hip_cooperative_groups.h>
#include <cstdio>
#include <cstdint>
namespace cg = cooperative_groups;

#define LAS __attribute__((address_space(3)))
typedef unsigned short bf16_t;
typedef short bf16x8 __attribute__((ext_vector_type(8)));
typedef short s16x4 __attribute__((ext_vector_type(4)));
typedef float f32x4 __attribute__((ext_vector_type(4)));
typedef unsigned u32x4 __attribute__((ext_vector_type(4)));
typedef unsigned u32x2 __attribute__((ext_vector_type(2)));

constexpr int DM = 1024, NCTX = 8192, NLAT = 32768, MTOK = NCTX + NLAT;
constexpr int DFF = 2816, NIN = 7168, NMODV = 9, MODW = 9 * 1024;
constexpr int NWAVES = 8, NTHR = 512;
constexpr float EPS = 1e-6f;

constexpr size_t MiB = 1u << 20;
constexpr size_t WS_MODS = 1 * MiB;
constexpr size_t WS_W = 2 * MiB;
constexpr size_t W_GU1 = WS_W, W_D1 = W_GU1 + 11 * MiB, W_IN = W_D1 + 11 * MiB / 2, W_B = W_IN + 14 * MiB, W_C = W_B + MiB, W_A = W_C + MiB,
                 W_M = W_A + MiB, W_GU2 = W_M + 2 * MiB, W_D2 = W_GU2 + 11 * MiB;
constexpr size_t WS_U = 54 * MiB, WS_H = 134 * MiB;
constexpr size_t WS_BG = 134 * MiB, WS_Q = 174 * MiB, WS_AOUT = 214 * MiB, WS_GLU = 254 * MiB, WS_CH = 294 * MiB, WS_K = 334 * MiB, WS_V = 374 * MiB;
constexpr size_t WS_GS = 254 * MiB;
constexpr size_t GS_STRIDE = 80 * MiB / 2, BR_STRIDE = 40 * MiB / 2, WO_STRIDE = MiB / 2;
constexpr size_t WS_CK = 494 * MiB, WS_CV = 502 * MiB, WS_END = 510 * MiB;
static_assert(W_D2 + 11 * MiB / 2 <= WS_U, "weights fit");
constexpr int LDS_BYTES = 147456;

__device__ __forceinline__ unsigned f2bf(float f) { unsigned u = __builtin_bit_cast(unsigned, f); return (u + 0x7fffu + ((u >> 16) & 1u)) >> 16; }
__device__ __forceinline__ unsigned pk2(float lo, float hi) { return f2bf(lo) | (f2bf(hi) << 16); }
typedef float f32x2_t __attribute__((ext_vector_type(2))); typedef __bf16 bf16x2_t __attribute__((ext_vector_type(2)));
__device__ __forceinline__ unsigned cvt_pk_bf16(float lo, float hi) { f32x2_t v = {lo, hi}; bf16x2_t b = __builtin_convertvector(v, bf16x2_t); return __builtin_bit_cast(unsigned, b); }
__device__ __forceinline__ float bflo(unsigned w) { return __uint_as_float(w << 16); }
__device__ __forceinline__ float bfhi(unsigned w) { return __uint_as_float(w & 0xffff0000u); }
__device__ __forceinline__ float sigmoidf_(float x) { return __builtin_amdgcn_rcpf(1.f + __expf(-x)); }
__device__ __forceinline__ float siluf_(float x) { return x * sigmoidf_(x); }
__device__ __forceinline__ float wave_sum(float v) {
#pragma unroll
    for (int o = 1; o < 64; o <<= 1) v += __shfl_xor(v, o);
    return v;
}
__device__ __forceinline__ int opaque_zero() { int z; asm volatile("s_mov_b32 %0, 0" : "=s"(z)); return z; }
__device__ __forceinline__ int opaque_vzero() { int z; asm volatile("v_mov_b32 %0, 0" : "=v"(z)); return z; }
template <class T> __device__ __forceinline__ T* launder_ptr(T* p) { T* r; asm volatile("s_mov_b64 %0, %1" : "=s"(r) : "s"(p)); return r; }
#define LDS_WAIT() asm volatile("s_waitcnt lgkmcnt(0)" ::: "memory")

namespace pg8 {
#define PG8_LAS __attribute__((address_space(3)))
constexpr int BM = 256, BK = 64, HALF = 128, HTB = HALF * BK * 2, STAGE_BYTES = 8 * HTB, NXCD = 8, WGM = 8;
__device__ __forceinline__ int lds_byte(int r, int c) { const int st = (r >> 4) * 2 + (c >> 5), rr = r & 15, cc = c & 31, ob = rr * 64 + cc * 2; return st * 1024 + (ob ^ (((ob >> 9) & 1) << 5)); }
__device__ __forceinline__ void stage_rc(int b, int& R, int& C) { const int st = b / 1024, sb = b % 1024, swz = sb ^ (((sb >> 9) & 1) << 5); R = (st >> 1) * 16 + swz / 64; C = (st & 1) * 32 + (swz % 64) / 2; }
__device__ __forceinline__ int perm32(int rho) { const int n = rho >> 4, i = rho & 15; return 8 * (i >> 2) + 4 * n + (i & 3); }

struct Unit { int pm, pn, seg; };
struct Gemm { const bf16_t* A; const bf16_t* Bt; size_t segA, segB; int M, N, K; };

struct Order {
    int nM, nN, nwg, G, c, nseg;
    __device__ void init(int M, int N, int G_, int c_, int nseg_) { nM = M / BM; nN = N / BM; nwg = nM * nN; G = G_; c = c_; nseg = nseg_; }
    __device__ bool next(int i, Unit& u) const {
        const int tile = i / nseg, seg = i - tile * nseg;
        const long L = (long)tile * G + c; if (L >= nwg) return false;
        int wgid = (int)L; { const int q = nwg / NXCD, r = nwg % NXCD, xcd = wgid % NXCD, off = wgid / NXCD; wgid = (xcd < r ? xcd * (q + 1) : r * (q + 1) + (xcd - r) * q) + off; }
        const int nig = WGM * nN, gid = wgid / nig, fm = gid * WGM, gsz = (nM - fm) < WGM ? (nM - fm) : WGM;
        u.pm = fm + ((wgid % nig) % gsz); u.pn = (wgid % nig) / gsz; u.seg = seg; return true;
    }
};

template <class Epi, bool ALIGN_EPI, bool SP2>
__device__ __forceinline__ void gemm_phase(PG8_LAS unsigned char* lds, const Gemm g, const Order& S, const Epi& E) {
    const int tid = threadIdx.x + opaque_vzero(), wid = __builtin_amdgcn_readfirstlane(tid >> 6), lane = tid & 63, wr = wid >> 2, wc = wid & 3, fr = lane & 15, fq = lane >> 4;
    const int K = g.K, nt = K / BK;
    unsigned voffA[2], voffB[2];
#pragma unroll
    for (int i = 0; i < 2; ++i) { int R, C; stage_rc(tid * 16 + i * 8192, R, C); const int Rb = Epi::PERM ? ((R & ~31) + perm32(R & 31)) : R;
        voffA[i] = (unsigned)(R * K + C) * 2u; voffB[i] = (unsigned)(Rb * K + C) * 2u; }
    const size_t kstep = (size_t)(BK * 2);
    const size_t hstep = (size_t)HALF * K * 2;
    const size_t tstep = 2 * hstep;
    const unsigned ldsw = (unsigned)wid * 1024u;
    const int aoff = lds_byte(wr * 64 + fr, fq * 8), boff = lds_byte(wc * 32 + fr, fq * 8);
#define PG8_SA(b, h) (((b) * 2 + (h)) * HTB)
#define PG8_SB(b, h) ((4 + (b) * 2 + (h)) * HTB)
#define PG8_STAGE(bufoff, gbase, voff) do { _Pragma("unroll") for (int _i = 0; _i < 2; ++_i) \
        __builtin_amdgcn_global_load_lds((const unsigned*)((const char*)(gbase) + (voff)[_i]), (PG8_LAS unsigned*)(lds + (bufoff) + ldsw + _i * 8192), 16, 0, 0); } while (0)
#define PG8_LDA(dst, b, h) do { _Pragma("unroll") for (int m = 0; m < 4; ++m) _Pragma("unroll") for (int k = 0; k < 2; ++k) dst[m][k] = *(const PG8_LAS bf16x8*)(lds + PG8_SA(b, h) + aoff + m * 2048 + k * 1024); } while (0)
#define PG8_LDB(dst, b, h) do { _Pragma("unroll") for (int n = 0; n < 2; ++n) _Pragma("unroll") for (int k = 0; k < 2; ++k) dst[n][k] = *(const PG8_LAS bf16x8*)(lds + PG8_SB(b, h) + boff + n * 2048 + k * 1024); } while (0)
#define PG8_MMA(ai, bj, At, Bt) do { __builtin_amdgcn_s_setprio(1); _Pragma("unroll") for (int m = 0; m < 4; ++m) _Pragma("unroll") for (int n = 0; n < 2; ++n) _Pragma("unroll") for (int k = 0; k < 2; ++k) \
        acc[ai][bj][m][n] = __builtin_amdgcn_mfma_f32_16x16x32_bf16(Bt[n][k], At[m][k], acc[ai][bj][m][n], 0, 0, 0); __builtin_amdgcn_s_setprio(0); } while (0)
#define PG8_WAIT_V(n) asm volatile("s_waitcnt vmcnt(" #n ")" ::: "memory")
#define PG8_WAIT_L(n) asm volatile("s_waitcnt lgkmcnt(" #n ")" ::: "memory")
#define PG8_BAR __builtin_amdgcn_s_barrier()
#define PG8_SCHED __builtin_amdgcn_sched_barrier(0)
    Unit cur, nxt; int ui = 0;
    if (!S.next(0, cur)) return;
    f32x4 acc[2][2][4][2];
#pragma unroll
    for (int a = 0; a < 2; ++a)
#pragma unroll
        for (int b = 0; b < 2; ++b)
#pragma unroll
            for (int m = 0; m < 4; ++m)
#pragma unroll
                for (int n = 0; n < 2; ++n) acc[a][b][m][n] = (f32x4){0.f, 0.f, 0.f, 0.f};
    bf16x8 At[4][2], B0[2][2], B1[2][2];
    const char* cA = (const char*)(g.A + cur.seg * g.segA) + (size_t)cur.pm * tstep; const char* cB = (const char*)(g.Bt + cur.seg * g.segB) + (size_t)cur.pn * tstep;
    if constexpr (SP2) {
        PG8_STAGE(PG8_SB(0, 0), cB, voffB); PG8_STAGE(PG8_SB(0, 1), cB + hstep, voffB); PG8_STAGE(PG8_SA(0, 0), cA, voffA); PG8_STAGE(PG8_SA(0, 1), cA + hstep, voffA);
        if (wr == 1) PG8_BAR;
        PG8_WAIT_V(2); PG8_BAR;
        PG8_STAGE(PG8_SB(1, 0), cB + kstep, voffB); PG8_STAGE(PG8_SA(1, 0), cA + kstep, voffA); PG8_STAGE(PG8_SB(1, 1), cB + hstep + kstep, voffB);
        PG8_WAIT_V(6); PG8_BAR;
    } else {
        PG8_STAGE(PG8_SB(0, 0), cB, voffB); PG8_STAGE(PG8_SA(0, 0), cA, voffA); PG8_STAGE(PG8_SB(0, 1), cB + hstep, voffB); PG8_STAGE(PG8_SA(0, 1), cA + hstep, voffA);
        if (wr == 1) PG8_BAR;
        PG8_WAIT_V(4); PG8_BAR;
        PG8_STAGE(PG8_SB(1, 0), cB + kstep, voffB); PG8_STAGE(PG8_SA(1, 0), cA + kstep, voffA); PG8_STAGE(PG8_SB(1, 1), cB + hstep + kstep, voffB);
        PG8_WAIT_V(6); PG8_BAR;
    }
    for (;;) {
        const bool has_next = S.next(ui + 1, nxt);
        const char* nA = has_next ? (const char*)(g.A + nxt.seg * g.segA) + (size_t)nxt.pm * tstep : cA; const char* nB = has_next ? (const char*)(g.Bt + nxt.seg * g.segB) + (size_t)nxt.pn * tstep : cB;
        for (int t = 0; t < nt; t += 2) {
            const bool last = (t == nt - 2);
            const char* a1 = cA + (size_t)(t + 1) * kstep;
            const char* a2 = last ? nA : cA + (size_t)(t + 2) * kstep; const char* b2 = last ? nB : cB + (size_t)(t + 2) * kstep;
            const char* a3 = a2 + kstep; const char* b3 = b2 + kstep;
            if constexpr (SP2) {
            PG8_LDB(B0, 0, 0); PG8_LDB(B1, 0, 1); PG8_SCHED; PG8_LDA(At, 0, 0); PG8_STAGE(PG8_SA(1, 1), a1 + hstep, voffA);
            PG8_WAIT_V(8); PG8_WAIT_L(0); PG8_BAR; PG8_MMA(0, 0, At, B0); PG8_MMA(0, 1, At, B1); PG8_BAR; PG8_SCHED;
            PG8_LDA(At, 0, 1); PG8_STAGE(PG8_SB(0, 0), b2, voffB); PG8_STAGE(PG8_SB(0, 1), b2 + hstep, voffB); PG8_STAGE(PG8_SA(0, 0), a2, voffA);
            PG8_WAIT_V(8); PG8_WAIT_L(0); PG8_BAR; PG8_MMA(1, 0, At, B0); PG8_MMA(1, 1, At, B1); PG8_BAR; PG8_SCHED;
            PG8_LDB(B0, 1, 0); PG8_LDB(B1, 1, 1); PG8_SCHED; PG8_LDA(At, 1, 0); PG8_STAGE(PG8_SA(0, 1), a2 + hstep, voffA);
            PG8_WAIT_V(8); PG8_WAIT_L(0); PG8_BAR; PG8_MMA(0, 0, At, B0); PG8_MMA(0, 1, At, B1); PG8_BAR; PG8_SCHED;
            PG8_LDA(At, 1, 1); PG8_STAGE(PG8_SB(1, 0), b3, voffB); PG8_STAGE(PG8_SB(1, 1), b3 + hstep, voffB); PG8_STAGE(PG8_SA(1, 0), a3, voffA);
            PG8_WAIT_V(8); PG8_WAIT_L(0); PG8_BAR; PG8_MMA(1, 0, At, B0); PG8_MMA(1, 1, At, B1); PG8_BAR; PG8_SCHED;
            } else {
            PG8_LDB(B0, 0, 0); PG8_SCHED; PG8_LDA(At, 0, 0); PG8_STAGE(PG8_SA(1, 1), a1 + hstep, voffA);
            PG8_WAIT_L(8); PG8_BAR; PG8_WAIT_L(0); PG8_MMA(0, 0, At, B0); PG8_BAR; PG8_SCHED;
            PG8_LDB(B1, 0, 1); PG8_STAGE(PG8_SB(0, 0), b2, voffB);
            PG8_BAR; PG8_WAIT_L(0); PG8_MMA(0, 1, At, B1); PG8_BAR;
            PG8_LDA(At, 0, 1); PG8_STAGE(PG8_SA(0, 0), a2, voffA);
            PG8_BAR; PG8_WAIT_L(0); PG8_MMA(1, 0, At, B0); PG8_BAR; PG8_SCHED;
            PG8_STAGE(PG8_SB(0, 1), b2 + hstep, voffB);
            PG8_WAIT_V(6); PG8_BAR; PG8_MMA(1, 1, At, B1); PG8_BAR;
            PG8_LDB(B0, 1, 0); PG8_SCHED; PG8_LDA(At, 1, 0); PG8_STAGE(PG8_SA(0, 1), a2 + hstep, voffA);
            PG8_WAIT_L(8); PG8_BAR; PG8_WAIT_L(0); PG8_MMA(0, 0, At, B0); PG8_BAR; PG8_SCHED;
            PG8_LDB(B1, 1, 1); PG8_STAGE(PG8_SB(1, 0), b3, voffB);
            PG8_BAR; PG8_WAIT_L(0); PG8_MMA(0, 1, At, B1); PG8_BAR;
            PG8_LDA(At, 1, 1); PG8_STAGE(PG8_SA(1, 0), a3, voffA);
            PG8_BAR; PG8_WAIT_L(0); PG8_MMA(1, 0, At, B0); PG8_BAR; PG8_SCHED;
            PG8_STAGE(PG8_SB(1, 1), b3 + hstep, voffB);
            PG8_WAIT_V(6); PG8_BAR; PG8_MMA(1, 1, At, B1); PG8_BAR;
            }
        }
        if constexpr (ALIGN_EPI) { if (wr == 0) PG8_BAR; }
        E(acc, cur, wr, wc, fr, fq);
        if (!has_next) break;
#pragma unroll
        for (int a = 0; a < 2; ++a)
#pragma unroll
            for (int b = 0; b < 2; ++b)
#pragma unroll
                for (int m = 0; m < 4; ++m)
#pragma unroll
                    for (int n = 0; n < 2; ++n) acc[a][b][m][n] = (f32x4){0.f, 0.f, 0.f, 0.f};
        cur = nxt; cA = nA; cB = nB; ++ui;
        if constexpr (ALIGN_EPI) { if (wr == 1) PG8_BAR; }
    }
    PG8_WAIT_V(0);
    if constexpr (!ALIGN_EPI) { if (wr == 0) PG8_BAR; }
    PG8_BAR;
#undef PG8_SA
#undef PG8_SB
#undef PG8_STAGE
#undef PG8_LDA
#undef PG8_LDB
#undef PG8_MMA
#undef PG8_WAIT_V
#undef PG8_WAIT_L
#undef PG8_BAR
#undef PG8_SCHED
}

typedef f32x4 Acc[2][2][4][2];

__device__ __forceinline__ u32x4 pack8(const f32x4 a, const f32x4 b) {
    u32x4 w; w.x = cvt_pk_bf16(a[0], a[1]); w.y = cvt_pk_bf16(a[2], a[3]); w.z = cvt_pk_bf16(b[0], b[1]); w.w = cvt_pk_bf16(b[2], b[3]); return w;
}

struct EpiSwiGLU {
    static constexpr bool PERM = true;
    bf16_t* H;
    __device__ __forceinline__ void operator()(const Acc& acc, const Unit& u, int wr, int wc, int fr, int fq) const {
        const int row0 = u.pm * BM + wr * 64 + fr, col0 = u.pn * HALF + wc * 32 + 8 * fq;
#pragma unroll
        for (int ai = 0; ai < 2; ++ai)
#pragma unroll
            for (int m = 0; m < 4; ++m) {
                bf16_t* rowp = H + (size_t)(row0 + ai * HALF + m * 16) * DFF + col0;
                f32x4 h0, h1;
#pragma unroll
                for (int j = 0; j < 4; ++j) { h0[j] = siluf_(acc[ai][0][m][0][j]) * acc[ai][1][m][0][j]; h1[j] = siluf_(acc[ai][0][m][1][j]) * acc[ai][1][m][1][j]; }
                *(u32x4*)rowp = pack8(h0, h1);
                __builtin_amdgcn_sched_barrier(0);
            }
    }
};

struct EpiResid {
    static constexpr bool PERM = false;
    const float* in0; const float* in1; float* out; const float* gate; float coef;
    __device__ __forceinline__ void operator()(const Acc& acc, const Unit& u, int wr, int wc, int fr, int fq) const {
        const int v = u.pm < 32 ? 0 : 1 + ((u.pm - 32) >> 4);
        const float* gv = gate + (size_t)v * MODW;
        const float* in = u.pm < 32 ? in0 : in1;
        const int col0 = u.pn * BM + wc * 32 + 4 * fq;
        f32x4 g[2][2];
#pragma unroll
        for (int bj = 0; bj < 2; ++bj)
#pragma unroll
            for (int n = 0; n < 2; ++n) g[bj][n] = *(const f32x4*)(gv + col0 + bj * HALF + n * 16) * coef;
#pragma unroll
        for (int ai = 0; ai < 2; ++ai) {
            f32x4 x[4][2][2];
#pragma unroll
            for (int m = 0; m < 4; ++m) {
                const size_t off = (size_t)(u.pm * BM + ai * HALF + wr * 64 + m * 16 + fr) * DM + col0;
#pragma unroll
                for (int bj = 0; bj < 2; ++bj)
#pragma unroll
                    for (int n = 0; n < 2; ++n) x[m][bj][n] = *(const f32x4*)(in + off + bj * HALF + n * 16);
            }
            __builtin_amdgcn_sched_barrier(0);
#pragma unroll
            for (int m = 0; m < 4; ++m) {
                const size_t off = (size_t)(u.pm * BM + ai * HALF + wr * 64 + m * 16 + fr) * DM + col0;
#pragma unroll
                for (int bj = 0; bj < 2; ++bj)
#pragma unroll
                    for (int n = 0; n < 2; ++n) *(f32x4*)(out + off + bj * HALF + n * 16) = x[m][bj][n] + g[bj][n] * acc[ai][bj][m][n];
            }
            __builtin_amdgcn_sched_barrier(0);
        }
    }
};

struct EpiWin {
    static constexpr bool PERM = true;
    bf16_t *GLU, *CH, *BG, *Q, *Kb, *Vb; const float *qg, *kg; float *newk, *newv; int layer;
    __device__ __forceinline__ void operator()(const Acc& acc, const Unit& u, int wr, int wc, int fr, int fq) const {
        const int row0 = u.pm * BM + wr * 64 + fr, cw = wc * 32 + 8 * fq, pn = u.pn;
        if (pn < 8) {
            bf16_t* O = (pn < 4 ? GLU : CH); const int col0 = (pn & 3) * HALF + cw;
#pragma unroll
            for (int ai = 0; ai < 2; ++ai)
#pragma unroll
                for (int m = 0; m < 4; ++m) {
                    f32x4 h0, h1;
                    if (pn < 4) {
#pragma unroll
                        for (int j = 0; j < 4; ++j) { h0[j] = acc[ai][0][m][0][j] * sigmoidf_(acc[ai][1][m][0][j]); h1[j] = acc[ai][0][m][1][j] * sigmoidf_(acc[ai][1][m][1][j]); }
                    } else { h0 = acc[ai][0][m][0] * acc[ai][1][m][0]; h1 = acc[ai][0][m][1] * acc[ai][1][m][1]; }
                    *(u32x4*)(O + (size_t)(row0 + ai * HALF + m * 16) * 512 + col0) = pack8(h0, h1);
                    __builtin_amdgcn_sched_barrier(0);
                }
        } else if (pn < 10 || pn >= 14) {
            bf16_t* O = (pn < 10 ? BG : Vb); const int colt = (pn < 10 ? pn - 8 : pn - 14) * BM + cw;
            const bool wnew = (pn >= 14) && (u.pm < 32);
#pragma unroll
            for (int ai = 0; ai < 2; ++ai)
#pragma unroll
                for (int m = 0; m < 4; ++m) {
                    const int row = row0 + ai * HALF + m * 16;
#pragma unroll
                    for (int bj = 0; bj < 2; ++bj) {
                        *(u32x4*)(O + (size_t)row * 512 + colt + bj * HALF) = pack8(acc[ai][bj][m][0], acc[ai][bj][m][1]);
                        if (wnew) { float* p = newv + ((size_t)(u.pm * 2 + layer) * 256 + (row - u.pm * BM)) * 512 + colt + bj * HALF;
                            *(f32x4*)p = acc[ai][bj][m][0]; *(f32x4*)(p + 4) = acc[ai][bj][m][1]; }
                    }
                    __builtin_amdgcn_sched_barrier(0);
                }
        } else {
            const bool isk = pn >= 12; bf16_t* O = isk ? Kb : Q; const float* gn = isk ? kg : qg;
            const int head = 4 * ((pn - 10) & 1) + wc; const bool wnew = isk && (u.pm < 32);
            f32x4 gv[2][2];
#pragma unroll
            for (int bj = 0; bj < 2; ++bj)
#pragma unroll
                for (int n = 0; n < 2; ++n) gv[bj][n] = *(const f32x4*)(gn + 32 * bj + 8 * fq + 4 * n);
#pragma unroll
            for (int ai = 0; ai < 2; ++ai)
#pragma unroll
                for (int m = 0; m < 4; ++m) {
                    const int row = row0 + ai * HALF + m * 16;
                    float ss = 0.f;
#pragma unroll
                    for (int bj = 0; bj < 2; ++bj)
#pragma unroll
                        for (int n = 0; n < 2; ++n) { const f32x4 x = acc[ai][bj][m][n]; ss += (x[0] * x[0] + x[1] * x[1]) + (x[2] * x[2] + x[3] * x[3]); }
                    ss += __shfl_xor(ss, 16); ss += __shfl_xor(ss, 32);
                    const float rinv = __builtin_amdgcn_rsqf(ss * (1.f / 64.f) + EPS);
#pragma unroll
                    for (int bj = 0; bj < 2; ++bj) {
                        const f32x4 y0 = acc[ai][bj][m][0] * rinv * gv[bj][0], y1 = acc[ai][bj][m][1] * rinv * gv[bj][1];
                        const int col = head * 64 + 32 * bj + 8 * fq;
                        *(u32x4*)(O + (size_t)row * 512 + col) = pack8(y0, y1);
                        if (wnew) { float* p = newk + ((size_t)(u.pm * 2 + layer) * 256 + (row - u.pm * BM)) * 512 + col; *(f32x4*)p = y0; *(f32x4*)(p + 4) = y1; }
                    }
                    __builtin_amdgcn_sched_barrier(0);
                }
        }
    }
};

struct EpiGates {
    static constexpr bool PERM = true;
    bf16_t* GS;
    __device__ __forceinline__ void operator()(const Acc& acc, const Unit& u, int wr, int wc, int fr, int fq) const {
        const int gi = u.pn >> 2; const int bi = gi == 0 ? 2 : gi - 1; bf16_t* O = GS + (size_t)bi * GS_STRIDE;
        const int row0 = u.pm * BM + wr * 64 + fr, col0 = (u.pn & 3) * BM + wc * 32 + 8 * fq;
#pragma unroll
        for (int ai = 0; ai < 2; ++ai)
#pragma unroll
            for (int m = 0; m < 4; ++m)
#pragma unroll
                for (int bj = 0; bj < 2; ++bj) {
                    f32x4 h0, h1;
#pragma unroll
                    for (int j = 0; j < 4; ++j) { h0[j] = sigmoidf_(acc[ai][bj][m][0][j]); h1[j] = sigmoidf_(acc[ai][bj][m][1][j]); }
                    *(u32x4*)(O + (size_t)(row0 + ai * HALF + m * 16) * DM + col0 + bj * HALF) = pack8(h0, h1);
                    __builtin_amdgcn_sched_barrier(0);
                }
    }
};

struct EpiM {
    static constexpr bool PERM = true;
    const bf16_t* GS; bf16_t* Mo;
    __device__ __forceinline__ void operator()(const Acc& acc, const Unit& u, int wr, int wc, int fr, int fq) const {
        const bf16_t* Gs = GS + (size_t)u.seg * GS_STRIDE;
        const int row0 = u.pm * BM + wr * 64 + fr, col0 = u.pn * BM + wc * 32 + 8 * fq;
#pragma unroll
        for (int ai = 0; ai < 2; ++ai) {
            u32x4 gw[4][2], mw[4][2];
#pragma unroll
            for (int m = 0; m < 4; ++m)
#pragma unroll
                for (int bj = 0; bj < 2; ++bj) {
                    const size_t off = (size_t)(row0 + ai * HALF + m * 16) * DM + col0 + bj * HALF;
                    gw[m][bj] = *(const u32x4*)(Gs + off);
                    mw[m][bj] = (u32x4){0u, 0u, 0u, 0u};
                    if (u.seg != 0) mw[m][bj] = *(const u32x4*)(Mo + off);
                }
            __builtin_amdgcn_sched_barrier(0);
#pragma unroll
            for (int m = 0; m < 4; ++m)
#pragma unroll
                for (int bj = 0; bj < 2; ++bj) {
                    const size_t off = (size_t)(row0 + ai * HALF + m * 16) * DM + col0 + bj * HALF;
                    const u32x4 g4 = gw[m][bj], m4 = mw[m][bj];
                    f32x4 h0, h1;
                    h0[0] = bflo(g4.x) * acc[ai][bj][m][0][0] + bflo(m4.x); h0[1] = bfhi(g4.x) * acc[ai][bj][m][0][1] + bfhi(m4.x);
                    h0[2] = bflo(g4.y) * acc[ai][bj][m][0][2] + bflo(m4.y); h0[3] = bfhi(g4.y) * acc[ai][bj][m][0][3] + bfhi(m4.y);
                    h1[0] = bflo(g4.z) * acc[ai][bj][m][1][0] + bflo(m4.z); h1[1] = bfhi(g4.z) * acc[ai][bj][m][1][1] + bfhi(m4.z);
                    h1[2] = bflo(g4.w) * acc[ai][bj][m][1][2] + bflo(m4.w); h1[3] = bfhi(g4.w) * acc[ai][bj][m][1][3] + bfhi(m4.w);
                    *(u32x4*)(Mo + off) = pack8(h0, h1);
                }
            __builtin_amdgcn_sched_barrier(0);
        }
    }
};
}

struct Args { const float* in[32]; };
__device__ __forceinline__ const float* inp(const Args& a, int i) { return a.in[i + opaque_zero()]; }

__device__ __forceinline__ void cvt_block(const float* W, int N, int K, int k0, int n0, bf16_t* WT, int dst_row0, float* scr, int lane) {
#pragma unroll 8
    for (int i = 0; i < 32; ++i) { const int kk = 2 * i + (lane >> 5); scr[kk * 33 + (lane & 31)] = W[(size_t)(k0 + kk) * N + n0 + (lane & 31)]; }
    LDS_WAIT();
    const int c = lane & 7;
#pragma unroll
    for (int j = 0; j < 4; ++j) { const int n = (lane >> 3) + 8 * j; const float* s = scr + (8 * c) * 33 + n;
        u32x4 o; o.x = pk2(s[0 * 33], s[1 * 33]); o.y = pk2(s[2 * 33], s[3 * 33]); o.z = pk2(s[4 * 33], s[5 * 33]); o.w = pk2(s[6 * 33], s[7 * 33]);
        *(u32x4*)(WT + (size_t)(dst_row0 + n) * K + k0 + 8 * c) = o; }
    LDS_WAIT();
}
__device__ __forceinline__ int win_dst(int n) {
    if (n < 512) return 256 * (n >> 7) + (n & 127);
    if (n < 1024) { const int s = n - 512; return 256 * (s >> 7) + 128 + (s & 127); }
    if (n < 1536) return 2048 + (n - 1024);
    if (n < 2048) { const int s = n - 1536; return 1024 + 256 * (s >> 7) + (s & 127); }
    if (n < 2560) { const int s = n - 2048; return 1024 + 256 * (s >> 7) + 128 + (s & 127); }
    if (n < 3584) { const int base = n < 3072 ? 2560 : 3072; const int s = n - base, head = s >> 6, dim = s & 63;
        return base + 256 * (head >> 2) + 128 * (dim >> 5) + 32 * (head & 3) + (dim & 31); }
    return n;
}
__device__ __forceinline__ void convert_weights(const Args& a, int l, unsigned char* lds, int gw, int ngw, int wave, int lane) {
    float* scr = (float*)(lds + wave * 8448);
    unsigned char* ws = (unsigned char*)inp(a, 31);
    constexpr int I_GU = 16 * 88, I_D = 44 * 32, I_IN = 16 * 224, I_O = 8 * 32, I_M = 16 * 32;
    constexpr int NIT = 6 * I_GU + I_IN + 3 * I_O + I_M;
    static_assert(I_GU == I_D, "");
    for (int it = gw; it < NIT; it += ngw) {
        int r = it;
        if (r < 6 * I_GU) {
            const int which = r / I_GU; r -= which * I_GU;
            const int ff = which / 3, kind = which % 3;
            if (kind < 2) {
                const float* W = inp(a, (ff ? 27 : 9) + kind) + (size_t)l * DM * DFF;
                const int kb = r / 88, nb = r % 88, n0 = nb * 32;
                cvt_block(W, DFF, DM, kb * 64, n0, (bf16_t*)(ws + (ff ? W_GU2 : W_GU1)), 256 * (n0 >> 7) + 128 * kind + (n0 & 127), scr, lane);
            } else {
                const float* W = inp(a, ff ? 29 : 11) + (size_t)l * DFF * DM;
                const int kb = r / 32, nb = r % 32;
                cvt_block(W, DM, DFF, kb * 64, nb * 32, (bf16_t*)(ws + (ff ? W_D2 : W_D1)), nb * 32, scr, lane);
            }
            continue;
        }
        r -= 6 * I_GU;
        if (r < I_IN) { const int kb = r / 224, nb = r % 224; cvt_block(inp(a, 13) + (size_t)l * DM * NIN, NIN, DM, kb * 64, nb * 32, (bf16_t*)(ws + W_IN), win_dst(nb * 32), scr, lane); continue; }
        r -= I_IN;
        if (r < 3 * I_O) { const int which = r / I_O; r -= which * I_O; const int kb = r / 32, nb = r % 32;
            const float* W = inp(a, which == 0 ? 18 : (which == 1 ? 20 : 24)) + (size_t)l * 512 * DM;
            cvt_block(W, DM, 512, kb * 64, nb * 32, (bf16_t*)(ws + (which == 0 ? W_A : (which == 1 ? W_B : W_C))), nb * 32, scr, lane); continue; }
        r -= 3 * I_O;
        { const int kb = r / 32, nb = r % 32; cvt_block(inp(a, 25) + (size_t)l * DM * DM, DM, DM, kb * 64, nb * 32, (bf16_t*)(ws + W_M), nb * 32, scr, lane); }
    }
}

__device__ __forceinline__ void compute_mods(const Args& a, unsigned char* lds, int tid, int wave, int lane) {
    float* sT = (float*)lds;
    float* red = (float*)(lds + 49152);
    const float* c = inp(a, 4); const float* cctx = inp(a, 5);
    for (int k = tid; k < DM; k += NTHR) {
        sT[k * 12 + 0] = siluf_(cctx[k]);
#pragma unroll
        for (int v = 1; v < 9; ++v) sT[k * 12 + v] = siluf_(c[(v - 1) * DM + k]);
        sT[k * 12 + 9] = 0.f; sT[k * 12 + 10] = 0.f; sT[k * 12 + 11] = 0.f;
    }
    __syncthreads();
    float* mods = (float*)((unsigned char*)inp(a, 31) + WS_MODS);
    for (int unit = blockIdx.x; unit < 288; unit += gridDim.x) {
        const int l = unit / 144, cb = unit % 144, col = cb * 64 + lane;
        const float* W = inp(a, 6) + (size_t)l * DM * MODW + col;
        float acc[9];
#pragma unroll
        for (int v = 0; v < 9; ++v) acc[v] = 0.f;
#pragma unroll 8
        for (int kk = 0; kk < 128; ++kk) {
            const int k = wave * 128 + kk;
            const float w = W[(size_t)k * MODW];
            const f32x4 s0 = *(const f32x4*)(sT + k * 12), s1 = *(const f32x4*)(sT + k * 12 + 4), s2 = *(const f32x4*)(sT + k * 12 + 8);
            acc[0] += s0[0] * w; acc[1] += s0[1] * w; acc[2] += s0[2] * w; acc[3] += s0[3] * w;
            acc[4] += s1[0] * w; acc[5] += s1[1] * w; acc[6] += s1[2] * w; acc[7] += s1[3] * w; acc[8] += s2[0] * w;
        }
#pragma unroll
        for (int v = 0; v < 9; ++v) red[(wave * 9 + v) * 64 + lane] = acc[v];
        __syncthreads();
        for (int idx = tid; idx < 576; idx += NTHR) {
            const int v = idx >> 6, ln = idx & 63; float s = inp(a, 7)[(size_t)l * MODW + cb * 64 + ln];
#pragma unroll
            for (int w = 0; w < 8; ++w) s += red[(w * 9 + v) * 64 + ln];
            mods[((size_t)l * 9 + v) * MODW + cb * 64 + ln] = s;
        }
        __syncthreads();
    }
}

__device__ __forceinline__ void adaln_phase(const float* in0, const float* in1, const float* g, const float* modl, int ish, bf16_t* U, int gw, int ngw, int lane) {
    for (int row = gw; row < MTOK; row += ngw) {
        const float* xr = (row < NCTX ? in0 : in1) + (size_t)row * DM;
        const int v = row < NCTX ? 0 : 1 + ((row - NCTX) >> 12);
        const float* sh = modl + (size_t)v * MODW + ish * DM; const float* sc = sh + DM;
        f32x4 x[4]; float ss = 0.f;
#pragma unroll
        for (int j = 0; j < 4; ++j) { x[j] = *(const f32x4*)(xr + 256 * j + 4 * lane); ss += (x[j][0] * x[j][0] + x[j][1] * x[j][1]) + (x[j][2] * x[j][2] + x[j][3] * x[j][3]); }
        const float rinv = __builtin_amdgcn_rsqf(wave_sum(ss) * (1.f / DM) + EPS);
#pragma unroll
        for (int j = 0; j < 4; ++j) {
            const int c = 256 * j + 4 * lane;
            const f32x4 gg = *(const f32x4*)(g + c), s1 = *(const f32x4*)(sc + c), s0 = *(const f32x4*)(sh + c);
            const f32x4 y = x[j] * rinv * gg * (s1 + 1.f) + s0;
            u32x2 w; w.x = pk2(y[0], y[1]); w.y = pk2(y[2], y[3]);
            *(u32x2*)(U + (size_t)row * DM + c) = w;
        }
    }
}

namespace att {
constexpr int TK = 128, PITCH = 272, KS_OFF = 0, VS_OFF = TK * PITCH, RPB_OFF = 2 * TK * PITCH;
typedef short v4i16_t __attribute__((ext_vector_type(4)));
__device__ __forceinline__ s16x4 vtr(const LAS char* p) { return __builtin_bit_cast(s16x4, __builtin_amdgcn_ds_read_tr16_b64_v4i16((LAS v4i16_t*)p)); }

struct TileSrc { const bf16_t* k; const bf16_t* v; };

template <bool LOCAL>
__device__ __forceinline__ void tile_compute(const LAS char* ldsb, const bf16x8 (&qf)[2], f32x4 (&O)[4], float& mrun, float& lrun,
                                             int hl, int koff, int fr, int fq, int lane, const float* rpbrow, const int (&dci)[8], unsigned vmask) {
    constexpr int NMT = LOCAL ? 4 : 8;
#define ATT_KEYOFF(mt) (LOCAL ? (((mt) >> 1) * 64 + koff + 16 * ((mt) & 1)) : 16 * (mt))
    f32x4 s[NMT];
#pragma unroll
    for (int mt = 0; mt < NMT; ++mt) {
        s[mt] = (f32x4){0.f, 0.f, 0.f, 0.f};
#pragma unroll
        for (int ks = 0; ks < 2; ++ks) {
            const bf16x8 kf = *(const LAS bf16x8*)(ldsb + KS_OFF + (ATT_KEYOFF(mt) + fr) * PITCH + hl * 128 + ks * 64 + fq * 16);
            s[mt] = __builtin_amdgcn_mfma_f32_16x16x32_bf16(kf, qf[ks], s[mt], 0, 0, 0);
        }
    }
    float tmax = -1e30f;
#pragma unroll
    for (int mt = 0; mt < NMT; ++mt)
#pragma unroll
        for (int j = 0; j < 4; ++j) {
            float v = s[mt][j] * 0.125f;
            if (LOCAL) { v += rpbrow[(mt >> 1) * 32 + dci[(mt & 1) * 4 + j]]; if (!((vmask >> ((mt & 1) * 4 + j)) & 1u)) v = -1e30f; }
            s[mt][j] = v; tmax = fmaxf(tmax, v);
        }
    tmax = fmaxf(tmax, __shfl_xor(tmax, 16)); tmax = fmaxf(tmax, __shfl_xor(tmax, 32));
    const float mnew = fmaxf(mrun, tmax), alpha = __expf(mrun - mnew);
    float psum = 0.f;
#pragma unroll
    for (int mt = 0; mt < NMT; ++mt)
#pragma unroll
        for (int j = 0; j < 4; ++j) { const float p = __expf(s[mt][j] - mnew); s[mt][j] = p; psum += p; }
    lrun = lrun * alpha + psum; mrun = mnew;
#pragma unroll
    for (int dt = 0; dt < 4; ++dt) O[dt] = O[dt] * alpha;
    const int g = lane >> 4, q = (lane & 15) >> 2, p4 = lane & 3;
#pragma unroll
    for (int kk = 0; kk < NMT / 2; ++kk) {
        bf16x8 pb;
        { const u32x4 w = pg8::pack8(s[2 * kk], s[2 * kk + 1]); pb = __builtin_bit_cast(bf16x8, w); }
#pragma unroll
        for (int dt = 0; dt < 4; ++dt) {
            const LAS char* vb = ldsb + VS_OFF + hl * 128 + 32 * dt + 8 * p4;
            const s16x4 v0 = vtr(vb + (ATT_KEYOFF(2 * kk) + 4 * g + q) * PITCH);
            const s16x4 v1 = vtr(vb + (ATT_KEYOFF(2 * kk + 1) + 4 * g + q) * PITCH);
            bf16x8 vf; vf[0] = v0[0]; vf[1] = v0[1]; vf[2] = v0[2]; vf[3] = v0[3]; vf[4] = v1[0]; vf[5] = v1[1]; vf[6] = v1[2]; vf[7] = v1[3];
            O[dt] = __builtin_amdgcn_mfma_f32_16x16x32_bf16(vf, pb, O[dt], 0, 0, 0);
        }
    }
#undef ATT_KEYOFF
}

template <bool LATENT>
__device__ __forceinline__ void unit(unsigned char* lds, bf16_t* QO, const bf16_t* Kb, const bf16_t* Vb, const bf16_t* CK, const bf16_t* CV, const float* rpb_l,
                                     int qrow0  , int keyrow0  , int hp, int r  ,
                                     int tid, int wave, int lane) {
    const LAS char* ldsb = (const LAS char*)(LAS unsigned char*)lds;
    const int hl = wave >> 2, J = wave & 3, fr = lane & 15, fq = lane >> 4;
    const int rs = LATENT ? min(max(r - 4, 0), 56) : 0;
    constexpr int NT = LATENT ? 8 : 2;
    int dci[8]; unsigned vmask = 0u; int koff = 0;
    if (LATENT) {
        const int qc = 16 * J + fr, wstart = min(max(qc - 8, 0), 48);
        koff = min(max(16 * J - 8, 0), 32);
#pragma unroll
        for (int mt = 0; mt < 2; ++mt)
#pragma unroll
            for (int j = 0; j < 4; ++j) { const int kc = koff + 16 * mt + 4 * fq + j;
                dci[mt * 4 + j] = min(max(kc - qc, -15), 15) + 15;
                if (kc >= wstart && kc < wstart + 16) vmask |= 1u << (mt * 4 + j); }
        float* tb = (float*)(lds + RPB_OFF);
        for (int i = tid; i < 2 * 15 * 32; i += NTHR) { const int h2 = i / 480, rem = i % 480, dr = rem >> 5, dc = rem & 31;
            tb[i] = dc < 31 ? rpb_l[((2 * hp + h2) * 15 + dr) * 31 + dc] : 0.f; }
    } else {
#pragma unroll
        for (int i = 0; i < 8; ++i) dci[i] = 0;
    }
    bf16x8 qf[2];
    { const bf16_t* qp = QO + (size_t)(qrow0 + 16 * J + fr) * 512 + (2 * hp + hl) * 64 + 8 * fq;
      qf[0] = *(const bf16x8*)qp; qf[1] = *(const bf16x8*)(qp + 32); }
    f32x4 O[4];
#pragma unroll
    for (int dt = 0; dt < 4; ++dt) O[dt] = (f32x4){0.f, 0.f, 0.f, 0.f};
    float mrun = -1e30f, lrun = 0.f;
    const int key0 = tid >> 4, part = tid & 15;
    u32x4 kA[4], vA[4], kB[4], vB[4];
    auto tsrc = [&](int t) -> TileSrc {
        TileSrc s;
        if (LATENT) {
            if (t < 4) { s.k = CK + (size_t)(t * TK) * 512 + hp * 128; s.v = CV + (size_t)(t * TK) * 512 + hp * 128; }
            else { const size_t ro = (size_t)(keyrow0 + (rs + 2 * (t - 4)) * 64) * 512 + hp * 128; s.k = Kb + ro; s.v = Vb + ro; }
        } else { const size_t ro = (size_t)(keyrow0 + t * TK) * 512 + hp * 128; s.k = Kb + ro; s.v = Vb + ro; }
        return s;
    };
#define ATT_GLOAD(KR, VR, t) do { const TileSrc s_ = tsrc(t); _Pragma("unroll") for (int i = 0; i < 4; ++i) { const size_t o = (size_t)(key0 + 32 * i) * 512 + part * 8; \
        KR[i] = *(const u32x4*)(s_.k + o); VR[i] = *(const u32x4*)(s_.v + o); } } while (0)
#define ATT_BAR() do { asm volatile("s_waitcnt lgkmcnt(0)" ::: "memory"); __builtin_amdgcn_s_barrier(); asm volatile("" ::: "memory"); } while (0)
#define ATT_LSTORE(KR, VR) do { _Pragma("unroll") for (int i = 0; i < 4; ++i) { const int lo = (key0 + 32 * i) * PITCH + part * 16; \
        *(u32x4*)(lds + KS_OFF + lo) = KR[i]; *(u32x4*)(lds + VS_OFF + lo) = VR[i]; } } while (0)
#define ATT_COMPUTE(t) do { if (LATENT && (t) >= 4) { const int dr = (rs + 2 * ((t) - 4)) - r + 7; \
            const float* rpbrow = (const float*)(lds + RPB_OFF) + (hl * 15 + dr) * 32; \
            tile_compute<true>(ldsb, qf, O, mrun, lrun, hl, koff, fr, fq, lane, rpbrow, dci, vmask); \
        } else { tile_compute<false>(ldsb, qf, O, mrun, lrun, hl, 0, fr, fq, lane, nullptr, dci, 0u); } } while (0)
    ATT_GLOAD(kA, vA, 0); ATT_GLOAD(kB, vB, 1);
    for (int t = 0; t < NT; t += 2) {
        ATT_BAR();
        ATT_LSTORE(kA, vA);
        ATT_BAR();
        if (t + 2 < NT) ATT_GLOAD(kA, vA, t + 2);
        ATT_COMPUTE(t);
        ATT_BAR();
        ATT_LSTORE(kB, vB);
        ATT_BAR();
        if (t + 3 < NT) ATT_GLOAD(kB, vB, t + 3);
        ATT_COMPUTE(t + 1);
    }
#undef ATT_GLOAD
#undef ATT_BAR
#undef ATT_LSTORE
#undef ATT_COMPUTE
    lrun += __shfl_xor(lrun, 16); lrun += __shfl_xor(lrun, 32);
    const float linv = 1.f / lrun;
    bf16_t* op = QO + (size_t)(qrow0 + 16 * J + fr) * 512 + (2 * hp + hl) * 64 + 4 * fq;
#pragma unroll
    for (int dt = 0; dt < 4; ++dt) { u32x2 w; w.x = cvt_pk_bf16(O[dt][0] * linv, O[dt][1] * linv); w.y = cvt_pk_bf16(O[dt][2] * linv, O[dt][3] * linv); *(u32x2*)(op + 16 * dt) = w; }
    __syncthreads();
}
}

__device__ __forceinline__ void conva_unit(unsigned char* lds, const bf16_t* GLU, bf16_t* AOUT, const float* cw, const float* cb, const float* lg, const float* lb,
                                           int rowbase, int len, int t0, int tid, int wave, int lane) {
    bf16_t* in_s = (bf16_t*)lds;
    float* hs = (float*)(lds + 62 * 512 * 2);
    for (int idx = tid; idx < 62 * 64; idx += NTHR) {
        const int i = idx >> 6, ch = idx & 63, p = t0 - 15 + i;
        u32x4 v = (u32x4){0u, 0u, 0u, 0u};
        if (p >= 0 && p < len) v = *(const u32x4*)(GLU + (size_t)(rowbase + p) * 512 + ch * 8);
        *(u32x4*)(in_s + i * 512 + ch * 8) = v;
    }
    float w[31];
#pragma unroll
    for (int j = 0; j < 31; ++j) w[j] = cw[j * 512 + tid];
    const float bias = cb[tid];
    __syncthreads();
    float col[62];
#pragma unroll
    for (int i = 0; i < 62; ++i) col[i] = __uint_as_float((unsigned)in_s[i * 512 + tid] << 16);
#pragma unroll
    for (int tt = 0; tt < 32; ++tt) {
        float acc = bias;
#pragma unroll
        for (int j = 0; j < 31; ++j) acc += col[tt + j] * w[j];
        hs[tt * 512 + tid] = acc;
    }
    __syncthreads();
#pragma unroll
    for (int q = 0; q < 4; ++q) {
        const int tt = wave * 4 + q;
        const f32x4 a = *(const f32x4*)(hs + tt * 512 + lane * 8), b = *(const f32x4*)(hs + tt * 512 + lane * 8 + 4);
        const float mean = wave_sum((a[0] + a[1]) + (a[2] + a[3]) + (b[0] + b[1]) + (b[2] + b[3])) * (1.f / 512.f);
        const f32x4 da = a - mean, db = b - mean;
        const float var = wave_sum((da[0] * da[0] + da[1] * da[1]) + (da[2] * da[2] + da[3] * da[3]) + (db[0] * db[0] + db[1] * db[1]) + (db[2] * db[2] + db[3] * db[3])) * (1.f / 512.f);
        const float rstd = __builtin_amdgcn_rsqf(var + EPS);
        const f32x4 g0 = *(const f32x4*)(lg + lane * 8), g1 = *(const f32x4*)(lg + lane * 8 + 4), b0 = *(const f32x4*)(lb + lane * 8), b1 = *(const f32x4*)(lb + lane * 8 + 4);
        f32x4 y0 = da * rstd * g0 + b0, y1 = db * rstd * g1 + b1;
#pragma unroll
        for (int j = 0; j < 4; ++j) { y0[j] = siluf_(y0[j]); y1[j] = siluf_(y1[j]); }
        *(u32x4*)(AOUT + (size_t)(rowbase + t0 + tt) * 512 + lane * 8) = pg8::pack8(y0, y1);
    }
    __syncthreads();
}

__device__ __forceinline__ void convb_phase(bf16_t* BG, const bf16_t* CH, const float* w3, int gtid, int nthreads) {
    for (int idx = gtid; idx < MTOK * 64; idx += nthreads) {
        const int row = idx >> 6, ch = idx & 63;
        int pos, len; if (row < NCTX) { pos = row & 255; len = 256; } else { pos = (row - NCTX) & 4095; len = 4096; }
        const u32x4 z = (u32x4){0u, 0u, 0u, 0u};
        const u32x4 c1 = *(const u32x4*)(CH + (size_t)row * 512 + ch * 8);
        const u32x4 c0 = pos > 0 ? *(const u32x4*)(CH + (size_t)(row - 1) * 512 + ch * 8) : z;
        const u32x4 c2 = pos < len - 1 ? *(const u32x4*)(CH + (size_t)(row + 1) * 512 + ch * 8) : z;
        const u32x4 bg = *(const u32x4*)(BG + (size_t)row * 512 + ch * 8);
        f32x4 wa[3], wb[3];
#pragma unroll
        for (int j = 0; j < 3; ++j) { wa[j] = *(const f32x4*)(w3 + j * 512 + ch * 8); wb[j] = *(const f32x4*)(w3 + j * 512 + ch * 8 + 4); }
        f32x4 y0, y1;
#define CB_(o, k, W, c0w, c1w, c2w, bgw, F) o[k] = F(bgw) * (F(c0w) * W[0][k] + F(c1w) * W[1][k] + F(c2w) * W[2][k])
        CB_(y0, 0, wa, c0.x, c1.x, c2.x, bg.x, bflo); CB_(y0, 1, wa, c0.x, c1.x, c2.x, bg.x, bfhi);
        CB_(y0, 2, wa, c0.y, c1.y, c2.y, bg.y, bflo); CB_(y0, 3, wa, c0.y, c1.y, c2.y, bg.y, bfhi);
        CB_(y1, 0, wb, c0.z, c1.z, c2.z, bg.z, bflo); CB_(y1, 1, wb, c0.z, c1.z, c2.z, bg.z, bfhi);
        CB_(y1, 2, wb, c0.w, c1.w, c2.w, bg.w, bflo); CB_(y1, 3, wb, c0.w, c1.w, c2.w, bg.w, bfhi);
#undef CB_
        *(u32x4*)(BG + (size_t)row * 512 + ch * 8) = pg8::pack8(y0, y1);
    }
}

#define XB_TMO      128
#define XB_XCNT(j)  (256  + 64 * (j))
#define XB_XSUB(j)  (1280 + 64 * (j))
#define XB_XGEN(j)  (2304 + 64 * (j))
#define XB_TOP      3328
#define XB_TOPGEN   3392
#define XCD_BAR_WORDS 3456
#define XB_SPIN_CAP (1u << 18)

__device__ __forceinline__ unsigned xb_ld(unsigned* p)              { return __hip_atomic_load(p, __ATOMIC_RELAXED, __HIP_MEMORY_SCOPE_AGENT); }
__device__ __forceinline__ unsigned xb_add(unsigned* p, unsigned v) { return __hip_atomic_fetch_add(p, v, __ATOMIC_RELAXED, __HIP_MEMORY_SCOPE_AGENT); }
__device__ __forceinline__ unsigned xb_xcc_id() { return (unsigned)__builtin_amdgcn_s_getreg((3 << 11) | 20) & 0xFu; }
#define XB_SPIN(cond, bar) do { unsigned _sp = 0; while (cond) { __builtin_amdgcn_s_sleep(1); \
    if ((++_sp & 255u) == 0u) { if (xb_ld(&(bar)[XB_TMO])) break; if (_sp > XB_SPIN_CAP) { atomicAdd(&(bar)[XB_TMO], 1u); break; } } } } while (0)

struct XcdBarrier {
    unsigned* bar; unsigned x;
    volatile LAS unsigned* st;
};

__device__ __forceinline__ XcdBarrier xcd_barrier_post(unsigned* bar, volatile LAS unsigned* st) {
    XcdBarrier b; b.bar = bar; b.x = xb_xcc_id(); b.st = st;
    if (threadIdx.x == 0) (void)xb_add(&bar[XB_XCNT(b.x)], 1u);
    return b;
}
__device__ __forceinline__ void xcd_barrier_complete(unsigned* bar, unsigned x, unsigned& nloc, unsigned& nx) {
    const unsigned G = gridDim.x * gridDim.y * gridDim.z;
    unsigned sum, cnt, mine, sp = 0u;
    for (;;) {
        sum = 0u; cnt = 0u; mine = 0u;
#pragma unroll
        for (unsigned j = 0; j < 16; ++j) { const unsigned c = xb_ld(&bar[XB_XCNT(j)]); sum += c; cnt += (c > 0u) ? 1u : 0u; mine = (j == x) ? c : mine; }
        if (sum == G) break;
        __builtin_amdgcn_s_sleep(1);
        if ((++sp & 255u) == 0u) { if (xb_ld(&bar[XB_TMO])) break; if (sp > XB_SPIN_CAP) { atomicAdd(&bar[XB_TMO], 1u); break; } }
    }
    nloc = mine > 0u ? mine : 1u; nx = cnt > 0u ? cnt : 1u;
}

__device__ __forceinline__ void xcd_barrier(const XcdBarrier& b) {
    asm volatile("s_waitcnt vmcnt(0)" ::: "memory");
    __syncthreads();
    if (threadIdx.x == 0) {
        unsigned* bar = b.bar;
        __builtin_amdgcn_s_waitcnt(0);
        unsigned nloc = b.st[0], nx = b.st[1];
        if (nloc == 0u) { xcd_barrier_complete(bar, b.x, nloc, nx); b.st[0] = nloc; b.st[1] = nx; }
        const unsigned old = xb_add(&bar[XB_XSUB(b.x)], 1u);
        const unsigned gen = old / nloc;
        if (old + 1u == (gen + 1u) * nloc) {
            __builtin_amdgcn_fence(__ATOMIC_RELEASE, "agent");
            asm volatile("s_waitcnt vmcnt(0)" ::: "memory");
            const unsigned og = xb_add(&bar[XB_TOP], 1u);
            const unsigned tg = og / nx;
            if (og + 1u == (tg + 1u) * nx) xb_add(&bar[XB_TOPGEN], 1u);
            else XB_SPIN(xb_ld(&bar[XB_TOPGEN]) == tg, bar);
            __builtin_amdgcn_fence(__ATOMIC_ACQUIRE, "agent");
            xb_add(&bar[XB_XGEN(b.x)], 1u);
            asm volatile("s_waitcnt vmcnt(0)" ::: "memory");
        } else {
            XB_SPIN(xb_ld(&bar[XB_XGEN(b.x)]) == gen, bar);
            __builtin_amdgcn_fence(__ATOMIC_ACQUIRE, "agent");
            asm volatile("s_waitcnt vmcnt(0)" ::: "memory");
        }
    }
    __syncthreads();
}


#ifndef PHASE_MASK
#define PHASE_MASK 0xFFFFF
#endif
#define PH_ON(n) ((PHASE_MASK >> (n)) & 1)
#ifndef LAST_PHASE
#define LAST_PHASE 99
#endif
#define PHX(n) if (l * 12 + (n) <= LAST_PHASE)

__global__ void __launch_bounds__(NTHR, 2) fwd_megakernel(Args a) {
    extern __shared__ __attribute__((aligned(16))) unsigned char lds[];
    cg::grid_group grid = cg::this_grid();
    const int G = gridDim.x, bx = blockIdx.x;
    PG8_LAS unsigned char* ldsg = (PG8_LAS unsigned char*)lds;
    grid.sync();
    volatile LAS unsigned* bst = (volatile LAS unsigned*)((LAS unsigned char*)lds + LDS_BYTES - 64);
    if (threadIdx.x < 16) bst[threadIdx.x] = 0u;
    __syncthreads();
    (void)xcd_barrier_post((unsigned*)inp(a, 31), bst);
#define GSYNC() do { XcdBarrier b_; b_.bar = (unsigned*)inp(a, 31); b_.x = xb_xcc_id(); b_.st = (volatile LAS unsigned*)((LAS unsigned char*)lds + LDS_BYTES - 64); xcd_barrier(b_); } while (0)
#define TIDS const int tid = threadIdx.x + opaque_vzero(), lane = tid & 63, wave = __builtin_amdgcn_readfirstlane(tid >> 6); \
             const int gw = bx * NWAVES + wave, ngw = G * NWAVES, gtid = bx * NTHR + tid, nthreads = G * NTHR; (void)gw; (void)ngw; (void)gtid; (void)nthreads; (void)lane;
#define BASES const int z_ = opaque_zero(); unsigned char* ws = (unsigned char*)inp(a, 31); float* out = (float*)inp(a, 30); const int lp = l + z_; const int bxp = bx + z_, Gp = G + z_; (void)bxp; (void)Gp; \
              const float* modl = (const float*)(ws + WS_MODS) + (size_t)lp * 9 * MODW; (void)modl; (void)out;

    {
        TIDS
#if PH_ON(0)
        compute_mods(a, lds, tid, wave, lane);
#endif
        unsigned char* ws = (unsigned char*)inp(a, 31);
        bf16_t* CK = (bf16_t*)(ws + WS_CK); bf16_t* CV = (bf16_t*)(ws + WS_CV);
        for (int i = gtid; i < 2 * 524288; i += nthreads) {
            const int which = i >= 524288; const int j = which ? i - 524288 : i;
            const float* src = inp(a, which ? 3 : 2) + (size_t)j * 8; bf16_t* dst = (which ? CV : CK) + (size_t)j * 8;
            const f32x4 x0 = *(const f32x4*)src, x1 = *(const f32x4*)(src + 4);
            u32x4 w; w.x = pk2(x0[0], x0[1]); w.y = pk2(x0[2], x0[3]); w.z = pk2(x1[0], x1[1]); w.w = pk2(x1[2], x1[3]);
            *(u32x4*)dst = w;
        }
    }
    GSYNC();

    for (int l = 0; l < 2; ++l) {
        PHX(1) {
            TIDS BASES
#if PH_ON(1)
            convert_weights(a, lp, lds, gw, ngw, wave, lane);
#endif
#if PH_ON(2)
            const float* xin0 = lp == 0 ? inp(a, 0) : out;
            const float* xin1 = lp == 0 ? inp(a, 1) - (size_t)NCTX * DM : out;
            adaln_phase(xin0, xin1, inp(a, 8) + lp * DM, modl, 0, (bf16_t*)(ws + WS_U), gw, ngw, lane);
#endif
        }
        GSYNC();
#if PH_ON(3)
        PHX(2) { BASES
          pg8::Gemm g{(const bf16_t*)(ws + WS_U), (const bf16_t*)(ws + W_GU1), 0, 0, MTOK, 2 * DFF, DM}; pg8::Order S; S.init(MTOK, 2 * DFF, Gp, bxp, 1);
          pg8::EpiSwiGLU E{(bf16_t*)(ws + WS_H)}; pg8::gemm_phase<pg8::EpiSwiGLU, true, true>(ldsg, g, S, E); }
#endif
        GSYNC();
#if PH_ON(4)
        PHX(3) { BASES
          const float* xin0 = lp == 0 ? inp(a, 0) : out;
          const float* xin1 = lp == 0 ? inp(a, 1) - (size_t)NCTX * DM : out;
          pg8::Gemm g{(const bf16_t*)(ws + WS_H), (const bf16_t*)(ws + W_D1), 0, 0, MTOK, DM, DFF}; pg8::Order S; S.init(MTOK, DM, Gp, bxp, 1);
          pg8::EpiResid E{xin0, xin1, out, modl + 2 * DM, 0.5f}; pg8::gemm_phase<pg8::EpiResid, true, true>(ldsg, g, S, E); }
#endif
        GSYNC();
#if PH_ON(14)
        PHX(4) { TIDS BASES
          adaln_phase(out, out, inp(a, 12) + lp * DM, modl, 3, (bf16_t*)(ws + WS_U), gw, ngw, lane); }
#endif
        GSYNC();
#if PH_ON(5)
        PHX(5) { BASES
          float* newk = out + (size_t)MTOK * DM; float* newv = newk + (size_t)32 * 2 * 256 * 512;
          pg8::Gemm g{(const bf16_t*)(ws + WS_U), (const bf16_t*)(ws + W_IN), 0, 0, MTOK, 4096, DM}; pg8::Order S; S.init(MTOK, 4096, Gp, bxp, 1);
          pg8::EpiWin E{(bf16_t*)(ws + WS_GLU), (bf16_t*)(ws + WS_CH), (bf16_t*)(ws + WS_BG), (bf16_t*)(ws + WS_Q), (bf16_t*)(ws + WS_K), (bf16_t*)(ws + WS_V),
                        inp(a, 21) + lp * 64, inp(a, 22) + lp * 64, newk, newv, lp};
          pg8::gemm_phase<pg8::EpiWin, true, true>(ldsg, g, S, E); }
#endif
        GSYNC();
        PHX(6) {
            TIDS BASES
            bf16_t* Q = (bf16_t*)(ws + WS_Q); const bf16_t* Kb = (const bf16_t*)(ws + WS_K); const bf16_t* Vb = (const bf16_t*)(ws + WS_V);
#if PH_ON(11)
            {
            const bf16_t* CK = (const bf16_t*)(ws + WS_CK); const bf16_t* CV = (const bf16_t*)(ws + WS_CV);
            const float* rpb_l = inp(a, 23) + (size_t)lp * 8 * 15 * 31;
            for (int u = bxp; u < 2048; u += Gp) {
                const int b = u >> 8, hp = (u >> 6) & 3, r = u & 63;
                const size_t co = (size_t)((b * 2 + lp) * 512) * 512;
                att::unit<true>(lds, Q, Kb, Vb, CK + co, CV + co, rpb_l, NCTX + b * 4096 + r * 64, NCTX + b * 4096, hp, r, tid, wave, lane);
            }
            for (int u = bxp; u < 512; u += Gp) {
                const int b = u >> 4, hp = (u >> 2) & 3, qb = u & 3;
                att::unit<false>(lds, Q, Kb, Vb, nullptr, nullptr, nullptr, b * 256 + qb * 64, b * 256, hp, 0, tid, wave, lane);
            }
            }
#endif
#if PH_ON(12)
            {
            const float* cw = inp(a, 14) + (size_t)lp * 31 * 512; const float* cb = inp(a, 15) + lp * 512; const float* lg = inp(a, 16) + lp * 512; const float* lb = inp(a, 17) + lp * 512;
            for (int u = bxp; u < 1280; u += Gp) {
                int rowbase, len, t0;
                if (u < 256) { rowbase = (u >> 3) * 256; len = 256; t0 = (u & 7) * 32; }
                else { const int v = u - 256; rowbase = NCTX + (v >> 7) * 4096; len = 4096; t0 = (v & 127) * 32; }
                conva_unit(lds, (const bf16_t*)(ws + WS_GLU), (bf16_t*)(ws + WS_AOUT), cw, cb, lg, lb, rowbase, len, t0, tid, wave, lane);
            }
            }
#endif
#if PH_ON(13)
            convb_phase((bf16_t*)(ws + WS_BG), (const bf16_t*)(ws + WS_CH), inp(a, 19) + (size_t)lp * 3 * 512, gtid, nthreads);
#endif
        }
        GSYNC();
#if PH_ON(6)
        PHX(7) { BASES
          const bf16_t* Wg = (const bf16_t*)(ws + W_IN) + (size_t)4096 * DM;
          pg8::Gemm g{(const bf16_t*)(ws + WS_U), Wg, 0, 0, MTOK, 3072, DM}; pg8::Order S; S.init(MTOK, 3072, Gp, bxp, 1);
          pg8::EpiGates E{(bf16_t*)(ws + WS_GS)}; pg8::gemm_phase<pg8::EpiGates, true, true>(ldsg, g, S, E); }
#endif
        GSYNC();
#if PH_ON(7)
        PHX(8) { BASES
          pg8::Gemm g{(const bf16_t*)(ws + WS_BG), (const bf16_t*)(ws + W_B), BR_STRIDE, WO_STRIDE, MTOK, DM, 512}; pg8::Order S; S.init(MTOK, DM, Gp, bxp, 3);
          pg8::EpiM E{(const bf16_t*)(ws + WS_GS), (bf16_t*)(ws + WS_U)}; pg8::gemm_phase<pg8::EpiM, true, true>(ldsg, g, S, E); }
#endif
        GSYNC();
#if PH_ON(8)
        PHX(9) { BASES
          pg8::Gemm g{(const bf16_t*)(ws + WS_U), (const bf16_t*)(ws + W_M), 0, 0, MTOK, DM, DM}; pg8::Order S; S.init(MTOK, DM, Gp, bxp, 1);
          pg8::EpiResid E{out, out, out, modl + 5 * DM, 1.0f}; pg8::gemm_phase<pg8::EpiResid, true, true>(ldsg, g, S, E); }
#endif
        GSYNC();
#if PH_ON(14)
        PHX(10) { TIDS BASES
          adaln_phase(out, out, inp(a, 26) + lp * DM, modl, 6, (bf16_t*)(ws + WS_U), gw, ngw, lane); }
#endif
        GSYNC();
#if PH_ON(9)
        PHX(11) { BASES
          pg8::Gemm g{(const bf16_t*)(ws + WS_U), (const bf16_t*)(ws + W_GU2), 0, 0, MTOK, 2 * DFF, DM}; pg8::Order S; S.init(MTOK, 2 * DFF, Gp, bxp, 1);
          pg8::EpiSwiGLU E{(bf16_t*)(ws + WS_H)}; pg8::gemm_phase<pg8::EpiSwiGLU, true, true>(ldsg, g, S, E); }
#endif
        GSYNC();
#if PH_ON(10)
        PHX(12) { BASES
          pg8::Gemm g{(const bf16_t*)(ws + WS_H), (const bf16_t*)(ws + W_D2), 0, 0, MTOK, DM, DFF}; pg8::Order S; S.init(MTOK, DM, Gp, bxp, 1);
          pg8::EpiResid E{out, out, out, modl + 8 * DM, 0.5f}; pg8::gemm_phase<pg8::EpiResid, true, true>(ldsg, g, S, E); }
#endif
        if (l == 0) GSYNC();
    }
}

extern "C" void kernel_launch(void* const* d_in, const int* in_sizes, int n_in, void* d_out, int out_size, void* d_ws, size_t ws_size, hipStream_t stream) {
    static int grid = 0;
    if (grid == 0) {
        if (n_in != 30 || ws_size < WS_END) { fprintf(stderr, "kernel_launch: unexpected inputs (n_in %d, ws %zu)\n", n_in, ws_size); grid = -1; return; }
        int dev = 0, cus = 0, per_cu = 0;
        hipGetDevice(&dev);
        hipDeviceGetAttribute(&cus, hipDeviceAttributeMultiprocessorCount, dev);
        hipFuncSetAttribute((const void*)fwd_megakernel, hipFuncAttributeMaxDynamicSharedMemorySize, LDS_BYTES);
        hipOccupancyMaxActiveBlocksPerMultiprocessor(&per_cu, (const void*)fwd_megakernel, NTHR, LDS_BYTES);
        if (per_cu < 1) per_cu = 1;
        (void)hipGetLastError();
        grid = cus;
        if (grid > 256) grid = 256;
    }
    if (grid < 0) return;
    Args a{};
    for (int i = 0; i < 30; ++i) a.in[i] = (const float*)d_in[i];
    a.in[30] = (const float*)d_out; a.in[31] = (const float*)d_ws;
    (void)hipMemsetAsync(d_ws, 0, 16384, stream);
    void* args[] = {&a};
    hipError_t e = hipLaunchCooperativeKernel((const void*)fwd_megakernel, dim3(grid), dim3(NTHR), args, LDS_BYTES, stream);
    if (e != hipSuccess) fprintf(stderr, "cooperative launch failed: %s (grid %d)\n", hipGetErrorString(e), grid);
}
```

```cpp
#include <hip/hip_runtime.h>
#include <hip/hip_cooperative_groups.h>
#include <cstdio>
#include <cstdint>
namespace cg = cooperative_groups;

#define LAS __attribute__((address_space(3)))
typedef unsigned short bf16_t;
typedef short bf16x8 __attribute__((ext_vector_type(8)));
typedef short s16x4 __attribute__((ext_vector_type(4)));
typedef float f32x4 __attribute__((ext_vector_type(4)));
typedef unsigned u32x4 __attribute__((ext_vector_type(4)));
typedef unsigned u32x2 __attribute__((ext_vector_type(2)));

constexpr int DM = 1024, NCTX = 8192, NLAT = 32768, MTOK = NCTX + NLAT;
constexpr int DFF = 2816, NIN = 7168, NMODV = 9, MODW = 9 * 1024;
constexpr int NWAVES = 8, NTHR = 512;
constexpr float EPS = 1e-6f;

constexpr size_t MiB = 1u << 20;
constexpr size_t WS_MODS = 1 * MiB;
constexpr size_t WS_W = 2 * MiB;
constexpr size_t W_GU1 = WS_W, W_D1 = W_GU1 + 11 * MiB, W_IN = W_D1 + 11 * MiB / 2, W_B = W_IN + 14 * MiB, W_C = W_B + MiB, W_A = W_C + MiB,
                 W_M = W_A + MiB, W_GU2 = W_M + 2 * MiB, W_D2 = W_GU2 + 11 * MiB;
constexpr size_t WS_U = 54 * MiB, WS_H = 134 * MiB;
constexpr size_t WS_BG = 134 * MiB, WS_Q = 174 * MiB, WS_AOUT = 214 * MiB, WS_GLU = 254 * MiB, WS_CH = 294 * MiB, WS_K = 334 * MiB, WS_V = 374 * MiB;
constexpr size_t WS_GS = 254 * MiB;
constexpr size_t GS_STRIDE = 80 * MiB / 2, BR_STRIDE = 40 * MiB / 2, WO_STRIDE = MiB / 2;
constexpr size_t WS_CK = 494 * MiB, WS_CV = 502 * MiB, WS_END = 510 * MiB;
static_assert(W_D2 + 11 * MiB / 2 <= WS_U, "weights fit");
constexpr int LDS_BYTES = 147456;

__device__ __forceinline__ unsigned f2bf(float f) { unsigned u = __builtin_bit_cast(unsigned, f); return (u + 0x7fffu + ((u >> 16) & 1u)) >> 16; }
__device__ __forceinline__ unsigned pk2(float lo, float hi) { return f2bf(lo) | (f2bf(hi) << 16); }
typedef float f32x2_t __attribute__((ext_vector_type(2))); typedef __bf16 bf16x2_t __attribute__((ext_vector_type(2)));
__device__ __forceinline__ unsigned cvt_pk_bf16(float lo, float hi) { f32x2_t v = {lo, hi}; bf16x2_t b = __builtin_convertvector(v, bf16x2_t); return __builtin_bit_cast(unsigned, b); }
__device__ __forceinline__ float bflo(unsigned w) { return __uint_as_float(w << 16); }
__device__ __forceinline__ float bfhi(unsigned w) { return __uint_as_float(w & 0xffff0000u); }
__device__ __forceinline__ float sigmoidf_(float x) { return __builtin_amdgcn_rcpf(1.f + __expf(-x)); }
__device__ __forceinline__ float siluf_(float x) { return x * sigmoidf_(x); }
__device__ __forceinline__ float wave_sum(float v) {
#pragma unroll
    for (int o = 1; o < 64; o <<= 1) v += __shfl_xor(v, o);
    return v;
}
__device__ __forceinline__ int opaque_zero() { int z; asm volatile("s_mov_b32 %0, 0" : "=s"(z)); return z; }
__device__ __forceinline__ int opaque_vzero() { int z; asm volatile("v_mov_b32 %0, 0" : "=v"(z)); return z; }
template <class T> __device__ __forceinline__ T* launder_ptr(T* p) { T* r; asm volatile("s_mov_b64 %0, %1" : "=s"(r) : "s"(p)); return r; }
#define LDS_WAIT() asm volatile("s_waitcnt lgkmcnt(0)" ::: "memory")

namespace pg8 {
#define PG8_LAS __attribute__((address_space(3)))
constexpr int BM = 256, BK = 64, HALF = 128, HTB = HALF * BK * 2, STAGE_BYTES = 8 * HTB, NXCD = 8, WGM = 8;
__device__ __forceinline__ int lds_byte(int r, int c) { const int st = (r >> 4) * 2 + (c >> 5), rr = r & 15, cc = c & 31, ob = rr * 64 + cc * 2; return st * 1024 + (ob ^ (((ob >> 9) & 1) << 5)); }
__device__ __forceinline__ void stage_rc(int b, int& R, int& C) { const int st = b / 1024, sb = b % 1024, swz = sb ^ (((sb >> 9) & 1) << 5); R = (st >> 1) * 16 + swz / 64; C = (st & 1) * 32 + (swz % 64) / 2; }
__device__ __forceinline__ int perm32(int rho) { const int n = rho >> 4, i = rho & 15; return 8 * (i >> 2) + 4 * n + (i & 3); }

struct Unit { int pm, pn, seg; };
struct Gemm { const bf16_t* A; const bf16_t* Bt; size_t segA, segB; int M, N, K; };

struct Order {
    int nM, nN, nwg, G, c, nseg;
    __device__ void init(int M, int N, int G_, int c_, int nseg_) { nM = M / BM; nN = N / BM; nwg = nM * nN; G = G_; c = c_; nseg = nseg_; }
    __device__ bool next(int i, Unit& u) const {
        const int tile = i / nseg, seg = i - tile * nseg;
        const long L = (long)tile * G + c; if (L >= nwg) return false;
        int wgid = (int)L; { const int q = nwg / NXCD, r = nwg % NXCD, xcd = wgid % NXCD, off = wgid / NXCD; wgid = (xcd < r ? xcd * (q + 1) : r * (q + 1) + (xcd - r) * q) + off; }
        const int nig = WGM * nN, gid = wgid / nig, fm = gid * WGM, gsz = (nM - fm) < WGM ? (nM - fm) : WGM;
        u.pm = fm + ((wgid % nig) % gsz); u.pn = (wgid % nig) / gsz; u.seg = seg; return true;
    }
};

template <class Epi, bool ALIGN_EPI, bool SP2>
__device__ __forceinline__ void gemm_phase(PG8_LAS unsigned char* lds, const Gemm g, const Order& S, const Epi& E) {
    const int tid = threadIdx.x + opaque_vzero(), wid = __builtin_amdgcn_readfirstlane(tid >> 6), lane = tid & 63, wr = wid >> 2, wc = wid & 3, fr = lane & 15, fq = lane >> 4;
    const int K = g.K, nt = K / BK;
    unsigned voffA[2], voffB[2];
#pragma unroll
    for (int i = 0; i < 2; ++i) { int R, C; stage_rc(tid * 16 + i * 8192, R, C); const int Rb = Epi::PERM ? ((R & ~31) + perm32(R & 31)) : R;
        voffA[i] = (unsigned)(R * K + C) * 2u; voffB[i] = (unsigned)(Rb * K + C) * 2u; }
    const size_t kstep = (size_t)(BK * 2);
    const size_t hstep = (size_t)HALF * K * 2;
    const size_t tstep = 2 * hstep;
    const unsigned ldsw = (unsigned)wid * 1024u;
    const int aoff = lds_byte(wr * 64 + fr, fq * 8), boff = lds_byte(wc * 32 + fr, fq * 8);
#define PG8_SA(b, h) (((b) * 2 + (h)) * HTB)
#define PG8_SB(b, h) ((4 + (b) * 2 + (h)) * HTB)
#define PG8_STAGE(bufoff, gbase, voff) do { _Pragma("unroll") for (int _i = 0; _i < 2; ++_i) \
        __builtin_amdgcn_global_load_lds((const unsigned*)((const char*)(gbase) + (voff)[_i]), (PG8_LAS unsigned*)(lds + (bufoff) + ldsw + _i * 8192), 16, 0, 0); } while (0)
#define PG8_LDA(dst, b, h) do { _Pragma("unroll") for (int m = 0; m < 4; ++m) _Pragma("unroll") for (int k = 0; k < 2; ++k) dst[m][k] = *(const PG8_LAS bf16x8*)(lds + PG8_SA(b, h) + aoff + m * 2048 + k * 1024); } while (0)
#define PG8_LDB(dst, b, h) do { _Pragma("unroll") for (int n = 0; n < 2; ++n) _Pragma("unroll") for (int k = 0; k < 2; ++k) dst[n][k] = *(const PG8_LAS bf16x8*)(lds + PG8_SB(b, h) + boff + n * 2048 + k * 1024); } while (0)
#define PG8_MMA(ai, bj, At, Bt) do { __builtin_amdgcn_s_setprio(1); _Pragma("unroll") for (int m = 0; m < 4; ++m) _Pragma("unroll") for (int n = 0; n < 2; ++n) _Pragma("unroll") for (int k = 0; k < 2; ++k) \
        acc[ai][bj][m][n] = __builtin_amdgcn_mfma_f32_16x16x32_bf16(Bt[n][k], At[m][k], acc[ai][bj][m][n], 0, 0, 0); __builtin_amdgcn_s_setprio(0); } while (0)
#define PG8_WAIT_V(n) asm volatile("s_waitcnt vmcnt(" #n ")" ::: "memory")
#define PG8_WAIT_L(n) asm volatile("s_waitcnt lgkmcnt(" #n ")" ::: "memory")
#define PG8_BAR __builtin_amdgcn_s_barrier()
#define PG8_SCHED __builtin_amdgcn_sched_barrier(0)
    Unit cur, nxt; int ui = 0;
    if (!S.next(0, cur)) return;
    f32x4 acc[2][2][4][2];
#pragma unroll
    for (int a = 0; a < 2; ++a)
#pragma unroll
        for (int b = 0; b < 2; ++b)
#pragma unroll
            for (int m = 0; m < 4; ++m)
#pragma unroll
                for (int n = 0; n < 2; ++n) acc[a][b][m][n] = (f32x4){0.f, 0.f, 0.f, 0.f};
    bf16x8 At[4][2], B0[2][2], B1[2][2];
    const char* cA = (const char*)(g.A + cur.seg * g.segA) + (size_t)cur.pm * tstep; const char* cB = (const char*)(g.Bt + cur.seg * g.segB) + (size_t)cur.pn * tstep;
    if constexpr (SP2) {
        PG8_STAGE(PG8_SB(0, 0), cB, voffB); PG8_STAGE(PG8_SB(0, 1), cB + hstep, voffB); PG8_STAGE(PG8_SA(0, 0), cA, voffA); PG8_STAGE(PG8_SA(0, 1), cA + hstep, voffA);
        if (wr == 1) PG8_BAR;
        PG8_WAIT_V(2); PG8_BAR;
        PG8_STAGE(PG8_SB(1, 0), cB + kstep, voffB); PG8_STAGE(PG8_SA(1, 0), cA + kstep, voffA); PG8_STAGE(PG8_SB(1, 1), cB + hstep + kstep, voffB);
        PG8_WAIT_V(6); PG8_BAR;
    } else {
        PG8_STAGE(PG8_SB(0, 0), cB, voffB); PG8_STAGE(PG8_SA(0, 0), cA, voffA); PG8_STAGE(PG8_SB(0, 1), cB + hstep, voffB); PG8_STAGE(PG8_SA(0, 1), cA + hstep, voffA);
        if (wr == 1) PG8_BAR;
        PG8_WAIT_V(4); PG8_BAR;
        PG8_STAGE(PG8_SB(1, 0), cB + kstep, voffB); PG8_STAGE(PG8_SA(1, 0), cA + kstep, voffA); PG8_STAGE(PG8_SB(1, 1), cB + hstep + kstep, voffB);
        PG8_WAIT_V(6); PG8_BAR;
    }
    for (;;) {
        const bool has_next = S.next(ui + 1, nxt);
        const char* nA = has_next ? (const char*)(g.A + nxt.seg * g.segA) + (size_t)nxt.pm * tstep : cA; const char* nB = has_next ? (const char*)(g.Bt + nxt.seg * g.segB) + (size_t)nxt.pn * tstep : cB;
        for (int t = 0; t < nt; t += 2) {
            const bool last = (t == nt - 2);
            const char* a1 = cA + (size_t)(t + 1) * kstep;
            const char* a2 = last ? nA : cA + (size_t)(t + 2) * kstep; const char* b2 = last ? nB : cB + (size_t)(t + 2) * kstep;
            const char* a3 = a2 + kstep; const char* b3 = b2 + kstep;
            if constexpr (SP2) {
            PG8_LDB(B0, 0, 0); PG8_LDB(B1, 0, 1); PG8_SCHED; PG8_LDA(At, 0, 0); PG8_STAGE(PG8_SA(1, 1), a1 + hstep, voffA);
            PG8_WAIT_V(8); PG8_WAIT_L(0); PG8_BAR; PG8_MMA(0, 0, At, B0); PG8_MMA(0, 1, At, B1); PG8_BAR; PG8_SCHED;
            PG8_LDA(At, 0, 1); PG8_STAGE(PG8_SB(0, 0), b2, voffB); PG8_STAGE(PG8_SB(0, 1), b2 + hstep, voffB); PG8_STAGE(PG8_SA(0, 0), a2, voffA);
            PG8_WAIT_V(8); PG8_WAIT_L(0); PG8_BAR; PG8_MMA(1, 0, At, B0); PG8_MMA(1, 1, At, B1); PG8_BAR; PG8_SCHED;
            PG8_LDB(B0, 1, 0); PG8_LDB(B1, 1, 1); PG8_SCHED; PG8_LDA(At, 1, 0); PG8_STAGE(PG8_SA(0, 1), a2 + hstep, voffA);
            PG8_WAIT_V(8); PG8_WAIT_L(0); PG8_BAR; PG8_MMA(0, 0, At, B0); PG8_MMA(0, 1, At, B1); PG8_BAR; PG8_SCHED;
            PG8_LDA(At, 1, 1); PG8_STAGE(PG8_SB(1, 0), b3, voffB); PG8_STAGE(PG8_SB(1, 1), b3 + hstep, voffB); PG8_STAGE(PG8_SA(1, 0), a3, voffA);
            PG8_WAIT_V(8); PG8_WAIT_L(0); PG8_BAR; PG8_MMA(1, 0, At, B0); PG8_MMA(1, 1, At, B1); PG8_BAR; PG8_SCHED;
            } else {
            PG8_LDB(B0, 0, 0); PG8_SCHED; PG8_LDA(At, 0, 0); PG8_STAGE(PG8_SA(1, 1), a1 + hstep, voffA);
            PG8_WAIT_L(8); PG8_BAR; PG8_WAIT_L(0); PG8_MMA(0, 0, At, B0); PG8_BAR; PG8_SCHED;
            PG8_LDB(B1, 0, 1); PG8_STAGE(PG8_SB(0, 0), b2, voffB);
            PG8_BAR; PG8_WAIT_L(0); PG8_MMA(0, 1, At, B1); PG8_BAR;
            PG8_LDA(At, 0, 1); PG8_STAGE(PG8_SA(0, 0), a2, voffA);
            PG8_BAR; PG8_WAIT_L(0); PG8_MMA(1, 0, At, B0); PG8_BAR; PG8_SCHED;
            PG8_STAGE(PG8_SB(0, 1), b2 + hstep, voffB);
            PG8_WAIT_V(6); PG8_BAR; PG8_MMA(1, 1, At, B1); PG8_BAR;
            PG8_LDB(B0, 1, 0); PG8_SCHED; PG8_LDA(At, 1, 0); PG8_STAGE(PG8_SA(0, 1), a2 + hstep, voffA);
            PG8_WAIT_L(8); PG8_BAR; PG8_WAIT_L(0); PG8_MMA(0, 0, At, B0); PG8_BAR; PG8_SCHED;
            PG8_LDB(B1, 1, 1); PG8_STAGE(PG8_SB(1, 0), b3, voffB);
            PG8_BAR; PG8_WAIT_L(0); PG8_MMA(0, 1, At, B1); PG8_BAR;
            PG8_LDA(At, 1, 1); PG8_STAGE(PG8_SA(1, 0), a3, voffA);
            PG8_BAR; PG8_WAIT_L(0); PG8_MMA(1, 0, At, B0); PG8_BAR; PG8_SCHED;
            PG8_STAGE(PG8_SB(1, 1), b3 + hstep, voffB);
            PG8_WAIT_V(6); PG8_BAR; PG8_MMA(1, 1, At, B1); PG8_BAR;
            }
        }
        if constexpr (ALIGN_EPI) { if (wr == 0) PG8_BAR; }
        E(acc, cur, wr, wc, fr, fq);
        if (!has_next) break;
#pragma unroll
        for (int a = 0; a < 2; ++a)
#pragma unroll
            for (int b = 0; b < 2; ++b)
#pragma unroll
                for (int m = 0; m < 4; ++m)
#pragma unroll
                    for (int n = 0; n < 2; ++n) acc[a][b][m][n] = (f32x4){0.f, 0.f, 0.f, 0.f};
        cur = nxt; cA = nA; cB = nB; ++ui;
        if constexpr (ALIGN_EPI) { if (wr == 1) PG8_BAR; }
    }
    PG8_WAIT_V(0);
    if constexpr (!ALIGN_EPI) { if (wr == 0) PG8_BAR; }
    PG8_BAR;
#undef PG8_SA
#undef PG8_SB
#undef PG8_STAGE
#undef PG8_LDA
#undef PG8_LDB
#undef PG8_MMA
#undef PG8_WAIT_V
#undef PG8_WAIT_L
#undef PG8_BAR
#undef PG8_SCHED
}

typedef f32x4 Acc[2][2][4][2];

__device__ __forceinline__ u32x4 pack8(const f32x4 a, const f32x4 b) {
    u32x4 w; w.x = cvt_pk_bf16(a[0], a[1]); w.y = cvt_pk_bf16(a[2], a[3]); w.z = cvt_pk_bf16(b[0], b[1]); w.w = cvt_pk_bf16(b[2], b[3]); return w;
}

struct EpiSwiGLU {
    static constexpr bool PERM = true;
    bf16_t* H;
    __device__ __forceinline__ void operator()(const Acc& acc, const Unit& u, int wr, int wc, int fr, int fq) const {
        const int row0 = u.pm * BM + wr * 64 + fr, col0 = u.pn * HALF + wc * 32 + 8 * fq;
#pragma unroll
        for (int ai = 0; ai < 2; ++ai)
#pragma unroll
            for (int m = 0; m < 4; ++m) {
                bf16_t* rowp = H + (size_t)(row0 + ai * HALF + m * 16) * DFF + col0;
                f32x4 h0, h1;
#pragma unroll
                for (int j = 0; j < 4; ++j) { h0[j] = siluf_(acc[ai][0][m][0][j]) * acc[ai][1][m][0][j]; h1[j] = siluf_(acc[ai][0][m][1][j]) * acc[ai][1][m][1][j]; }
                *(u32x4*)rowp = pack8(h0, h1);
                __builtin_amdgcn_sched_barrier(0);
            }
    }
};

struct EpiResid {
    static constexpr bool PERM = false;
    const float* in0; const float* in1; float* out; const float* gate; float coef;
    __device__ __forceinline__ void operator()(const Acc& acc, const Unit& u, int wr, int wc, int fr, int fq) const {
        const int v = u.pm < 32 ? 0 : 1 + ((u.pm - 32) >> 4);
        const float* gv = gate + (size_t)v * MODW;
        const float* in = u.pm < 32 ? in0 : in1;
        const int col0 = u.pn * BM + wc * 32 + 4 * fq;
        f32x4 g[2][2];
#pragma unroll
        for (int bj = 0; bj < 2; ++bj)
#pragma unroll
            for (int n = 0; n < 2; ++n) g[bj][n] = *(const f32x4*)(gv + col0 + bj * HALF + n * 16) * coef;
#pragma unroll
        for (int ai = 0; ai < 2; ++ai) {
            f32x4 x[4][2][2];
#pragma unroll
            for (int m = 0; m < 4; ++m) {
                const size_t off = (size_t)(u.pm * BM + ai * HALF + wr * 64 + m * 16 + fr) * DM + col0;
#pragma unroll
                for (int bj = 0; bj < 2; ++bj)
#pragma unroll
                    for (int n = 0; n < 2; ++n) x[m][bj][n] = *(const f32x4*)(in + off + bj * HALF + n * 16);
            }
            __builtin_amdgcn_sched_barrier(0);
#pragma unroll
            for (int m = 0; m < 4; ++m) {
                const size_t off = (size_t)(u.pm * BM + ai * HALF + wr * 64 + m * 16 + fr) * DM + col0;
#pragma unroll
                for (int bj = 0; bj < 2; ++bj)
#pragma unroll
                    for (int n = 0; n < 2; ++n) *(f32x4*)(out + off + bj * HALF + n * 16) = x[m][bj][n] + g[bj][n] * acc[ai][bj][m][n];
            }
            __builtin_amdgcn_sched_barrier(0);
        }
    }
};

struct EpiWin {
    static constexpr bool PERM = true;
    bf16_t *GLU, *CH, *BG, *Q, *Kb, *Vb; const float *qg, *kg; float *newk, *newv; int layer;
    __device__ __forceinline__ void operator()(const Acc& acc, const Unit& u, int wr, int wc, int fr, int fq) const {
        const int row0 = u.pm * BM + wr * 64 + fr, cw = wc * 32 + 8 * fq, pn = u.pn;
        if (pn < 8) {
            bf16_t* O = (pn < 4 ? GLU : CH); const int col0 = (pn & 3) * HALF + cw;
#pragma unroll
            for (int ai = 0; ai < 2; ++ai)
#pragma unroll
                for (int m = 0; m < 4; ++m) {
                    f32x4 h0, h1;
                    if (pn < 4) {
#pragma unroll
                        for (int j = 0; j < 4; ++j) { h0[j] = acc[ai][0][m][0][j] * sigmoidf_(acc[ai][1][m][0][j]); h1[j] = acc[ai][0][m][1][j] * sigmoidf_(acc[ai][1][m][1][j]); }
                    } else { h0 = acc[ai][0][m][0] * acc[ai][1][m][0]; h1 = acc[ai][0][m][1] * acc[ai][1][m][1]; }
                    *(u32x4*)(O + (size_t)(row0 + ai * HALF + m * 16) * 512 + col0) = pack8(h0, h1);
                    __builtin_amdgcn_sched_barrier(0);
                }
        } else if (pn < 10 || pn >= 14) {
            bf16_t* O = (pn < 10 ? BG : Vb); const int colt = (pn < 10 ? pn - 8 : pn - 14) * BM + cw;
            const bool wnew = (pn >= 14) && (u.pm < 32);
#pragma unroll
            for (int ai = 0; ai < 2; ++ai)
#pragma unroll
                for (int m = 0; m < 4; ++m) {
                    const int row = row0 + ai * HALF + m * 16;
#pragma unroll
                    for (int bj = 0; bj < 2; ++bj) {
                        *(u32x4*)(O + (size_t)row * 512 + colt + bj * HALF) = pack8(acc[ai][bj][m][0], acc[ai][bj][m][1]);
                        if (wnew) { float* p = newv + ((size_t)(u.pm * 2 + layer) * 256 + (row - u.pm * BM)) * 512 + colt + bj * HALF;
                            *(f32x4*)p = acc[ai][bj][m][0]; *(f32x4*)(p + 4) = acc[ai][bj][m][1]; }
                    }
                    __builtin_amdgcn_sched_barrier(0);
                }
        } else {
            const bool isk = pn >= 12; bf16_t* O = isk ? Kb : Q; const float* gn = isk ? kg : qg;
            const int head = 4 * ((pn - 10) & 1) + wc; const bool wnew = isk && (u.pm < 32);
            f32x4 gv[2][2];
#pragma unroll
            for (int bj = 0; bj < 2; ++bj)
#pragma unroll
                for (int n = 0; n < 2; ++n) gv[bj][n] = *(const f32x4*)(gn + 32 * bj + 8 * fq + 4 * n);
#pragma unroll
            for (int ai = 0; ai < 2; ++ai)
#pragma unroll
                for (int m = 0; m < 4; ++m) {
                    const int row = row0 + ai * HALF + m * 16;
                    float ss = 0.f;
#pragma unroll
                    for (int bj = 0; bj < 2; ++bj)
#pragma unroll
                        for (int n = 0; n < 2; ++n) { const f32x4 x = acc[ai][bj][m][n]; ss += (x[0] * x[0] + x[1] * x[1]) + (x[2] * x[2] + x[3] * x[3]); }
                    ss += __shfl_xor(ss, 16); ss += __shfl_xor(ss, 32);
                    const float rinv = __builtin_amdgcn_rsqf(ss * (1.f / 64.f) + EPS);
#pragma unroll
                    for (int bj = 0; bj < 2; ++bj) {
                        const f32x4 y0 = acc[ai][bj][m][0] * rinv * gv[bj][0], y1 = acc[ai][bj][m][1] * rinv * gv[bj][1];
                        const int col = head * 64 + 32 * bj + 8 * fq;
                        *(u32x4*)(O + (size_t)row * 512 + col) = pack8(y0, y1);
                        if (wnew) { float* p = newk + ((size_t)(u.pm * 2 + layer) * 256 + (row - u.pm * BM)) * 512 + col; *(f32x4*)p = y0; *(f32x4*)(p + 4) = y1; }
                    }
                    __builtin_amdgcn_sched_barrier(0);
                }
        }
    }
};

struct EpiGates {
    static constexpr bool PERM = true;
    bf16_t* GS;
    __device__ __forceinline__ void operator()(const Acc& acc, const Unit& u, int wr, int wc, int fr, int fq) const {
        const int gi = u.pn >> 2; const int bi = gi == 0 ? 2 : gi - 1; bf16_t* O = GS + (size_t)bi * GS_STRIDE;
        const int row0 = u.pm * BM + wr * 64 + fr, col0 = (u.pn & 3) * BM + wc * 32 + 8 * fq;
#pragma unroll
        for (int ai = 0; ai < 2; ++ai)
#pragma unroll
            for (int m = 0; m < 4; ++m)
#pragma unroll
                for (int bj = 0; bj < 2; ++bj) {
                    f32x4 h0, h1;
#pragma unroll
                    for (int j = 0; j < 4; ++j) { h0[j] = sigmoidf_(acc[ai][bj][m][0][j]); h1[j] = sigmoidf_(acc[ai][bj][m][1][j]); }
                    *(u32x4*)(O + (size_t)(row0 + ai * HALF + m * 16) * DM + col0 + bj * HALF) = pack8(h0, h1);
                    __builtin_amdgcn_sched_barrier(0);
                }
    }
};

struct EpiM {
    static constexpr bool PERM = true;
    const bf16_t* GS; bf16_t* Mo;
    __device__ __forceinline__ void operator()(const Acc& acc, const Unit& u, int wr, int wc, int fr, int fq) const {
        const bf16_t* Gs = GS + (size_t)u.seg * GS_STRIDE;
        const int row0 = u.pm * BM + wr * 64 + fr, col0 = u.pn * BM + wc * 32 + 8 * fq;
#pragma unroll
        for (int ai = 0; ai < 2; ++ai) {
            u32x4 gw[4][2], mw[4][2];
#pragma unroll
            for (int m = 0; m < 4; ++m)
#pragma unroll
                for (int bj = 0; bj < 2; ++bj) {
                    const size_t off = (size_t)(row0 + ai * HALF + m * 16) * DM + col0 + bj * HALF;
                    gw[m][bj] = *(const u32x4*)(Gs + off);
                    mw[m][bj] = (u32x4){0u, 0u, 0u, 0u};
                    if (u.seg != 0) mw[m][bj] = *(const u32x4*)(Mo + off);
                }
            __builtin_amdgcn_sched_barrier(0);
#pragma unroll
            for (int m = 0; m < 4; ++m)
#pragma unroll
                for (int bj = 0; bj < 2; ++bj) {
                    const size_t off = (size_t)(row0 + ai * HALF + m * 16) * DM + col0 + bj * HALF;
                    const u32x4 g4 = gw[m][bj], m4 = mw[m][bj];
                    f32x4 h0, h1;
                    h0[0] = bflo(g4.x) * acc[ai][bj][m][0][0] + bflo(m4.x); h0[1] = bfhi(g4.x) * acc[ai][bj][m][0][1] + bfhi(m4.x);
                    h0[2] = bflo(g4.y) * acc[ai][bj][m][0][2] + bflo(m4.y); h0[3] = bfhi(g4.y) * acc[ai][bj][m][0][3] + bfhi(m4.y);
                    h1[0] = bflo(g4.z) * acc[ai][bj][m][1][0] + bflo(m4.z); h1[1] = bfhi(g4.z) * acc[ai][bj][m][1][1] + bfhi(m4.z);
                    h1[2] = bflo(g4.w) * acc[ai][bj][m][1][2] + bflo(m4.w); h1[3] = bfhi(g4.w) * acc[ai][bj][m][1][3] + bfhi(m4.w);
                    *(u32x4*)(Mo + off) = pack8(h0, h1);
                }
            __builtin_amdgcn_sched_barrier(0);
        }
    }
};
}

struct Args { const float* in[32]; };
__device__ __forceinline__ const float* inp(const Args& a, int i) { return a.in[i + opaque_zero()]; }

__device__ __forceinline__ void cvt_block(const float* W, int N, int K, int k0, int n0, bf16_t* WT, int dst_row0, float* scr, int lane) {
#pragma unroll 8
    for (int i = 0; i < 32; ++i) { const int kk = 2 * i + (lane >> 5); scr[kk * 33 + (lane & 31)] = W[(size_t)(k0 + kk) * N + n0 + (lane & 31)]; }
    LDS_WAIT();
    const int c = lane & 7;
#pragma unroll
    for (int j = 0; j < 4; ++j) { const int n = (lane >> 3) + 8 * j; const float* s = scr + (8 * c) * 33 + n;
        u32x4 o; o.x = pk2(s[0 * 33], s[1 * 33]); o.y = pk2(s[2 * 33], s[3 * 33]); o.z = pk2(s[4 * 33], s[5 * 33]); o.w = pk2(s[6 * 33], s[7 * 33]);
        *(u32x4*)(WT + (size_t)(dst_row0 + n) * K + k0 + 8 * c) = o; }
    LDS_WAIT();
}
__device__ __forceinline__ int win_dst(int n) {
    if (n < 512) return 256 * (n >> 7) + (n & 127);
    if (n < 1024) { const int s = n - 512; return 256 * (s >> 7) + 128 + (s & 127); }
    if (n < 1536) return 2048 + (n - 1024);
    if (n < 2048) { const int s = n - 1536; return 1024 + 256 * (s >> 7) + (s & 127); }
    if (n < 2560) { const int s = n - 2048; return 1024 + 256 * (s >> 7) + 128 + (s & 127); }
    if (n < 3584) { const int base = n < 3072 ? 2560 : 3072; const int s = n - base, head = s >> 6, dim = s & 63;
        return base + 256 * (head >> 2) + 128 * (dim >> 5) + 32 * (head & 3) + (dim & 31); }
    return n;
}
__device__ __forceinline__ void convert_weights(const Args& a, int l, unsigned char* lds, int gw, int ngw, int wave, int lane) {
    float* scr = (float*)(lds + wave * 8448);
    unsigned char* ws = (unsigned char*)inp(a, 31);
    constexpr int I_GU = 16 * 88, I_D = 44 * 32, I_IN = 16 * 224, I_O = 8 * 32, I_M = 16 * 32;
    constexpr int NIT = 6 * I_GU + I_IN + 3 * I_O + I_M;
    static_assert(I_GU == I_D, "");
    for (int it = gw; it < NIT; it += ngw) {
        int r = it;
        if (r < 6 * I_GU) {
            const int which = r / I_GU; r -= which * I_GU;
            const int ff = which / 3, kind = which % 3;
            if (kind < 2) {
                const float* W = inp(a, (ff ? 27 : 9) + kind) + (size_t)l * DM * DFF;
                const int kb = r / 88, nb = r % 88, n0 = nb * 32;
                cvt_block(W, DFF, DM, kb * 64, n0, (bf16_t*)(ws + (ff ? W_GU2 : W_GU1)), 256 * (n0 >> 7) + 128 * kind + (n0 & 127), scr, lane);
            } else {
                const float* W = inp(a, ff ? 29 : 11) + (size_t)l * DFF * DM;
                const int kb = r / 32, nb = r % 32;
                cvt_block(W, DM, DFF, kb * 64, nb * 32, (bf16_t*)(ws + (ff ? W_D2 : W_D1)), nb * 32, scr, lane);
            }
            continue;
        }
        r -= 6 * I_GU;
        if (r < I_IN) { const int kb = r / 224, nb = r % 224; cvt_block(inp(a, 13) + (size_t)l * DM * NIN, NIN, DM, kb * 64, nb * 32, (bf16_t*)(ws + W_IN), win_dst(nb * 32), scr, lane); continue; }
        r -= I_IN;
        if (r < 3 * I_O) { const int which = r / I_O; r -= which * I_O; const int kb = r / 32, nb = r % 32;
            const float* W = inp(a, which == 0 ? 18 : (which == 1 ? 20 : 24)) + (size_t)l * 512 * DM;
            cvt_block(W, DM, 512, kb * 64, nb * 32, (bf16_t*)(ws + (which == 0 ? W_A : (which == 1 ? W_B : W_C))), nb * 32, scr, lane); continue; }
        r -= 3 * I_O;
        { const int kb = r / 32, nb = r % 32; cvt_block(inp(a, 25) + (size_t)l * DM * DM, DM, DM, kb * 64, nb * 32, (bf16_t*)(ws + W_M), nb * 32, scr, lane); }
    }
}

__device__ __forceinline__ void compute_mods(const Args& a, unsigned char* lds, int tid, int wave, int lane) {
    float* sT = (float*)lds;
    float* red = (float*)(lds + 49152);
    const float* c = inp(a, 4); const float* cctx = inp(a, 5);
    for (int k = tid; k < DM; k += NTHR) {
        sT[k * 12 + 0] = siluf_(cctx[k]);
#pragma unroll
        for (int v = 1; v < 9; ++v) sT[k * 12 + v] = siluf_(c[(v - 1) * DM + k]);
        sT[k * 12 + 9] = 0.f; sT[k * 12 + 10] = 0.f; sT[k * 12 + 11] = 0.f;
    }
    __syncthreads();
    float* mods = (float*)((unsigned char*)inp(a, 31) + WS_MODS);
    for (int unit = blockIdx.x; unit < 288; unit += gridDim.x) {
        const int l = unit / 144, cb = unit % 144, col = cb * 64 + lane;
        const float* W = inp(a, 6) + (size_t)l * DM * MODW + col;
        float acc[9];
#pragma unroll
        for (int v = 0; v < 9; ++v) acc[v] = 0.f;
#pragma unroll 8
        for (int kk = 0; kk < 128; ++kk) {
            const int k = wave * 128 + kk;
            const float w = W[(size_t)k * MODW];
            const f32x4 s0 = *(const f32x4*)(sT + k * 12), s1 = *(const f32x4*)(sT + k * 12 + 4), s2 = *(const f32x4*)(sT + k * 12 + 8);
            acc[0] += s0[0] * w; acc[1] += s0[1] * w; acc[2] += s0[2] * w; acc[3] += s0[3] * w;
            acc[4] += s1[0] * w; acc[5] += s1[1] * w; acc[6] += s1[2] * w; acc[7] += s1[3] * w; acc[8] += s2[0] * w;
        }
#pragma unroll
        for (int v = 0; v < 9; ++v) red[(wave * 9 + v) * 64 + lane] = acc[v];
        __syncthreads();
        for (int idx = tid; idx < 576; idx += NTHR) {
            const int v = idx >> 6, ln = idx & 63; float s = inp(a, 7)[(size_t)l * MODW + cb * 64 + ln];
#pragma unroll
            for (int w = 0; w < 8; ++w) s += red[(w * 9 + v) * 64 + ln];
            mods[((size_t)l * 9 + v) * MODW + cb * 64 + ln] = s;
        }
        __syncthreads();
    }
}

__device__ __forceinline__ void adaln_phase(const float* in0, const float* in1, const float* g, const float* modl, int ish, bf16_t* U, int gw, int ngw, int lane) {
    static_assert(MTOK % (2 * 256 * NWAVES) == 0, "row pairs");
    for (int row0 = gw; row0 < MTOK; row0 += 2 * ngw) {
        f32x4 x[2][4];
#pragma unroll
        for (int h = 0; h < 2; ++h) { const int row = min(row0 + h * ngw, MTOK - 1); const float* xr = (row < NCTX ? in0 : in1) + (size_t)row * DM;
#pragma unroll
            for (int j = 0; j < 4; ++j) x[h][j] = *(const f32x4*)(xr + 256 * j + 4 * lane); }
#pragma unroll
        for (int h = 0; h < 2; ++h) {
            const int row = row0 + h * ngw; if (row >= MTOK) break;
            const int v = row < NCTX ? 0 : 1 + ((row - NCTX) >> 12);
            const float* sh = modl + (size_t)v * MODW + ish * DM; const float* sc = sh + DM;
            float ss = 0.f;
#pragma unroll
            for (int j = 0; j < 4; ++j) ss += (x[h][j][0] * x[h][j][0] + x[h][j][1] * x[h][j][1]) + (x[h][j][2] * x[h][j][2] + x[h][j][3] * x[h][j][3]);
            const float rinv = __builtin_amdgcn_rsqf(wave_sum(ss) * (1.f / DM) + EPS);
#pragma unroll
            for (int j = 0; j < 4; ++j) {
                const int c = 256 * j + 4 * lane;
                const f32x4 gg = *(const f32x4*)(g + c), s1 = *(const f32x4*)(sc + c), s0 = *(const f32x4*)(sh + c);
                const f32x4 y = x[h][j] * rinv * gg * (s1 + 1.f) + s0;
                u32x2 w; w.x = pk2(y[0], y[1]); w.y = pk2(y[2], y[3]);
                *(u32x2*)(U + (size_t)row * DM + c) = w;
            }
        }
    }
}

namespace att {
constexpr int TK = 128, PITCH = 272, KS_OFF = 0, VS_OFF = TK * PITCH, RPB_OFF = 2 * TK * PITCH;
typedef short v4i16_t __attribute__((ext_vector_type(4)));
__device__ __forceinline__ s16x4 vtr(const LAS char* p) { return __builtin_bit_cast(s16x4, __builtin_amdgcn_ds_read_tr16_b64_v4i16((LAS v4i16_t*)p)); }

struct TileSrc { const bf16_t* k; const bf16_t* v; };

template <bool LOCAL>
__device__ __forceinline__ void tile_compute(const LAS char* ldsb, const bf16x8 (&qf)[2], f32x4 (&O)[4], float& mrun, float& lrun,
                                             int hl, int koff, int fr, int fq, int lane, const float* rpbrow, const int (&dci)[8], unsigned vmask) {
    constexpr int NMT = LOCAL ? 4 : 8;
#define ATT_KEYOFF(mt) (LOCAL ? (((mt) >> 1) * 64 + koff + 16 * ((mt) & 1)) : 16 * (mt))
    f32x4 s[NMT];
#pragma unroll
    for (int mt = 0; mt < NMT; ++mt) {
        s[mt] = (f32x4){0.f, 0.f, 0.f, 0.f};
#pragma unroll
        for (int ks = 0; ks < 2; ++ks) {
            const bf16x8 kf = *(const LAS bf16x8*)(ldsb + KS_OFF + (ATT_KEYOFF(mt) + fr) * PITCH + hl * 128 + ks * 64 + fq * 16);
            s[mt] = __builtin_amdgcn_mfma_f32_16x16x32_bf16(kf, qf[ks], s[mt], 0, 0, 0);
        }
    }
    constexpr float C1 = 0.125f * 1.4426950408889634f;
    float tmax = -1e30f;
    if (LOCAL) {
#pragma unroll
        for (int mt = 0; mt < NMT; ++mt)
#pragma unroll
            for (int j = 0; j < 4; ++j) {
                float v = __builtin_fmaf(s[mt][j], C1, rpbrow[(mt >> 1) * 32 + dci[(mt & 1) * 4 + j]]);
                if (!((vmask >> ((mt & 1) * 4 + j)) & 1u)) v = -1e30f;
                s[mt][j] = v; tmax = fmaxf(tmax, v);
            }
    } else {
#pragma unroll
        for (int mt = 0; mt < NMT; ++mt)
#pragma unroll
            for (int j = 0; j < 4; ++j) tmax = fmaxf(tmax, s[mt][j]);
        tmax *= C1;
    }
    tmax = fmaxf(tmax, __shfl_xor(tmax, 16)); tmax = fmaxf(tmax, __shfl_xor(tmax, 32));
    const float mnew = fmaxf(mrun, tmax), alpha = __builtin_amdgcn_exp2f(mrun - mnew);
    float psum = 0.f;
#pragma unroll
    for (int mt = 0; mt < NMT; ++mt)
#pragma unroll
        for (int j = 0; j < 4; ++j) { const float p = __builtin_amdgcn_exp2f(LOCAL ? s[mt][j] - mnew : __builtin_fmaf(s[mt][j], C1, -mnew)); s[mt][j] = p; psum += p; }
    lrun = lrun * alpha + psum; mrun = mnew;
#pragma unroll
    for (int dt = 0; dt < 4; ++dt) O[dt] = O[dt] * alpha;
    const int g = lane >> 4, q = (lane & 15) >> 2, p4 = lane & 3;
#pragma unroll
    for (int kk = 0; kk < NMT / 2; ++kk) {
        bf16x8 pb;
        { const u32x4 w = pg8::pack8(s[2 * kk], s[2 * kk + 1]); pb = __builtin_bit_cast(bf16x8, w); }
#pragma unroll
        for (int dt = 0; dt < 4; ++dt) {
            const LAS char* vb = ldsb + VS_OFF + hl * 128 + 32 * dt + 8 * p4;
            const s16x4 v0 = vtr(vb + (ATT_KEYOFF(2 * kk) + 4 * g + q) * PITCH);
            const s16x4 v1 = vtr(vb + (ATT_KEYOFF(2 * kk + 1) + 4 * g + q) * PITCH);
            bf16x8 vf; vf[0] = v0[0]; vf[1] = v0[1]; vf[2] = v0[2]; vf[3] = v0[3]; vf[4] = v1[0]; vf[5] = v1[1]; vf[6] = v1[2]; vf[7] = v1[3];
            O[dt] = __builtin_amdgcn_mfma_f32_16x16x32_bf16(vf, pb, O[dt], 0, 0, 0);
        }
    }
#undef ATT_KEYOFF
}

template <bool LATENT>
__device__ __forceinline__ void unit(unsigned char* lds, bf16_t* QO, const bf16_t* Kb, const bf16_t* Vb, const bf16_t* CK, const bf16_t* CV, const float* rpb_l,
                                     int qrow0  , int keyrow0  , int hp, int r  ,
                                     int tid, int wave, int lane) {
    const LAS char* ldsb = (const LAS char*)(LAS unsigned char*)lds;
    const int hl = wave >> 2, J = wave & 3, fr = lane & 15, fq = lane >> 4;
    const int rs = LATENT ? min(max(r - 4, 0), 56) : 0;
    constexpr int NT = LATENT ? 8 : 2;
    int dci[8]; unsigned vmask = 0u; int koff = 0;
    if (LATENT) {
        const int qc = 16 * J + fr, wstart = min(max(qc - 8, 0), 48);
        koff = min(max(16 * J - 8, 0), 32);
#pragma unroll
        for (int mt = 0; mt < 2; ++mt)
#pragma unroll
            for (int j = 0; j < 4; ++j) { const int kc = koff + 16 * mt + 4 * fq + j;
                dci[mt * 4 + j] = min(max(kc - qc, -15), 15) + 15;
                if (kc >= wstart && kc < wstart + 16) vmask |= 1u << (mt * 4 + j); }
        float* tb = (float*)(lds + RPB_OFF);
        for (int i = tid; i < 2 * 15 * 32; i += NTHR) { const int h2 = i / 480, rem = i % 480, dr = rem >> 5, dc = rem & 31;
            tb[i] = dc < 31 ? rpb_l[((2 * hp + h2) * 15 + dr) * 31 + dc] * 1.4426950408889634f : 0.f; }
    } else {
#pragma unroll
        for (int i = 0; i < 8; ++i) dci[i] = 0;
    }
    bf16x8 qf[2];
    { const bf16_t* qp = QO + (size_t)(qrow0 + 16 * J + fr) * 512 + (2 * hp + hl) * 64 + 8 * fq;
      qf[0] = *(const bf16x8*)qp; qf[1] = *(const bf16x8*)(qp + 32); }
    f32x4 O[4];
#pragma unroll
    for (int dt = 0; dt < 4; ++dt) O[dt] = (f32x4){0.f, 0.f, 0.f, 0.f};
    float mrun = -1e30f, lrun = 0.f;
    const int key0 = tid >> 4, part = tid & 15;
    u32x4 kA[4], vA[4], kB[4], vB[4];
    auto tsrc = [&](int t) -> TileSrc {
        TileSrc s;
        if (LATENT) {
            if (t < 4) { s.k = CK + (size_t)(t * TK) * 512 + hp * 128; s.v = CV + (size_t)(t * TK) * 512 + hp * 128; }
            else { const size_t ro = (size_t)(keyrow0 + (rs + 2 * (t - 4)) * 64) * 512 + hp * 128; s.k = Kb + ro; s.v = Vb + ro; }
        } else { const size_t ro = (size_t)(keyrow0 + t * TK) * 512 + hp * 128; s.k = Kb + ro; s.v = Vb + ro; }
        return s;
    };
#define ATT_GLOAD(KR, VR, t) do { const TileSrc s_ = tsrc(t); _Pragma("unroll") for (int i = 0; i < 4; ++i) { const size_t o = (size_t)(key0 + 32 * i) * 512 + part * 8; \
        KR[i] = *(const u32x4*)(s_.k + o); VR[i] = *(const u32x4*)(s_.v + o); } } while (0)
#define ATT_BAR() do { asm volatile("s_waitcnt lgkmcnt(0)" ::: "memory"); __builtin_amdgcn_s_barrier(); asm volatile("" ::: "memory"); } while (0)
#define ATT_LSTORE(KR, VR) do { _Pragma("unroll") for (int i = 0; i < 4; ++i) { const int lo = (key0 + 32 * i) * PITCH + part * 16; \
        *(u32x4*)(lds + KS_OFF + lo) = KR[i]; *(u32x4*)(lds + VS_OFF + lo) = VR[i]; } } while (0)
#define ATT_COMPUTE(t) do { if (LATENT && (t) >= 4) { const int dr = (rs + 2 * ((t) - 4)) - r + 7; \
            const float* rpbrow = (const float*)(lds + RPB_OFF) + (hl * 15 + dr) * 32; \
            tile_compute<true>(ldsb, qf, O, mrun, lrun, hl, koff, fr, fq, lane, rpbrow, dci, vmask); \
        } else { tile_compute<false>(ldsb, qf, O, mrun, lrun, hl, 0, fr, fq, lane, nullptr, dci, 0u); } } while (0)
    ATT_GLOAD(kA, vA, 0); ATT_GLOAD(kB, vB, 1);
    for (int t = 0; t < NT; t += 2) {
        ATT_BAR();
        ATT_LSTORE(kA, vA);
        ATT_BAR();
        if (t + 2 < NT) ATT_GLOAD(kA, vA, t + 2);
        ATT_COMPUTE(t);
        ATT_BAR();
        ATT_LSTORE(kB, vB);
        ATT_BAR();
        if (t + 3 < NT) ATT_GLOAD(kB, vB, t + 3);
        ATT_COMPUTE(t + 1);
    }
#undef ATT_GLOAD
#undef ATT_BAR
#undef ATT_LSTORE
#undef ATT_COMPUTE
    lrun += __shfl_xor(lrun, 16); lrun += __shfl_xor(lrun, 32);
    const float linv = 1.f / lrun;
    bf16_t* op = QO + (size_t)(qrow0 + 16 * J + fr) * 512 + (2 * hp + hl) * 64 + 4 * fq;
#pragma unroll
    for (int dt = 0; dt < 4; ++dt) { u32x2 w; w.x = cvt_pk_bf16(O[dt][0] * linv, O[dt][1] * linv); w.y = cvt_pk_bf16(O[dt][2] * linv, O[dt][3] * linv); *(u32x2*)(op + 16 * dt) = w; }
    __syncthreads();
}
}

__device__ __forceinline__ void conva_unit(unsigned char* lds, const bf16_t* GLU, bf16_t* AOUT, const float* cw, const float* cb, const float* lg, const float* lb,
                                           int rowbase, int len, int t0, int tid, int wave, int lane) {
    bf16_t* in_s = (bf16_t*)lds;
    float* hs = (float*)(lds + 62 * 512 * 2);
    for (int idx = tid; idx < 62 * 64; idx += NTHR) {
        const int i = idx >> 6, ch = idx & 63, p = t0 - 15 + i;
        u32x4 v = (u32x4){0u, 0u, 0u, 0u};
        if (p >= 0 && p < len) v = *(const u32x4*)(GLU + (size_t)(rowbase + p) * 512 + ch * 8);
        *(u32x4*)(in_s + i * 512 + ch * 8) = v;
    }
    float w[31];
#pragma unroll
    for (int j = 0; j < 31; ++j) w[j] = cw[j * 512 + tid];
    const float bias = cb[tid];
    __syncthreads();
    float col[62];
#pragma unroll
    for (int i = 0; i < 62; ++i) col[i] = __uint_as_float((unsigned)in_s[i * 512 + tid] << 16);
#pragma unroll
    for (int tt = 0; tt < 32; ++tt) {
        float acc = bias;
#pragma unroll
        for (int j = 0; j < 31; ++j) acc += col[tt + j] * w[j];
        hs[tt * 512 + tid] = acc;
    }
    __syncthreads();
#pragma unroll
    for (int q = 0; q < 4; ++q) {
        const int tt = wave * 4 + q;
        const f32x4 a = *(const f32x4*)(hs + tt * 512 + lane * 8), b = *(const f32x4*)(hs + tt * 512 + lane * 8 + 4);
        const float mean = wave_sum((a[0] + a[1]) + (a[2] + a[3]) + (b[0] + b[1]) + (b[2] + b[3])) * (1.f / 512.f);
        const f32x4 da = a - mean, db = b - mean;
        const float var = wave_sum((da[0] * da[0] + da[1] * da[1]) + (da[2] * da[2] + da[3] * da[3]) + (db[0] * db[0] + db[1] * db[1]) + (db[2] * db[2] + db[3] * db[3])) * (1.f / 512.f);
        const float rstd = __builtin_amdgcn_rsqf(var + EPS);
        const f32x4 g0 = *(const f32x4*)(lg + lane * 8), g1 = *(const f32x4*)(lg + lane * 8 + 4), b0 = *(const f32x4*)(lb + lane * 8), b1 = *(const f32x4*)(lb + lane * 8 + 4);
        f32x4 y0 = da * rstd * g0 + b0, y1 = db * rstd * g1 + b1;
#pragma unroll
        for (int j = 0; j < 4; ++j) { y0[j] = siluf_(y0[j]); y1[j] = siluf_(y1[j]); }
        *(u32x4*)(AOUT + (size_t)(rowbase + t0 + tt) * 512 + lane * 8) = pg8::pack8(y0, y1);
    }
    __syncthreads();
}

__device__ __forceinline__ void convb_phase(bf16_t* BG, const bf16_t* CH, const float* w3, int gtid, int nthreads) {
    for (int idx = gtid; idx < MTOK * 64; idx += nthreads) {
        const int row = idx >> 6, ch = idx & 63;
        int pos, len; if (row < NCTX) { pos = row & 255; len = 256; } else { pos = (row - NCTX) & 4095; len = 4096; }
        const u32x4 z = (u32x4){0u, 0u, 0u, 0u};
        const u32x4 c1 = *(const u32x4*)(CH + (size_t)row * 512 + ch * 8);
        const u32x4 c0 = pos > 0 ? *(const u32x4*)(CH + (size_t)(row - 1) * 512 + ch * 8) : z;
        const u32x4 c2 = pos < len - 1 ? *(const u32x4*)(CH + (size_t)(row + 1) * 512 + ch * 8) : z;
        const u32x4 bg = *(const u32x4*)(BG + (size_t)row * 512 + ch * 8);
        f32x4 wa[3], wb[3];
#pragma unroll
        for (int j = 0; j < 3; ++j) { wa[j] = *(const f32x4*)(w3 + j * 512 + ch * 8); wb[j] = *(const f32x4*)(w3 + j * 512 + ch * 8 + 4); }
        f32x4 y0, y1;
#define CB_(o, k, W, c0w, c1w, c2w, bgw, F) o[k] = F(bgw) * (F(c0w) * W[0][k] + F(c1w) * W[1][k] + F(c2w) * W[2][k])
        CB_(y0, 0, wa, c0.x, c1.x, c2.x, bg.x, bflo); CB_(y0, 1, wa, c0.x, c1.x, c2.x, bg.x, bfhi);
        CB_(y0, 2, wa, c0.y, c1.y, c2.y, bg.y, bflo); CB_(y0, 3, wa, c0.y, c1.y, c2.y, bg.y, bfhi);
        CB_(y1, 0, wb, c0.z, c1.z, c2.z, bg.z, bflo); CB_(y1, 1, wb, c0.z, c1.z, c2.z, bg.z, bfhi);
        CB_(y1, 2, wb, c0.w, c1.w, c2.w, bg.w, bflo); CB_(y1, 3, wb, c0.w, c1.w, c2.w, bg.w, bfhi);
#undef CB_
        *(u32x4*)(BG + (size_t)row * 512 + ch * 8) = pg8::pack8(y0, y1);
    }
}

#define XB_TMO      128
#define XB_XCNT(j)  (256  + 64 * (j))
#define XB_XSUB(j)  (1280 + 64 * (j))
#define XB_XGEN(j)  (2304 + 64 * (j))
#define XB_TOP      3328
#define XB_TOPGEN   3392
#define XCD_BAR_WORDS 3456
#define XB_SPIN_CAP (1u << 18)

__device__ __forceinline__ unsigned xb_ld(unsigned* p)              { return __hip_atomic_load(p, __ATOMIC_RELAXED, __HIP_MEMORY_SCOPE_AGENT); }
__device__ __forceinline__ unsigned xb_add(unsigned* p, unsigned v) { return __hip_atomic_fetch_add(p, v, __ATOMIC_RELAXED, __HIP_MEMORY_SCOPE_AGENT); }
__device__ __forceinline__ unsigned xb_xcc_id() { return (unsigned)__builtin_amdgcn_s_getreg((3 << 11) | 20) & 0xFu; }
#define XB_SPIN(cond, bar) do { unsigned _sp = 0; while (cond) { __builtin_amdgcn_s_sleep(1); \
    if ((++_sp & 255u) == 0u) { if (xb_ld(&(bar)[XB_TMO])) break; if (_sp > XB_SPIN_CAP) { atomicAdd(&(bar)[XB_TMO], 1u); break; } } } } while (0)

struct XcdBarrier {
    unsigned* bar; unsigned x;
    volatile LAS unsigned* st;
};

__device__ __forceinline__ XcdBarrier xcd_barrier_post(unsigned* bar, volatile LAS unsigned* st) {
    XcdBarrier b; b.bar = bar; b.x = xb_xcc_id(); b.st = st;
    if (threadIdx.x == 0) (void)xb_add(&bar[XB_XCNT(b.x)], 1u);
    return b;
}
__device__ __forceinline__ void xcd_barrier_complete(unsigned* bar, unsigned x, unsigned& nloc, unsigned& nx) {
    const unsigned G = gridDim.x * gridDim.y * gridDim.z;
    unsigned sum, cnt, mine, sp = 0u;
    for (;;) {
        sum = 0u; cnt = 0u; mine = 0u;
#pragma unroll
        for (unsigned j = 0; j < 16; ++j) { const unsigned c = xb_ld(&bar[XB_XCNT(j)]); sum += c; cnt += (c > 0u) ? 1u : 0u; mine = (j == x) ? c : mine; }
        if (sum == G) break;
        __builtin_amdgcn_s_sleep(1);
        if ((++sp & 255u) == 0u) { if (xb_ld(&bar[XB_TMO])) break; if (sp > XB_SPIN_CAP) { atomicAdd(&bar[XB_TMO], 1u); break; } }
    }
    nloc = mine > 0u ? mine : 1u; nx = cnt > 0u ? cnt : 1u;
}

__device__ __forceinline__ void xcd_barrier(const XcdBarrier& b) {
    asm volatile("s_waitcnt vmcnt(0)" ::: "memory");
    __syncthreads();
    if (threadIdx.x == 0) {
        unsigned* bar = b.bar;
        __builtin_amdgcn_s_waitcnt(0);
        unsigned nloc = b.st[0], nx = b.st[1];
        if (nloc == 0u) { xcd_barrier_complete(bar, b.x, nloc, nx); b.st[0] = nloc; b.st[1] = nx; }
        const unsigned old = xb_add(&bar[XB_XSUB(b.x)], 1u);
        const unsigned gen = old / nloc;
        if (old + 1u == (gen + 1u) * nloc) {
            __builtin_amdgcn_fence(__ATOMIC_RELEASE, "agent");
            asm volatile("s_waitcnt vmcnt(0)" ::: "memory");
            const unsigned og = xb_add(&bar[XB_TOP], 1u);
            const unsigned tg = og / nx;
            if (og + 1u == (tg + 1u) * nx) xb_add(&bar[XB_TOPGEN], 1u);
            else XB_SPIN(xb_ld(&bar[XB_TOPGEN]) == tg, bar);
            __builtin_amdgcn_fence(__ATOMIC_ACQUIRE, "agent");
            xb_add(&bar[XB_XGEN(b.x)], 1u);
            asm volatile("s_waitcnt vmcnt(0)" ::: "memory");
        } else {
            XB_SPIN(xb_ld(&bar[XB_XGEN(b.x)]) == gen, bar);
            __builtin_amdgcn_fence(__ATOMIC_ACQUIRE, "agent");
            asm volatile("s_waitcnt vmcnt(0)" ::: "memory");
        }
    }
    __syncthreads();
}


#ifndef PHASE_MASK
#define PHASE_MASK 0xFFFFF
#endif
#define PH_ON(n) ((PHASE_MASK >> (n)) & 1)
#ifndef LAST_PHASE
#define LAST_PHASE 99
#endif
#define PHX(n) if (l * 12 + (n) <= LAST_PHASE)

__global__ void __launch_bounds__(NTHR, 2) fwd_megakernel(Args a) {
    extern __shared__ __attribute__((aligned(16))) unsigned char lds[];
    cg::grid_group grid = cg::this_grid();
    const int G = gridDim.x, bx = blockIdx.x;
    PG8_LAS unsigned char* ldsg = (PG8_LAS unsigned char*)lds;
    grid.sync();
    volatile LAS unsigned* bst = (volatile LAS unsigned*)((LAS unsigned char*)lds + LDS_BYTES - 64);
    if (threadIdx.x < 16) bst[threadIdx.x] = 0u;
    __syncthreads();
    (void)xcd_barrier_post((unsigned*)inp(a, 31), bst);
#define GSYNC() do { XcdBarrier b_; b_.bar = (unsigned*)inp(a, 31); b_.x = xb_xcc_id(); b_.st = (volatile LAS unsigned*)((LAS unsigned char*)lds + LDS_BYTES - 64); xcd_barrier(b_); } while (0)
#define TIDS const int tid = threadIdx.x + opaque_vzero(), lane = tid & 63, wave = __builtin_amdgcn_readfirstlane(tid >> 6); \
             const int gw = bx * NWAVES + wave, ngw = G * NWAVES, gtid = bx * NTHR + tid, nthreads = G * NTHR; (void)gw; (void)ngw; (void)gtid; (void)nthreads; (void)lane;
#define BASES const int z_ = opaque_zero(); unsigned char* ws = (unsigned char*)inp(a, 31); float* out = (float*)inp(a, 30); const int lp = l + z_; const int bxp = bx + z_, Gp = G + z_; (void)bxp; (void)Gp; \
              const float* modl = (const float*)(ws + WS_MODS) + (size_t)lp * 9 * MODW; (void)modl; (void)out;

    {
        TIDS
#if PH_ON(0)
        compute_mods(a, lds, tid, wave, lane);
#endif
        unsigned char* ws = (unsigned char*)inp(a, 31);
        bf16_t* CK = (bf16_t*)(ws + WS_CK); bf16_t* CV = (bf16_t*)(ws + WS_CV);
        for (int i = gtid; i < 2 * 524288; i += nthreads) {
            const int which = i >= 524288; const int j = which ? i - 524288 : i;
            const float* src = inp(a, which ? 3 : 2) + (size_t)j * 8; bf16_t* dst = (which ? CV : CK) + (size_t)j * 8;
            const f32x4 x0 = *(const f32x4*)src, x1 = *(const f32x4*)(src + 4);
            u32x4 w; w.x = pk2(x0[0], x0[1]); w.y = pk2(x0[2], x0[3]); w.z = pk2(x1[0], x1[1]); w.w = pk2(x1[2], x1[3]);
            *(u32x4*)dst = w;
        }
    }
    GSYNC();

    for (int l = 0; l < 2; ++l) {
        PHX(1) {
            TIDS BASES
#if PH_ON(1)
            convert_weights(a, lp, lds, gw, ngw, wave, lane);
#endif
#if PH_ON(2)
            const float* xin0 = lp == 0 ? inp(a, 0) : out;
            const float* xin1 = lp == 0 ? inp(a, 1) - (size_t)NCTX * DM : out;
            adaln_phase(xin0, xin1, inp(a, 8) + lp * DM, modl, 0, (bf16_t*)(ws + WS_U), gw, ngw, lane);
#endif
        }
        GSYNC();
#if PH_ON(3)
        PHX(2) { BASES
          pg8::Gemm g{(const bf16_t*)(ws + WS_U), (const bf16_t*)(ws + W_GU1), 0, 0, MTOK, 2 * DFF, DM}; pg8::Order S; S.init(MTOK, 2 * DFF, Gp, bxp, 1);
          pg8::EpiSwiGLU E{(bf16_t*)(ws + WS_H)}; pg8::gemm_phase<pg8::EpiSwiGLU, true, true>(ldsg, g, S, E); }
#endif
        GSYNC();
#if PH_ON(4)
        PHX(3) { BASES
          const float* xin0 = lp == 0 ? inp(a, 0) : out;
          const float* xin1 = lp == 0 ? inp(a, 1) - (size_t)NCTX * DM : out;
          pg8::Gemm g{(const bf16_t*)(ws + WS_H), (const bf16_t*)(ws + W_D1), 0, 0, MTOK, DM, DFF}; pg8::Order S; S.init(MTOK, DM, Gp, bxp, 1);
          pg8::EpiResid E{xin0, xin1, out, modl + 2 * DM, 0.5f}; pg8::gemm_phase<pg8::EpiResid, true, true>(ldsg, g, S, E); }
#endif
        GSYNC();
#if PH_ON(14)
        PHX(4) { TIDS BASES
          adaln_phase(out, out, inp(a, 12) + lp * DM, modl, 3, (bf16_t*)(ws + WS_U), gw, ngw, lane); }
#endif
        GSYNC();
#if PH_ON(5)
        PHX(5) { BASES
          float* newk = out + (size_t)MTOK * DM; float* newv = newk + (size_t)32 * 2 * 256 * 512;
          pg8::Gemm g{(const bf16_t*)(ws + WS_U), (const bf16_t*)(ws + W_IN), 0, 0, MTOK, 4096, DM}; pg8::Order S; S.init(MTOK, 4096, Gp, bxp, 1);
          pg8::EpiWin E{(bf16_t*)(ws + WS_GLU), (bf16_t*)(ws + WS_CH), (bf16_t*)(ws + WS_BG), (bf16_t*)(ws + WS_Q), (bf16_t*)(ws + WS_K), (bf16_t*)(ws + WS_V),
                        inp(a, 21) + lp * 64, inp(a, 22) + lp * 64, newk, newv, lp};
          pg8::gemm_phase<pg8::EpiWin, true, true>(ldsg, g, S, E); }
#endif
        GSYNC();
        PHX(6) {
            TIDS BASES
            bf16_t* Q = (bf16_t*)(ws + WS_Q); const bf16_t* Kb = (const bf16_t*)(ws + WS_K); const bf16_t* Vb = (const bf16_t*)(ws + WS_V);
#if PH_ON(11)
            {
            const bf16_t* CK = (const bf16_t*)(ws + WS_CK); const bf16_t* CV = (const bf16_t*)(ws + WS_CV);
            const float* rpb_l = inp(a, 23) + (size_t)lp * 8 * 15 * 31;
            for (int u = bxp; u < 2048; u += Gp) {
                const int b = u >> 8, hp = (u >> 6) & 3, r = u & 63;
                const size_t co = (size_t)((b * 2 + lp) * 512) * 512;
                att::unit<true>(lds, Q, Kb, Vb, CK + co, CV + co, rpb_l, NCTX + b * 4096 + r * 64, NCTX + b * 4096, hp, r, tid, wave, lane);
            }
            for (int u = bxp; u < 512; u += Gp) {
                const int b = u >> 4, hp = (u >> 2) & 3, qb = u & 3;
                att::unit<false>(lds, Q, Kb, Vb, nullptr, nullptr, nullptr, b * 256 + qb * 64, b * 256, hp, 0, tid, wave, lane);
            }
            }
#endif
#if PH_ON(12)
            {
            const float* cw = inp(a, 14) + (size_t)lp * 31 * 512; const float* cb = inp(a, 15) + lp * 512; const float* lg = inp(a, 16) + lp * 512; const float* lb = inp(a, 17) + lp * 512;
            for (int u = bxp; u < 1280; u += Gp) {
                int rowbase, len, t0;
                if (u < 256) { rowbase = (u >> 3) * 256; len = 256; t0 = (u & 7) * 32; }
                else { const int v = u - 256; rowbase = NCTX + (v >> 7) * 4096; len = 4096; t0 = (v & 127) * 32; }
                conva_unit(lds, (const bf16_t*)(ws + WS_GLU), (bf16_t*)(ws + WS_AOUT), cw, cb, lg, lb, rowbase, len, t0, tid, wave, lane);
            }
            }
#endif
#if PH_ON(13)
            convb_phase((bf16_t*)(ws + WS_BG), (const bf16_t*)(ws + WS_CH), inp(a, 19) + (size_t)lp * 3 * 512, gtid, nthreads);
#endif
        }
        GSYNC();
#if PH_ON(6)
        PHX(7) { BASES
          const bf16_t* Wg = (const bf16_t*)(ws + W_IN) + (size_t)4096 * DM;
          pg8::Gemm g{(const bf16_t*)(ws + WS_U), Wg, 0, 0, MTOK, 3072, DM}; pg8::Order S; S.init(MTOK, 3072, Gp, bxp, 1);
          pg8::EpiGates E{(bf16_t*)(ws + WS_GS)}; pg8::gemm_phase<pg8::EpiGates, true, true>(ldsg, g, S, E); }
#endif
        GSYNC();
#if PH_ON(7)
        PHX(8) { BASES
          pg8::Gemm g{(const bf16_t*)(ws + WS_BG), (const bf16_t*)(ws + W_B), BR_STRIDE, WO_STRIDE, MTOK, DM, 512}; pg8::Order S; S.init(MTOK, DM, Gp, bxp, 3);
          pg8::EpiM E{(const bf16_t*)(ws + WS_GS), (bf16_t*)(ws + WS_U)}; pg8::gemm_phase<pg8::EpiM, true, true>(ldsg, g, S, E); }
#endif
        GSYNC();
#if PH_ON(8)
        PHX(9) { BASES
          pg8::Gemm g{(const bf16_t*)(ws + WS_U), (const bf16_t*)(ws + W_M), 0, 0, MTOK, DM, DM}; pg8::Order S; S.init(MTOK, DM, Gp, bxp, 1);
          pg8::EpiResid E{out, out, out, modl + 5 * DM, 1.0f}; pg8::gemm_phase<pg8::EpiResid, true, true>(ldsg, g, S, E); }
#endif
        GSYNC();
#if PH_ON(14)
        PHX(10) { TIDS BASES
          adaln_phase(out, out, inp(a, 26) + lp * DM, modl, 6, (bf16_t*)(ws + WS_U), gw, ngw, lane); }
#endif
        GSYNC();
#if PH_ON(9)
        PHX(11) { BASES
          pg8::Gemm g{(const bf16_t*)(ws + WS_U), (const bf16_t*)(ws + W_GU2), 0, 0, MTOK, 2 * DFF, DM}; pg8::Order S; S.init(MTOK, 2 * DFF, Gp, bxp, 1);
          pg8::EpiSwiGLU E{(bf16_t*)(ws + WS_H)}; pg8::gemm_phase<pg8::EpiSwiGLU, true, true>(ldsg, g, S, E); }
#endif
        GSYNC();
#if PH_ON(10)
        PHX(12) { BASES
          pg8::Gemm g{(const bf16_t*)(ws + WS_H), (const bf16_t*)(ws + W_D2), 0, 0, MTOK, DM, DFF}; pg8::Order S; S.init(MTOK, DM, Gp, bxp, 1);
          pg8::EpiResid E{out, out, out, modl + 8 * DM, 0.5f}; pg8::gemm_phase<pg8::EpiResid, true, true>(ldsg, g, S, E); }
#endif
        if (l == 0) GSYNC();
    }
}

extern "C" void kernel_launch(void* const* d_in, const int* in_sizes, int n_in, void* d_out, int out_size, void* d_ws, size_t ws_size, hipStream_t stream) {
    static int grid = 0;
    if (grid == 0) {
        if (n_in != 30 || ws_size < WS_END) { fprintf(stderr, "kernel_launch: unexpected inputs (n_in %d, ws %zu)\n", n_in, ws_size); grid = -1; return; }
        int dev = 0, cus = 0, per_cu = 0;
        hipGetDevice(&dev);
        hipDeviceGetAttribute(&cus, hipDeviceAttributeMultiprocessorCount, dev);
        hipFuncSetAttribute((const void*)fwd_megakernel, hipFuncAttributeMaxDynamicSharedMemorySize, LDS_BYTES);
        hipOccupancyMaxActiveBlocksPerMultiprocessor(&per_cu, (const void*)fwd_megakernel, NTHR, LDS_BYTES);
        if (per_cu < 1) per_cu = 1;
        (void)hipGetLastError();
        grid = cus;
        if (grid > 256) grid = 256;
    }
    if (grid < 0) return;
    Args a{};
    for (int i = 0; i < 30; ++i) a.in[i] = (const float*)d_in[i];
    a.in[30] = (const float*)d_out; a.in[31] = (const float*)d_ws;
    (void)hipMemsetAsync(d_ws, 0, 16384, stream);
    void* args[] = {&a};
    hipError_t e = hipLaunchCooperativeKernel((const void*)fwd_megakernel, dim3(grid), dim3(NTHR), args, LDS_BYTES, stream);
    if (e != hipSuccess) fprintf(stderr, "cooperative launch failed: %s (grid %d)\n", hipGetErrorString(e), grid);
}
```

```cpp
#include <hip/hip_runtime.h>
#include <hip/hip_cooperative_groups.h>
#include <cstdio>
#include <cstdint>
namespace cg = cooperative_groups;

#define LAS __attribute__((address_space(3)))
typedef unsigned short bf16_t;
typedef short bf16x8 __attribute__((ext_vector_type(8)));
typedef short s16x4 __attribute__((ext_vector_type(4)));
typedef float f32x4 __attribute__((ext_vector_type(4)));
typedef unsigned u32x4 __attribute__((ext_vector_type(4)));
typedef unsigned u32x2 __attribute__((ext_vector_type(2)));

constexpr int DM = 1024, NCTX = 8192, NLAT = 32768, MTOK = NCTX + NLAT;
constexpr int DFF = 2816, NIN = 7168, NMODV = 9, MODW = 9 * 1024;
constexpr int NWAVES = 8, NTHR = 512;
constexpr float EPS = 1e-6f;

constexpr size_t MiB = 1u << 20;
constexpr size_t WS_MODS = 1 * MiB;
constexpr size_t WS_W = 2 * MiB;
constexpr size_t W_GU1 = WS_W, W_D1 = W_GU1 + 11 * MiB, W_IN = W_D1 + 11 * MiB / 2, W_B = W_IN + 14 * MiB, W_C = W_B + MiB, W_A = W_C + MiB,
                 W_M = W_A + MiB, W_GU2 = W_M + 2 * MiB, W_D2 = W_GU2 + 11 * MiB;
constexpr size_t WS_U = 54 * MiB, WS_H = 134 * MiB;
constexpr size_t WS_BG = 134 * MiB, WS_Q = 174 * MiB, WS_AOUT = 214 * MiB, WS_GLU = 254 * MiB, WS_CH = 294 * MiB, WS_K = 334 * MiB, WS_V = 374 * MiB;
constexpr size_t WS_GS = 254 * MiB;
constexpr size_t GS_STRIDE = 80 * MiB / 2, BR_STRIDE = 40 * MiB / 2, WO_STRIDE = MiB / 2;
constexpr size_t WS_CK = 494 * MiB, WS_CV = 502 * MiB, WS_END = 510 * MiB;
static_assert(W_D2 + 11 * MiB / 2 <= WS_U, "weights fit");
constexpr int LDS_BYTES = 147456;

__device__ __forceinline__ unsigned f2bf(float f) { unsigned u = __builtin_bit_cast(unsigned, f); return (u + 0x7fffu + ((u >> 16) & 1u)) >> 16; }
__device__ __forceinline__ unsigned pk2(float lo, float hi) { return f2bf(lo) | (f2bf(hi) << 16); }
typedef float f32x2_t __attribute__((ext_vector_type(2))); typedef __bf16 bf16x2_t __attribute__((ext_vector_type(2)));
__device__ __forceinline__ unsigned cvt_pk_bf16(float lo, float hi) { f32x2_t v = {lo, hi}; bf16x2_t b = __builtin_convertvector(v, bf16x2_t); return __builtin_bit_cast(unsigned, b); }
__device__ __forceinline__ float bflo(unsigned w) { return __uint_as_float(w << 16); }
__device__ __forceinline__ float bfhi(unsigned w) { return __uint_as_float(w & 0xffff0000u); }
__device__ __forceinline__ float sigmoidf_(float x) { return __builtin_amdgcn_rcpf(1.f + __expf(-x)); }
__device__ __forceinline__ float siluf_(float x) { return x * sigmoidf_(x); }
__device__ __forceinline__ float wave_sum(float v) {
#pragma unroll
    for (int o = 1; o < 64; o <<= 1) v += __shfl_xor(v, o);
    return v;
}
__device__ __forceinline__ int opaque_zero() { int z; asm volatile("s_mov_b32 %0, 0" : "=s"(z)); return z; }
__device__ __forceinline__ int opaque_vzero() { int z; asm volatile("v_mov_b32 %0, 0" : "=v"(z)); return z; }
template <class T> __device__ __forceinline__ T* launder_ptr(T* p) { T* r; asm volatile("s_mov_b64 %0, %1" : "=s"(r) : "s"(p)); return r; }
#define LDS_WAIT() asm volatile("s_waitcnt lgkmcnt(0)" ::: "memory")

namespace pg8 {
#define PG8_LAS __attribute__((address_space(3)))
constexpr int BM = 256, BK = 64, HALF = 128, HTB = HALF * BK * 2, STAGE_BYTES = 8 * HTB, NXCD = 8, WGM = 8;
__device__ __forceinline__ int lds_byte(int r, int c) { const int st = (r >> 4) * 2 + (c >> 5), rr = r & 15, cc = c & 31, ob = rr * 64 + cc * 2; return st * 1024 + (ob ^ (((ob >> 9) & 1) << 5)); }
__device__ __forceinline__ void stage_rc(int b, int& R, int& C) { const int st = b / 1024, sb = b % 1024, swz = sb ^ (((sb >> 9) & 1) << 5); R = (st >> 1) * 16 + swz / 64; C = (st & 1) * 32 + (swz % 64) / 2; }
__device__ __forceinline__ int perm32(int rho) { const int n = rho >> 4, i = rho & 15; return 8 * (i >> 2) + 4 * n + (i & 3); }

struct Unit { int pm, pn, seg; };
struct Gemm { const bf16_t* A; const bf16_t* Bt; size_t segA, segB; int M, N, K; };

struct Order {
    int nM, nN, nwg, G, c, nseg;
    __device__ void init(int M, int N, int G_, int c_, int nseg_) { nM = M / BM; nN = N / BM; nwg = nM * nN; G = G_; c = c_; nseg = nseg_; }
    __device__ bool next(int i, Unit& u) const {
        const int tile = i / nseg, seg = i - tile * nseg;
        const long L = (long)tile * G + c; if (L >= nwg) return false;
        int wgid = (int)L; { const int q = nwg / NXCD, r = nwg % NXCD, xcd = wgid % NXCD, off = wgid / NXCD; wgid = (xcd < r ? xcd * (q + 1) : r * (q + 1) + (xcd - r) * q) + off; }
        const int nig = WGM * nN, gid = wgid / nig, fm = gid * WGM, gsz = (nM - fm) < WGM ? (nM - fm) : WGM;
        u.pm = fm + ((wgid % nig) % gsz); u.pn = (wgid % nig) / gsz; u.seg = seg; return true;
    }
};

template <class Epi, bool ALIGN_EPI, bool SP2>
__device__ __forceinline__ void gemm_phase(PG8_LAS unsigned char* lds, const Gemm g, const Order& S, const Epi& E) {
    const int tid = threadIdx.x + opaque_vzero(), wid = __builtin_amdgcn_readfirstlane(tid >> 6), lane = tid & 63, wr = wid >> 2, wc = wid & 3, fr = lane & 15, fq = lane >> 4;
    const int K = g.K, nt = K / BK;
    unsigned voffA[2], voffB[2];
#pragma unroll
    for (int i = 0; i < 2; ++i) { int R, C; stage_rc(tid * 16 + i * 8192, R, C); const int Rb = Epi::PERM ? ((R & ~31) + perm32(R & 31)) : R;
        voffA[i] = (unsigned)(R * K + C) * 2u; voffB[i] = (unsigned)(Rb * K + C) * 2u; }
    const size_t kstep = (size_t)(BK * 2);
    const size_t hstep = (size_t)HALF * K * 2;
    const size_t tstep = 2 * hstep;
    const unsigned ldsw = (unsigned)wid * 1024u;
    const int aoff = lds_byte(wr * 64 + fr, fq * 8), boff = lds_byte(wc * 32 + fr, fq * 8);
#define PG8_SA(b, h) (((b) * 2 + (h)) * HTB)
#define PG8_SB(b, h) ((4 + (b) * 2 + (h)) * HTB)
#define PG8_STAGE(bufoff, gbase, voff) do { _Pragma("unroll") for (int _i = 0; _i < 2; ++_i) \
        __builtin_amdgcn_global_load_lds((const unsigned*)((const char*)(gbase) + (voff)[_i]), (PG8_LAS unsigned*)(lds + (bufoff) + ldsw + _i * 8192), 16, 0, 0); } while (0)
#define PG8_LDA(dst, b, h) do { _Pragma("unroll") for (int m = 0; m < 4; ++m) _Pragma("unroll") for (int k = 0; k < 2; ++k) dst[m][k] = *(const PG8_LAS bf16x8*)(lds + PG8_SA(b, h) + aoff + m * 2048 + k * 1024); } while (0)
#define PG8_LDB(dst, b, h) do { _Pragma("unroll") for (int n = 0; n < 2; ++n) _Pragma("unroll") for (int k = 0; k < 2; ++k) dst[n][k] = *(const PG8_LAS bf16x8*)(lds + PG8_SB(b, h) + boff + n * 2048 + k * 1024); } while (0)
#define PG8_MMA(ai, bj, At, Bt) do { __builtin_amdgcn_s_setprio(1); _Pragma("unroll") for (int m = 0; m < 4; ++m) _Pragma("unroll") for (int n = 0; n < 2; ++n) _Pragma("unroll") for (int k = 0; k < 2; ++k) \
        acc[ai][bj][m][n] = __builtin_amdgcn_mfma_f32_16x16x32_bf16(Bt[n][k], At[m][k], acc[ai][bj][m][n], 0, 0, 0); __builtin_amdgcn_s_setprio(0); } while (0)
#define PG8_WAIT_V(n) asm volatile("s_waitcnt vmcnt(" #n ")" ::: "memory")
#define PG8_WAIT_L(n) asm volatile("s_waitcnt lgkmcnt(" #n ")" ::: "memory")
#define PG8_BAR __builtin_amdgcn_s_barrier()
#define PG8_SCHED __builtin_amdgcn_sched_barrier(0)
    Unit cur, nxt; int ui = 0;
    if (!S.next(0, cur)) return;
    f32x4 acc[2][2][4][2];
#pragma unroll
    for (int a = 0; a < 2; ++a)
#pragma unroll
        for (int b = 0; b < 2; ++b)
#pragma unroll
            for (int m = 0; m < 4; ++m)
#pragma unroll
                for (int n = 0; n < 2; ++n) acc[a][b][m][n] = (f32x4){0.f, 0.f, 0.f, 0.f};
    bf16x8 At[4][2], B0[2][2], B1[2][2];
    const char* cA = (const char*)(g.A + cur.seg * g.segA) + (size_t)cur.pm * tstep; const char* cB = (const char*)(g.Bt + cur.seg * g.segB) + (size_t)cur.pn * tstep;
    if constexpr (SP2) {
        PG8_STAGE(PG8_SB(0, 0), cB, voffB); PG8_STAGE(PG8_SB(0, 1), cB + hstep, voffB); PG8_STAGE(PG8_SA(0, 0), cA, voffA); PG8_STAGE(PG8_SA(0, 1), cA + hstep, voffA);
        if (wr == 1) PG8_BAR;
        PG8_WAIT_V(2); PG8_BAR;
        PG8_STAGE(PG8_SB(1, 0), cB + kstep, voffB); PG8_STAGE(PG8_SA(1, 0), cA + kstep, voffA); PG8_STAGE(PG8_SB(1, 1), cB + hstep + kstep, voffB);
        PG8_WAIT_V(6); PG8_BAR;
    } else {
        PG8_STAGE(PG8_SB(0, 0), cB, voffB); PG8_STAGE(PG8_SA(0, 0), cA, voffA); PG8_STAGE(PG8_SB(0, 1), cB + hstep, voffB); PG8_STAGE(PG8_SA(0, 1), cA + hstep, voffA);
        if (wr == 1) PG8_BAR;
        PG8_WAIT_V(4); PG8_BAR;
        PG8_STAGE(PG8_SB(1, 0), cB + kstep, voffB); PG8_STAGE(PG8_SA(1, 0), cA + kstep, voffA); PG8_STAGE(PG8_SB(1, 1), cB + hstep + kstep, voffB);
        PG8_WAIT_V(6); PG8_BAR;
    }
    for (;;) {
        const bool has_next = S.next(ui + 1, nxt);
        const char* nA = has_next ? (const char*)(g.A + nxt.seg * g.segA) + (size_t)nxt.pm * tstep : cA; const char* nB = has_next ? (const char*)(g.Bt + nxt.seg * g.segB) + (size_t)nxt.pn * tstep : cB;
        for (int t = 0; t < nt; t += 2) {
            const bool last = (t == nt - 2);
            const char* a1 = cA + (size_t)(t + 1) * kstep;
            const char* a2 = last ? nA : cA + (size_t)(t + 2) * kstep; const char* b2 = last ? nB : cB + (size_t)(t + 2) * kstep;
            const char* a3 = a2 + kstep; const char* b3 = b2 + kstep;
            if constexpr (SP2) {
            PG8_LDB(B0, 0, 0); PG8_LDB(B1, 0, 1); PG8_SCHED; PG8_LDA(At, 0, 0); PG8_STAGE(PG8_SA(1, 1), a1 + hstep, voffA);
            PG8_WAIT_V(8); PG8_WAIT_L(0); PG8_BAR; PG8_MMA(0, 0, At, B0); PG8_MMA(0, 1, At, B1); PG8_BAR; PG8_SCHED;
            PG8_LDA(At, 0, 1); PG8_STAGE(PG8_SB(0, 0), b2, voffB); PG8_STAGE(PG8_SB(0, 1), b2 + hstep, voffB); PG8_STAGE(PG8_SA(0, 0), a2, voffA);
            PG8_WAIT_V(8); PG8_WAIT_L(0); PG8_BAR; PG8_MMA(1, 0, At, B0); PG8_MMA(1, 1, At, B1); PG8_BAR; PG8_SCHED;
            PG8_LDB(B0, 1, 0); PG8_LDB(B1, 1, 1); PG8_SCHED; PG8_LDA(At, 1, 0); PG8_STAGE(PG8_SA(0, 1), a2 + hstep, voffA);
            PG8_WAIT_V(8); PG8_WAIT_L(0); PG8_BAR; PG8_MMA(0, 0, At, B0); PG8_MMA(0, 1, At, B1); PG8_BAR; PG8_SCHED;
            PG8_LDA(At, 1, 1); PG8_STAGE(PG8_SB(1, 0), b3, voffB); PG8_STAGE(PG8_SB(1, 1), b3 + hstep, voffB); PG8_STAGE(PG8_SA(1, 0), a3, voffA);
            PG8_WAIT_V(8); PG8_WAIT_L(0); PG8_BAR; PG8_MMA(1, 0, At, B0); PG8_MMA(1, 1, At, B1); PG8_BAR; PG8_SCHED;
            } else {
            PG8_LDB(B0, 0, 0); PG8_SCHED; PG8_LDA(At, 0, 0); PG8_STAGE(PG8_SA(1, 1), a1 + hstep, voffA);
            PG8_WAIT_L(8); PG8_BAR; PG8_WAIT_L(0); PG8_MMA(0, 0, At, B0); PG8_BAR; PG8_SCHED;
            PG8_LDB(B1, 0, 1); PG8_STAGE(PG8_SB(0, 0), b2, voffB);
            PG8_BAR; PG8_WAIT_L(0); PG8_MMA(0, 1, At, B1); PG8_BAR;
            PG8_LDA(At, 0, 1); PG8_STAGE(PG8_SA(0, 0), a2, voffA);
            PG8_BAR; PG8_WAIT_L(0); PG8_MMA(1, 0, At, B0); PG8_BAR; PG8_SCHED;
            PG8_STAGE(PG8_SB(0, 1), b2 + hstep, voffB);
            PG8_WAIT_V(6); PG8_BAR; PG8_MMA(1, 1, At, B1); PG8_BAR;
            PG8_LDB(B0, 1, 0); PG8_SCHED; PG8_LDA(At, 1, 0); PG8_STAGE(PG8_SA(0, 1), a2 + hstep, voffA);
            PG8_WAIT_L(8); PG8_BAR; PG8_WAIT_L(0); PG8_MMA(0, 0, At, B0); PG8_BAR; PG8_SCHED;
            PG8_LDB(B1, 1, 1); PG8_STAGE(PG8_SB(1, 0), b3, voffB);
            PG8_BAR; PG8_WAIT_L(0); PG8_MMA(0, 1, At, B1); PG8_BAR;
            PG8_LDA(At, 1, 1); PG8_STAGE(PG8_SA(1, 0), a3, voffA);
            PG8_BAR; PG8_WAIT_L(0); PG8_MMA(1, 0, At, B0); PG8_BAR; PG8_SCHED;
            PG8_STAGE(PG8_SB(1, 1), b3 + hstep, voffB);
            PG8_WAIT_V(6); PG8_BAR; PG8_MMA(1, 1, At, B1); PG8_BAR;
            }
        }
        if constexpr (ALIGN_EPI) { if (wr == 0) PG8_BAR; }
        E(acc, cur, wr, wc, fr, fq);
        if (!has_next) break;
#pragma unroll
        for (int a = 0; a < 2; ++a)
#pragma unroll
            for (int b = 0; b < 2; ++b)
#pragma unroll
                for (int m = 0; m < 4; ++m)
#pragma unroll
                    for (int n = 0; n < 2; ++n) acc[a][b][m][n] = (f32x4){0.f, 0.f, 0.f, 0.f};
        cur = nxt; cA = nA; cB = nB; ++ui;
        if constexpr (ALIGN_EPI) { if (wr == 1) PG8_BAR; }
    }
    PG8_WAIT_V(0);
    if constexpr (!ALIGN_EPI) { if (wr == 0) PG8_BAR; }
    PG8_BAR;
#undef PG8_SA
#undef PG8_SB
#undef PG8_STAGE
#undef PG8_LDA
#undef PG8_LDB
#undef PG8_MMA
#undef PG8_WAIT_V
#undef PG8_WAIT_L
#undef PG8_BAR
#undef PG8_SCHED
}

typedef f32x4 Acc[2][2][4][2];

__device__ __forceinline__ u32x4 pack8(const f32x4 a, const f32x4 b) {
    u32x4 w; w.x = cvt_pk_bf16(a[0], a[1]); w.y = cvt_pk_bf16(a[2], a[3]); w.z = cvt_pk_bf16(b[0], b[1]); w.w = cvt_pk_bf16(b[2], b[3]); return w;
}

struct EpiSwiGLU {
    static constexpr bool PERM = true;
    bf16_t* H;
    __device__ __forceinline__ void operator()(const Acc& acc, const Unit& u, int wr, int wc, int fr, int fq) const {
        const int row0 = u.pm * BM + wr * 64 + fr, col0 = u.pn * HALF + wc * 32 + 8 * fq;
#pragma unroll
        for (int ai = 0; ai < 2; ++ai)
#pragma unroll
            for (int m = 0; m < 4; ++m) {
                bf16_t* rowp = H + (size_t)(row0 + ai * HALF + m * 16) * DFF + col0;
                f32x4 h0, h1;
#pragma unroll
                for (int j = 0; j < 4; ++j) { h0[j] = siluf_(acc[ai][0][m][0][j]) * acc[ai][1][m][0][j]; h1[j] = siluf_(acc[ai][0][m][1][j]) * acc[ai][1][m][1][j]; }
                *(u32x4*)rowp = pack8(h0, h1);
                __builtin_amdgcn_sched_barrier(0);
            }
    }
};

struct EpiResid {
    static constexpr bool PERM = false;
    const float* in0; const float* in1; float* out; const float* gate; float coef;
    __device__ __forceinline__ void operator()(const Acc& acc, const Unit& u, int wr, int wc, int fr, int fq) const {
        const int v = u.pm < 32 ? 0 : 1 + ((u.pm - 32) >> 4);
        const float* gv = gate + (size_t)v * MODW;
        const float* in = u.pm < 32 ? in0 : in1;
        const int col0 = u.pn * BM + wc * 32 + 4 * fq;
        f32x4 g[2][2];
#pragma unroll
        for (int bj = 0; bj < 2; ++bj)
#pragma unroll
            for (int n = 0; n < 2; ++n) g[bj][n] = *(const f32x4*)(gv + col0 + bj * HALF + n * 16) * coef;
#pragma unroll
        for (int ai = 0; ai < 2; ++ai) {
            f32x4 x[4][2][2];
#pragma unroll
            for (int m = 0; m < 4; ++m) {
                const size_t off = (size_t)(u.pm * BM + ai * HALF + wr * 64 + m * 16 + fr) * DM + col0;
#pragma unroll
                for (int bj = 0; bj < 2; ++bj)
#pragma unroll
                    for (int n = 0; n < 2; ++n) x[m][bj][n] = *(const f32x4*)(in + off + bj * HALF + n * 16);
            }
            __builtin_amdgcn_sched_barrier(0);
#pragma unroll
            for (int m = 0; m < 4; ++m) {
                const size_t off = (size_t)(u.pm * BM + ai * HALF + wr * 64 + m * 16 + fr) * DM + col0;
#pragma unroll
                for (int bj = 0; bj < 2; ++bj)
#pragma unroll
                    for (int n = 0; n < 2; ++n) *(f32x4*)(out + off + bj * HALF + n * 16) = x[m][bj][n] + g[bj][n] * acc[ai][bj][m][n];
            }
            __builtin_amdgcn_sched_barrier(0);
        }
    }
};

struct EpiWin {
    static constexpr bool PERM = true;
    bf16_t *GLU, *CH, *BG, *Q, *Kb, *Vb; const float *qg, *kg; float *newk, *newv; int layer;
    __device__ __forceinline__ void operator()(const Acc& acc, const Unit& u, int wr, int wc, int fr, int fq) const {
        const int row0 = u.pm * BM + wr * 64 + fr, cw = wc * 32 + 8 * fq, pn = u.pn;
        if (pn < 8) {
            bf16_t* O = (pn < 4 ? GLU : CH); const int col0 = (pn & 3) * HALF + cw;
#pragma unroll
            for (int ai = 0; ai < 2; ++ai)
#pragma unroll
                for (int m = 0; m < 4; ++m) {
                    f32x4 h0, h1;
                    if (pn < 4) {
#pragma unroll
                        for (int j = 0; j < 4; ++j) { h0[j] = acc[ai][0][m][0][j] * sigmoidf_(acc[ai][1][m][0][j]); h1[j] = acc[ai][0][m][1][j] * sigmoidf_(acc[ai][1][m][1][j]); }
                    } else { h0 = acc[ai][0][m][0] * acc[ai][1][m][0]; h1 = acc[ai][0][m][1] * acc[ai][1][m][1]; }
                    *(u32x4*)(O + (size_t)(row0 + ai * HALF + m * 16) * 512 + col0) = pack8(h0, h1);
                    __builtin_amdgcn_sched_barrier(0);
                }
        } else if (pn < 10 || pn >= 14) {
            bf16_t* O = (pn < 10 ? BG : Vb); const int colt = (pn < 10 ? pn - 8 : pn - 14) * BM + cw;
            const bool wnew = (pn >= 14) && (u.pm < 32);
#pragma unroll
            for (int ai = 0; ai < 2; ++ai)
#pragma unroll
                for (int m = 0; m < 4; ++m) {
                    const int row = row0 + ai * HALF + m * 16;
#pragma unroll
                    for (int bj = 0; bj < 2; ++bj) {
                        *(u32x4*)(O + (size_t)row * 512 + colt + bj * HALF) = pack8(acc[ai][bj][m][0], acc[ai][bj][m][1]);
                        if (wnew) { float* p = newv + ((size_t)(u.pm * 2 + layer) * 256 + (row - u.pm * BM)) * 512 + colt + bj * HALF;
                            *(f32x4*)p = acc[ai][bj][m][0]; *(f32x4*)(p + 4) = acc[ai][bj][m][1]; }
                    }
                    __builtin_amdgcn_sched_barrier(0);
                }
        } else {
            const bool isk = pn >= 12; bf16_t* O = isk ? Kb : Q; const float* gn = isk ? kg : qg;
            const int head = 4 * ((pn - 10) & 1) + wc; const bool wnew = isk && (u.pm < 32);
            f32x4 gv[2][2];
#pragma unroll
            for (int bj = 0; bj < 2; ++bj)
#pragma unroll
                for (int n = 0; n < 2; ++n) gv[bj][n] = *(const f32x4*)(gn + 32 * bj + 8 * fq + 4 * n);
#pragma unroll
            for (int ai = 0; ai < 2; ++ai)
#pragma unroll
                for (int m = 0; m < 4; ++m) {
                    const int row = row0 + ai * HALF + m * 16;
                    float ss = 0.f;
#pragma unroll
                    for (int bj = 0; bj < 2; ++bj)
#pragma unroll
                        for (int n = 0; n < 2; ++n) { const f32x4 x = acc[ai][bj][m][n]; ss += (x[0] * x[0] + x[1] * x[1]) + (x[2] * x[2] + x[3] * x[3]); }
                    ss += __shfl_xor(ss, 16); ss += __shfl_xor(ss, 32);
                    const float rinv = __builtin_amdgcn_rsqf(ss * (1.f / 64.f) + EPS);
#pragma unroll
                    for (int bj = 0; bj < 2; ++bj) {
                        const f32x4 y0 = acc[ai][bj][m][0] * rinv * gv[bj][0], y1 = acc[ai][bj][m][1] * rinv * gv[bj][1];
                        const int col = head * 64 + 32 * bj + 8 * fq;
                        *(u32x4*)(O + (size_t)row * 512 + col) = pack8(y0, y1);
                        if (wnew) { float* p = newk + ((size_t)(u.pm * 2 + layer) * 256 + (row - u.pm * BM)) * 512 + col; *(f32x4*)p = y0; *(f32x4*)(p + 4) = y1; }
                    }
                    __builtin_amdgcn_sched_barrier(0);
                }
        }
    }
};

struct EpiGates {
    static constexpr bool PERM = true;
    bf16_t* GS;
    __device__ __forceinline__ void operator()(const Acc& acc, const Unit& u, int wr, int wc, int fr, int fq) const {
        const int gi = u.pn >> 2; const int bi = gi == 0 ? 2 : gi - 1; bf16_t* O = GS + (size_t)bi * GS_STRIDE;
        const int row0 = u.pm * BM + wr * 64 + fr, col0 = (u.pn & 3) * BM + wc * 32 + 8 * fq;
#pragma unroll
        for (int ai = 0; ai < 2; ++ai)
#pragma unroll
            for (int m = 0; m < 4; ++m)
#pragma unroll
                for (int bj = 0; bj < 2; ++bj) {
                    f32x4 h0, h1;
#pragma unroll
                    for (int j = 0; j < 4; ++j) { h0[j] = sigmoidf_(acc[ai][bj][m][0][j]); h1[j] = sigmoidf_(acc[ai][bj][m][1][j]); }
                    *(u32x4*)(O + (size_t)(row0 + ai * HALF + m * 16) * DM + col0 + bj * HALF) = pack8(h0, h1);
                    __builtin_amdgcn_sched_barrier(0);
                }
    }
};

struct EpiM {
    static constexpr bool PERM = true;
    const bf16_t* GS; bf16_t* Mo;
    __device__ __forceinline__ void operator()(const Acc& acc, const Unit& u, int wr, int wc, int fr, int fq) const {
        const bf16_t* Gs = GS + (size_t)u.seg * GS_STRIDE;
        const int row0 = u.pm * BM + wr * 64 + fr, col0 = u.pn * BM + wc * 32 + 8 * fq;
#pragma unroll
        for (int ai = 0; ai < 2; ++ai) {
            u32x4 gw[4][2], mw[4][2];
#pragma unroll
            for (int m = 0; m < 4; ++m)
#pragma unroll
                for (int bj = 0; bj < 2; ++bj) {
                    const size_t off = (size_t)(row0 + ai * HALF + m * 16) * DM + col0 + bj * HALF;
                    gw[m][bj] = *(const u32x4*)(Gs + off);
                    mw[m][bj] = (u32x4){0u, 0u, 0u, 0u};
                    if (u.seg != 0) mw[m][bj] = *(const u32x4*)(Mo + off);
                }
            __builtin_amdgcn_sched_barrier(0);
#pragma unroll
            for (int m = 0; m < 4; ++m)
#pragma unroll
                for (int bj = 0; bj < 2; ++bj) {
                    const size_t off = (size_t)(row0 + ai * HALF + m * 16) * DM + col0 + bj * HALF;
                    const u32x4 g4 = gw[m][bj], m4 = mw[m][bj];
                    f32x4 h0, h1;
                    h0[0] = bflo(g4.x) * acc[ai][bj][m][0][0] + bflo(m4.x); h0[1] = bfhi(g4.x) * acc[ai][bj][m][0][1] + bfhi(m4.x);
                    h0[2] = bflo(g4.y) * acc[ai][bj][m][0][2] + bflo(m4.y); h0[3] = bfhi(g4.y) * acc[ai][bj][m][0][3] + bfhi(m4.y);
                    h1[0] = bflo(g4.z) * acc[ai][bj][m][1][0] + bflo(m4.z); h1[1] = bfhi(g4.z) * acc[ai][bj][m][1][1] + bfhi(m4.z);
                    h1[2] = bflo(g4.w) * acc[ai][bj][m][1][2] + bflo(m4.w); h1[3] = bfhi(g4.w) * acc[ai][bj][m][1][3] + bfhi(m4.w);
                    *(u32x4*)(Mo + off) = pack8(h0, h1);
                }
            __builtin_amdgcn_sched_barrier(0);
        }
    }
};
}

struct Args { const float* in[32]; };
__device__ __forceinline__ const float* inp(const Args& a, int i) { return a.in[i + opaque_zero()]; }

__device__ __forceinline__ void cvt_block(const float* W, int N, int K, int k0, int n0, bf16_t* WT, int dst_row0, float* scr, int lane) {
    const int kq = lane >> 3, n4 = (lane & 7) * 4;
    f32x4 v[8];
#pragma unroll
    for (int i = 0; i < 8; ++i) v[i] = *(const f32x4*)(W + (size_t)(k0 + kq + 8 * i) * N + n0 + n4);
#pragma unroll
    for (int i = 0; i < 8; ++i) { float* d = scr + (kq + 8 * i) * 33 + n4; d[0] = v[i][0]; d[1] = v[i][1]; d[2] = v[i][2]; d[3] = v[i][3]; }
    LDS_WAIT();
    const int c = lane & 7;
#pragma unroll
    for (int j = 0; j < 4; ++j) { const int n = (lane >> 3) + 8 * j; const float* s = scr + (8 * c) * 33 + n;
        u32x4 o; o.x = pk2(s[0 * 33], s[1 * 33]); o.y = pk2(s[2 * 33], s[3 * 33]); o.z = pk2(s[4 * 33], s[5 * 33]); o.w = pk2(s[6 * 33], s[7 * 33]);
        *(u32x4*)(WT + (size_t)(dst_row0 + n) * K + k0 + 8 * c) = o; }
    LDS_WAIT();
}
__device__ __forceinline__ int win_dst(int n) {
    if (n < 512) return 256 * (n >> 7) + (n & 127);
    if (n < 1024) { const int s = n - 512; return 256 * (s >> 7) + 128 + (s & 127); }
    if (n < 1536) return 2048 + (n - 1024);
    if (n < 2048) { const int s = n - 1536; return 1024 + 256 * (s >> 7) + (s & 127); }
    if (n < 2560) { const int s = n - 2048; return 1024 + 256 * (s >> 7) + 128 + (s & 127); }
    if (n < 3584) { const int base = n < 3072 ? 2560 : 3072; const int s = n - base, head = s >> 6, dim = s & 63;
        return base + 256 * (head >> 2) + 128 * (dim >> 5) + 32 * (head & 3) + (dim & 31); }
    return n;
}
__device__ __forceinline__ void convert_weights(const Args& a, int l, unsigned char* lds, int gw, int ngw, int wave, int lane) {
    float* scr = (float*)(lds + wave * 8448);
    unsigned char* ws = (unsigned char*)inp(a, 31);
    constexpr int I_GU = 16 * 88, I_D = 44 * 32, I_IN = 16 * 224, I_O = 8 * 32, I_M = 16 * 32;
    constexpr int NIT = 6 * I_GU + I_IN + 3 * I_O + I_M;
    static_assert(I_GU == I_D, "");
    for (int it = gw; it < NIT; it += ngw) {
        int r = it;
        if (r < 6 * I_GU) {
            const int which = r / I_GU; r -= which * I_GU;
            const int ff = which / 3, kind = which % 3;
            if (kind < 2) {
                const float* W = inp(a, (ff ? 27 : 9) + kind) + (size_t)l * DM * DFF;
                const int kb = r / 88, nb = r % 88, n0 = nb * 32;
                cvt_block(W, DFF, DM, kb * 64, n0, (bf16_t*)(ws + (ff ? W_GU2 : W_GU1)), 256 * (n0 >> 7) + 128 * kind + (n0 & 127), scr, lane);
            } else {
                const float* W = inp(a, ff ? 29 : 11) + (size_t)l * DFF * DM;
                const int kb = r / 32, nb = r % 32;
                cvt_block(W, DM, DFF, kb * 64, nb * 32, (bf16_t*)(ws + (ff ? W_D2 : W_D1)), nb * 32, scr, lane);
            }
            continue;
        }
        r -= 6 * I_GU;
        if (r < I_IN) { const int kb = r / 224, nb = r % 224; cvt_block(inp(a, 13) + (size_t)l * DM * NIN, NIN, DM, kb * 64, nb * 32, (bf16_t*)(ws + W_IN), win_dst(nb * 32), scr, lane); continue; }
        r -= I_IN;
        if (r < 3 * I_O) { const int which = r / I_O; r -= which * I_O; const int kb = r / 32, nb = r % 32;
            const float* W = inp(a, which == 0 ? 18 : (which == 1 ? 20 : 24)) + (size_t)l * 512 * DM;
            cvt_block(W, DM, 512, kb * 64, nb * 32, (bf16_t*)(ws + (which == 0 ? W_A : (which == 1 ? W_B : W_C))), nb * 32, scr, lane); continue; }
        r -= 3 * I_O;
        { const int kb = r / 32, nb = r % 32; cvt_block(inp(a, 25) + (size_t)l * DM * DM, DM, DM, kb * 64, nb * 32, (bf16_t*)(ws + W_M), nb * 32, scr, lane); }
    }
}

__device__ __forceinline__ void compute_mods(const Args& a, unsigned char* lds, int tid, int wave, int lane) {
    float* sT = (float*)lds;
    float* red = (float*)(lds + 49152);
    const float* c = inp(a, 4); const float* cctx = inp(a, 5);
    for (int k = tid; k < DM; k += NTHR) {
        sT[k * 12 + 0] = siluf_(cctx[k]);
#pragma unroll
        for (int v = 1; v < 9; ++v) sT[k * 12 + v] = siluf_(c[(v - 1) * DM + k]);
        sT[k * 12 + 9] = 0.f; sT[k * 12 + 10] = 0.f; sT[k * 12 + 11] = 0.f;
    }
    __syncthreads();
    float* mods = (float*)((unsigned char*)inp(a, 31) + WS_MODS);
    for (int unit = blockIdx.x; unit < 288; unit += gridDim.x) {
        const int l = unit / 144, cb = unit % 144, col = cb * 64 + lane;
        const float* W = inp(a, 6) + (size_t)l * DM * MODW + col;
        float acc[9];
#pragma unroll
        for (int v = 0; v < 9; ++v) acc[v] = 0.f;
#pragma unroll 32
        for (int kk = 0; kk < 128; ++kk) {
            const int k = wave * 128 + kk;
            const float w = W[(size_t)k * MODW];
            const f32x4 s0 = *(const f32x4*)(sT + k * 12), s1 = *(const f32x4*)(sT + k * 12 + 4), s2 = *(const f32x4*)(sT + k * 12 + 8);
            acc[0] += s0[0] * w; acc[1] += s0[1] * w; acc[2] += s0[2] * w; acc[3] += s0[3] * w;
            acc[4] += s1[0] * w; acc[5] += s1[1] * w; acc[6] += s1[2] * w; acc[7] += s1[3] * w; acc[8] += s2[0] * w;
        }
#pragma unroll
        for (int v = 0; v < 9; ++v) red[(wave * 9 + v) * 64 + lane] = acc[v];
        __syncthreads();
        for (int idx = tid; idx < 576; idx += NTHR) {
            const int v = idx >> 6, ln = idx & 63; float s = inp(a, 7)[(size_t)l * MODW + cb * 64 + ln];
#pragma unroll
            for (int w = 0; w < 8; ++w) s += red[(w * 9 + v) * 64 + ln];
            mods[((size_t)l * 9 + v) * MODW + cb * 64 + ln] = s;
        }
        __syncthreads();
    }
}

__device__ __forceinline__ void adaln_phase(const float* in0, const float* in1, const float* g, const float* modl, int ish, bf16_t* U, int gw, int ngw, int lane) {
    static_assert(MTOK % (2 * 256 * NWAVES) == 0, "row pairs");
    for (int row0 = gw; row0 < MTOK; row0 += 2 * ngw) {
        f32x4 x[2][4];
#pragma unroll
        for (int h = 0; h < 2; ++h) { const int row = min(row0 + h * ngw, MTOK - 1); const float* xr = (row < NCTX ? in0 : in1) + (size_t)row * DM;
#pragma unroll
            for (int j = 0; j < 4; ++j) x[h][j] = *(const f32x4*)(xr + 256 * j + 4 * lane); }
#pragma unroll
        for (int h = 0; h < 2; ++h) {
            const int row = row0 + h * ngw; if (row >= MTOK) break;
            const int v = row < NCTX ? 0 : 1 + ((row - NCTX) >> 12);
            const float* sh = modl + (size_t)v * MODW + ish * DM; const float* sc = sh + DM;
            float ss = 0.f;
#pragma unroll
            for (int j = 0; j < 4; ++j) ss += (x[h][j][0] * x[h][j][0] + x[h][j][1] * x[h][j][1]) + (x[h][j][2] * x[h][j][2] + x[h][j][3] * x[h][j][3]);
            const float rinv = __builtin_amdgcn_rsqf(wave_sum(ss) * (1.f / DM) + EPS);
#pragma unroll
            for (int j = 0; j < 4; ++j) {
                const int c = 256 * j + 4 * lane;
                const f32x4 gg = *(const f32x4*)(g + c), s1 = *(const f32x4*)(sc + c), s0 = *(const f32x4*)(sh + c);
                const f32x4 y = x[h][j] * rinv * gg * (s1 + 1.f) + s0;
                u32x2 w; w.x = pk2(y[0], y[1]); w.y = pk2(y[2], y[3]);
                *(u32x2*)(U + (size_t)row * DM + c) = w;
            }
        }
    }
}

namespace att {
constexpr int TK = 128, PITCH = 272, KS_OFF = 0, VS_OFF = TK * PITCH, RPB_OFF = 2 * TK * PITCH;
typedef short v4i16_t __attribute__((ext_vector_type(4)));
__device__ __forceinline__ s16x4 vtr(const LAS char* p) { return __builtin_bit_cast(s16x4, __builtin_amdgcn_ds_read_tr16_b64_v4i16((LAS v4i16_t*)p)); }

struct TileSrc { const bf16_t* k; const bf16_t* v; };

template <bool LOCAL>
__device__ __forceinline__ void tile_compute(const LAS char* ldsb, const bf16x8 (&qf)[2], f32x4 (&O)[4], float& mrun, float& lrun,
                                             int hl, int kbase, int koff, int fr, int fq, int lane, const float* rpbrow, const int (&dci)[8], unsigned vmask) {
    constexpr int NMT = LOCAL ? 2 : 4;
#define ATT_KEYOFF(mt) (kbase + (LOCAL ? koff : 0) + 16 * (mt))
    f32x4 s[NMT];
#pragma unroll
    for (int mt = 0; mt < NMT; ++mt) {
        s[mt] = (f32x4){0.f, 0.f, 0.f, 0.f};
#pragma unroll
        for (int ks = 0; ks < 2; ++ks) {
            const bf16x8 kf = *(const LAS bf16x8*)(ldsb + KS_OFF + (ATT_KEYOFF(mt) + fr) * PITCH + hl * 128 + ks * 64 + fq * 16);
            s[mt] = __builtin_amdgcn_mfma_f32_16x16x32_bf16(kf, qf[ks], s[mt], 0, 0, 0);
        }
    }
    constexpr float C1 = 0.125f * 1.4426950408889634f;
    float tmax = -1e30f;
    if (LOCAL) {
#pragma unroll
        for (int mt = 0; mt < NMT; ++mt)
#pragma unroll
            for (int j = 0; j < 4; ++j) {
                float v = __builtin_fmaf(s[mt][j], C1, rpbrow[dci[mt * 4 + j]]);
                if (!((vmask >> (mt * 4 + j)) & 1u)) v = -1e30f;
                s[mt][j] = v; tmax = fmaxf(tmax, v);
            }
    } else {
#pragma unroll
        for (int mt = 0; mt < NMT; ++mt)
#pragma unroll
            for (int j = 0; j < 4; ++j) tmax = fmaxf(tmax, s[mt][j]);
        tmax *= C1;
    }
    tmax = fmaxf(tmax, __shfl_xor(tmax, 16)); tmax = fmaxf(tmax, __shfl_xor(tmax, 32));
    const float mnew = fmaxf(mrun, tmax), alpha = __builtin_amdgcn_exp2f(mrun - mnew);
    float psum = 0.f;
#pragma unroll
    for (int mt = 0; mt < NMT; ++mt)
#pragma unroll
        for (int j = 0; j < 4; ++j) { const float p = __builtin_amdgcn_exp2f(LOCAL ? s[mt][j] - mnew : __builtin_fmaf(s[mt][j], C1, -mnew)); s[mt][j] = p; psum += p; }
    lrun = lrun * alpha + psum; mrun = mnew;
#pragma unroll
    for (int dt = 0; dt < 4; ++dt) O[dt] = O[dt] * alpha;
    const int g = lane >> 4, q = (lane & 15) >> 2, p4 = lane & 3;
#pragma unroll
    for (int kk = 0; kk < NMT / 2; ++kk) {
        bf16x8 pb;
        { const u32x4 w = pg8::pack8(s[2 * kk], s[2 * kk + 1]); pb = __builtin_bit_cast(bf16x8, w); }
#pragma unroll
        for (int dt = 0; dt < 4; ++dt) {
            const LAS char* vb = ldsb + VS_OFF + hl * 128 + 32 * dt + 8 * p4;
            const s16x4 v0 = vtr(vb + (ATT_KEYOFF(2 * kk) + 4 * g + q) * PITCH);
            const s16x4 v1 = vtr(vb + (ATT_KEYOFF(2 * kk + 1) + 4 * g + q) * PITCH);
            bf16x8 vf; vf[0] = v0[0]; vf[1] = v0[1]; vf[2] = v0[2]; vf[3] = v0[3]; vf[4] = v1[0]; vf[5] = v1[1]; vf[6] = v1[2]; vf[7] = v1[3];
            O[dt] = __builtin_amdgcn_mfma_f32_16x16x32_bf16(vf, pb, O[dt], 0, 0, 0);
        }
    }
#undef ATT_KEYOFF
}

template <bool LATENT>
__device__ __forceinline__ void unit(unsigned char* lds, bf16_t* QO, const bf16_t* Kb, const bf16_t* Vb, const bf16_t* CK, const bf16_t* CV, const float* rpb_l,
                                     int qrow0  , int keyrow0  , int hp, int r  ,
                                     int tid, int wave, int lane) {
    const LAS char* ldsb = (const LAS char*)(LAS unsigned char*)lds;
    const int hl = wave >> 2, J = wave & 3, fr = lane & 15, fq = lane >> 4;
    const int rs = LATENT ? min(max(r - 4, 0), 56) : 0;
    constexpr int NT = LATENT ? 8 : 2;
    int dci[8]; unsigned vmask = 0u; int koff = 0;
    if (LATENT) {
        const int qc = 16 * J + fr, wstart = min(max(qc - 8, 0), 48);
        koff = min(max(16 * J - 8, 0), 32);
#pragma unroll
        for (int mt = 0; mt < 2; ++mt)
#pragma unroll
            for (int j = 0; j < 4; ++j) { const int kc = koff + 16 * mt + 4 * fq + j;
                dci[mt * 4 + j] = min(max(kc - qc, -15), 15) + 15;
                if (kc >= wstart && kc < wstart + 16) vmask |= 1u << (mt * 4 + j); }
        float* tb = (float*)(lds + RPB_OFF);
        for (int i = tid; i < 2 * 15 * 32; i += NTHR) { const int h2 = i / 480, rem = i % 480, dr = rem >> 5, dc = rem & 31;
            tb[i] = dc < 31 ? rpb_l[((2 * hp + h2) * 15 + dr) * 31 + dc] * 1.4426950408889634f : 0.f; }
    } else {
#pragma unroll
        for (int i = 0; i < 8; ++i) dci[i] = 0;
    }
    bf16x8 qf[2];
    { const bf16_t* qp = QO + (size_t)(qrow0 + 16 * J + fr) * 512 + (2 * hp + hl) * 64 + 8 * fq;
      qf[0] = *(const bf16x8*)qp; qf[1] = *(const bf16x8*)(qp + 32); }
    f32x4 O[4], OB[4];
#pragma unroll
    for (int dt = 0; dt < 4; ++dt) { O[dt] = (f32x4){0.f, 0.f, 0.f, 0.f}; OB[dt] = (f32x4){0.f, 0.f, 0.f, 0.f}; }
    float mrun = -1e30f, lrun = 0.f, mrunB = -1e30f, lrunB = 0.f;
    const int key0 = tid >> 4, part = tid & 15;
    u32x4 kA[4], vA[4], kB[4], vB[4];
    auto tsrc = [&](int t) -> TileSrc {
        TileSrc s;
        if (LATENT) {
            if (t < 4) { s.k = CK + (size_t)(t * TK) * 512 + hp * 128; s.v = CV + (size_t)(t * TK) * 512 + hp * 128; }
            else { const size_t ro = (size_t)(keyrow0 + (rs + 2 * (t - 4)) * 64) * 512 + hp * 128; s.k = Kb + ro; s.v = Vb + ro; }
        } else { const size_t ro = (size_t)(keyrow0 + t * TK) * 512 + hp * 128; s.k = Kb + ro; s.v = Vb + ro; }
        return s;
    };
#define ATT_GLOAD(KR, VR, t) do { const TileSrc s_ = tsrc(t); _Pragma("unroll") for (int i = 0; i < 4; ++i) { const size_t o = (size_t)(key0 + 32 * i) * 512 + part * 8; \
        KR[i] = *(const u32x4*)(s_.k + o); VR[i] = *(const u32x4*)(s_.v + o); } } while (0)
#define ATT_BAR() do { asm volatile("s_waitcnt lgkmcnt(0)" ::: "memory"); __builtin_amdgcn_s_barrier(); asm volatile("" ::: "memory"); } while (0)
#define ATT_LSTORE(KR, VR) do { _Pragma("unroll") for (int i = 0; i < 4; ++i) { const int lo = (key0 + 32 * i) * PITCH + part * 16; \
        *(u32x4*)(lds + KS_OFF + lo) = KR[i]; *(u32x4*)(lds + VS_OFF + lo) = VR[i]; } } while (0)
#define ATT_COMPUTE(t) do { if (LATENT && (t) >= 4) { const int dr = (rs + 2 * ((t) - 4)) - r + 7; \
            const float* rpbrow = (const float*)(lds + RPB_OFF) + (hl * 15 + dr) * 32; \
            tile_compute<true>(ldsb, qf, O, mrun, lrun, hl, 0, koff, fr, fq, lane, rpbrow, dci, vmask); \
            tile_compute<true>(ldsb, qf, OB, mrunB, lrunB, hl, 64, koff, fr, fq, lane, rpbrow + 32, dci, vmask); \
        } else { tile_compute<false>(ldsb, qf, O, mrun, lrun, hl, 0, 0, fr, fq, lane, nullptr, dci, 0u); \
                 tile_compute<false>(ldsb, qf, OB, mrunB, lrunB, hl, 64, 0, fr, fq, lane, nullptr, dci, 0u); } } while (0)
    ATT_GLOAD(kA, vA, 0); ATT_GLOAD(kB, vB, 1);
    for (int t = 0; t < NT; t += 2) {
        ATT_BAR();
        ATT_LSTORE(kA, vA);
        ATT_BAR();
        if (t + 2 < NT) ATT_GLOAD(kA, vA, t + 2);
        ATT_COMPUTE(t);
        ATT_BAR();
        ATT_LSTORE(kB, vB);
        ATT_BAR();
        if (t + 3 < NT) ATT_GLOAD(kB, vB, t + 3);
        ATT_COMPUTE(t + 1);
    }
#undef ATT_GLOAD
#undef ATT_BAR
#undef ATT_LSTORE
#undef ATT_COMPUTE
    { const float mm = fmaxf(mrun, mrunB), aA = __builtin_amdgcn_exp2f(mrun - mm), aB = __builtin_amdgcn_exp2f(mrunB - mm);
      lrun = lrun * aA + lrunB * aB;
#pragma unroll
      for (int dt = 0; dt < 4; ++dt) O[dt] = O[dt] * aA + OB[dt] * aB; }
    lrun += __shfl_xor(lrun, 16); lrun += __shfl_xor(lrun, 32);
    const float linv = 1.f / lrun;
    bf16_t* op = QO + (size_t)(qrow0 + 16 * J + fr) * 512 + (2 * hp + hl) * 64 + 4 * fq;
#pragma unroll
    for (int dt = 0; dt < 4; ++dt) { u32x2 w; w.x = cvt_pk_bf16(O[dt][0] * linv, O[dt][1] * linv); w.y = cvt_pk_bf16(O[dt][2] * linv, O[dt][3] * linv); *(u32x2*)(op + 16 * dt) = w; }
    __syncthreads();
}
}

__device__ __forceinline__ void conva_unit(unsigned char* lds, const bf16_t* GLU, bf16_t* AOUT, const float* cw, const float* cb, const float* lg, const float* lb,
                                           int rowbase, int len, int t0, int tid, int wave, int lane) {
    bf16_t* in_s = (bf16_t*)lds;
    float* hs = (float*)(lds + 62 * 512 * 2);
    for (int idx = tid; idx < 62 * 64; idx += NTHR) {
        const int i = idx >> 6, ch = idx & 63, p = t0 - 15 + i;
        u32x4 v = (u32x4){0u, 0u, 0u, 0u};
        if (p >= 0 && p < len) v = *(const u32x4*)(GLU + (size_t)(rowbase + p) * 512 + ch * 8);
        *(u32x4*)(in_s + i * 512 + ch * 8) = v;
    }
    float w[31];
#pragma unroll
    for (int j = 0; j < 31; ++j) w[j] = cw[j * 512 + tid];
    const float bias = cb[tid];
    __syncthreads();
    float col[62];
#pragma unroll
    for (int i = 0; i < 62; ++i) col[i] = __uint_as_float((unsigned)in_s[i * 512 + tid] << 16);
#pragma unroll
    for (int tt = 0; tt < 32; ++tt) {
        float acc = bias;
#pragma unroll
        for (int j = 0; j < 31; ++j) acc += col[tt + j] * w[j];
        hs[tt * 512 + tid] = acc;
    }
    __syncthreads();
#pragma unroll
    for (int q = 0; q < 4; ++q) {
        const int tt = wave * 4 + q;
        const f32x4 a = *(const f32x4*)(hs + tt * 512 + lane * 8), b = *(const f32x4*)(hs + tt * 512 + lane * 8 + 4);
        const float mean = wave_sum((a[0] + a[1]) + (a[2] + a[3]) + (b[0] + b[1]) + (b[2] + b[3])) * (1.f / 512.f);
        const f32x4 da = a - mean, db = b - mean;
        const float var = wave_sum((da[0] * da[0] + da[1] * da[1]) + (da[2] * da[2] + da[3] * da[3]) + (db[0] * db[0] + db[1] * db[1]) + (db[2] * db[2] + db[3] * db[3])) * (1.f / 512.f);
        const float rstd = __builtin_amdgcn_rsqf(var + EPS);
        const f32x4 g0 = *(const f32x4*)(lg + lane * 8), g1 = *(const f32x4*)(lg + lane * 8 + 4), b0 = *(const f32x4*)(lb + lane * 8), b1 = *(const f32x4*)(lb + lane * 8 + 4);
        f32x4 y0 = da * rstd * g0 + b0, y1 = db * rstd * g1 + b1;
#pragma unroll
        for (int j = 0; j < 4; ++j) { y0[j] = siluf_(y0[j]); y1[j] = siluf_(y1[j]); }
        *(u32x4*)(AOUT + (size_t)(rowbase + t0 + tt) * 512 + lane * 8) = pg8::pack8(y0, y1);
    }
    __syncthreads();
}

__device__ __forceinline__ f32x4 cb_lo(u32x4 v) { return (f32x4){bflo(v.x), bfhi(v.x), bflo(v.y), bfhi(v.y)}; }
__device__ __forceinline__ f32x4 cb_hi(u32x4 v) { return (f32x4){bflo(v.z), bfhi(v.z), bflo(v.w), bfhi(v.w)}; }
__device__ __forceinline__ void convb_phase(bf16_t* BG, const bf16_t* CH, const float* w3, int gtid, int nthreads) {
    const u32x4 z = (u32x4){0u, 0u, 0u, 0u};
    for (int idx = gtid; idx < (MTOK / 2) * 64; idx += nthreads) {
        const int row = (idx >> 6) * 2, ch = idx & 63;
        int pos, len; if (row < NCTX) { pos = row & 255; len = 256; } else { pos = (row - NCTX) & 4095; len = 4096; }
        const bf16_t* cp = CH + (size_t)row * 512 + ch * 8; bf16_t* bp = BG + (size_t)row * 512 + ch * 8;
        const u32x4 c1 = *(const u32x4*)cp, c2 = *(const u32x4*)(cp + 512);
        const u32x4 c0 = pos > 0 ? *(const u32x4*)(cp - 512) : z;
        const u32x4 c3 = pos + 2 < len ? *(const u32x4*)(cp + 1024) : z;
        const u32x4 b0 = *(const u32x4*)bp, b1 = *(const u32x4*)(bp + 512);
        f32x4 wa[3], wb[3];
#pragma unroll
        for (int j = 0; j < 3; ++j) { wa[j] = *(const f32x4*)(w3 + j * 512 + ch * 8); wb[j] = *(const f32x4*)(w3 + j * 512 + ch * 8 + 4); }
        const f32x4 y0a = cb_lo(b0) * (cb_lo(c0) * wa[0] + cb_lo(c1) * wa[1] + cb_lo(c2) * wa[2]), y0b = cb_hi(b0) * (cb_hi(c0) * wb[0] + cb_hi(c1) * wb[1] + cb_hi(c2) * wb[2]);
        const f32x4 y1a = cb_lo(b1) * (cb_lo(c1) * wa[0] + cb_lo(c2) * wa[1] + cb_lo(c3) * wa[2]), y1b = cb_hi(b1) * (cb_hi(c1) * wb[0] + cb_hi(c2) * wb[1] + cb_hi(c3) * wb[2]);
        *(u32x4*)bp = pg8::pack8(y0a, y0b); *(u32x4*)(bp + 512) = pg8::pack8(y1a, y1b);
    }
}

#define XB_TMO      128
#define XB_XCNT(j)  (256  + 64 * (j))
#define XB_XSUB(j)  (1280 + 64 * (j))
#define XB_XGEN(j)  (2304 + 64 * (j))
#define XB_TOP      3328
#define XB_TOPGEN   3392
#define XCD_BAR_WORDS 3456
#define XB_SPIN_CAP (1u << 18)

__device__ __forceinline__ unsigned xb_ld(unsigned* p)              { return __hip_atomic_load(p, __ATOMIC_RELAXED, __HIP_MEMORY_SCOPE_AGENT); }
__device__ __forceinline__ unsigned xb_add(unsigned* p, unsigned v) { return __hip_atomic_fetch_add(p, v, __ATOMIC_RELAXED, __HIP_MEMORY_SCOPE_AGENT); }
__device__ __forceinline__ unsigned xb_xcc_id() { return (unsigned)__builtin_amdgcn_s_getreg((3 << 11) | 20) & 0xFu; }
#define XB_SPIN(cond, bar) do { unsigned _sp = 0; while (cond) { __builtin_amdgcn_s_sleep(1); \
    if ((++_sp & 255u) == 0u) { if (xb_ld(&(bar)[XB_TMO])) break; if (_sp > XB_SPIN_CAP) { atomicAdd(&(bar)[XB_TMO], 1u); break; } } } } while (0)

struct XcdBarrier {
    unsigned* bar; unsigned x;
    volatile LAS unsigned* st;
};

__device__ __forceinline__ XcdBarrier xcd_barrier_post(unsigned* bar, volatile LAS unsigned* st) {
    XcdBarrier b; b.bar = bar; b.x = xb_xcc_id(); b.st = st;
    if (threadIdx.x == 0) (void)xb_add(&bar[XB_XCNT(b.x)], 1u);
    return b;
}
__device__ __forceinline__ void xcd_barrier_complete(unsigned* bar, unsigned x, unsigned& nloc, unsigned& nx) {
    const unsigned G = gridDim.x * gridDim.y * gridDim.z;
    unsigned sum, cnt, mine, sp = 0u;
    for (;;) {
        sum = 0u; cnt = 0u; mine = 0u;
#pragma unroll
        for (unsigned j = 0; j < 16; ++j) { const unsigned c = xb_ld(&bar[XB_XCNT(j)]); sum += c; cnt += (c > 0u) ? 1u : 0u; mine = (j == x) ? c : mine; }
        if (sum == G) break;
        __builtin_amdgcn_s_sleep(1);
        if ((++sp & 255u) == 0u) { if (xb_ld(&bar[XB_TMO])) break; if (sp > XB_SPIN_CAP) { atomicAdd(&bar[XB_TMO], 1u); break; } }
    }
    nloc = mine > 0u ? mine : 1u; nx = cnt > 0u ? cnt : 1u;
}

__device__ __forceinline__ void xcd_barrier(const XcdBarrier& b) {
    asm volatile("s_waitcnt vmcnt(0)" ::: "memory");
    __syncthreads();
    if (threadIdx.x == 0) {
        unsigned* bar = b.bar;
        __builtin_amdgcn_s_waitcnt(0);
        unsigned nloc = b.st[0], nx = b.st[1];
        if (nloc == 0u) { xcd_barrier_complete(bar, b.x, nloc, nx); b.st[0] = nloc; b.st[1] = nx; }
        const unsigned old = xb_add(&bar[XB_XSUB(b.x)], 1u);
        const unsigned gen = old / nloc;
        if (old + 1u == (gen + 1u) * nloc) {
            __builtin_amdgcn_fence(__ATOMIC_RELEASE, "agent");
            asm volatile("s_waitcnt vmcnt(0)" ::: "memory");
            const unsigned og = xb_add(&bar[XB_TOP], 1u);
            const unsigned tg = og / nx;
            if (og + 1u == (tg + 1u) * nx) xb_add(&bar[XB_TOPGEN], 1u);
            else XB_SPIN(xb_ld(&bar[XB_TOPGEN]) == tg, bar);
            __builtin_amdgcn_fence(__ATOMIC_ACQUIRE, "agent");
            xb_add(&bar[XB_XGEN(b.x)], 1u);
            asm volatile("s_waitcnt vmcnt(0)" ::: "memory");
        } else {
            XB_SPIN(xb_ld(&bar[XB_XGEN(b.x)]) == gen, bar);
            __builtin_amdgcn_fence(__ATOMIC_ACQUIRE, "agent");
            asm volatile("s_waitcnt vmcnt(0)" ::: "memory");
        }
    }
    __syncthreads();
}


#ifndef PHASE_MASK
#define PHASE_MASK 0xFFFFF
#endif
#define PH_ON(n) ((PHASE_MASK >> (n)) & 1)
#ifndef LAST_PHASE
#define LAST_PHASE 99
#endif
#define PHX(n) if (l * 12 + (n) <= LAST_PHASE)

__global__ void __launch_bounds__(NTHR, 2) fwd_megakernel(Args a) {
    extern __shared__ __attribute__((aligned(16))) unsigned char lds[];
    cg::grid_group grid = cg::this_grid();
    const int G = gridDim.x, bx = blockIdx.x;
    PG8_LAS unsigned char* ldsg = (PG8_LAS unsigned char*)lds;
    grid.sync();
    volatile LAS unsigned* bst = (volatile LAS unsigned*)((LAS unsigned char*)lds + LDS_BYTES - 64);
    if (threadIdx.x < 16) bst[threadIdx.x] = 0u;
    __syncthreads();
    (void)xcd_barrier_post((unsigned*)inp(a, 31), bst);
#define GSYNC() do { XcdBarrier b_; b_.bar = (unsigned*)inp(a, 31); b_.x = xb_xcc_id(); b_.st = (volatile LAS unsigned*)((LAS unsigned char*)lds + LDS_BYTES - 64); xcd_barrier(b_); } while (0)
#define TIDS const int tid = threadIdx.x + opaque_vzero(), lane = tid & 63, wave = __builtin_amdgcn_readfirstlane(tid >> 6); \
             const int gw = bx * NWAVES + wave, ngw = G * NWAVES, gtid = bx * NTHR + tid, nthreads = G * NTHR; (void)gw; (void)ngw; (void)gtid; (void)nthreads; (void)lane;
#define BASES const int z_ = opaque_zero(); unsigned char* ws = (unsigned char*)inp(a, 31); float* out = (float*)inp(a, 30); const int lp = l + z_; const int bxp = bx + z_, Gp = G + z_; (void)bxp; (void)Gp; \
              const float* modl = (const float*)(ws + WS_MODS) + (size_t)lp * 9 * MODW; (void)modl; (void)out;

    {
        TIDS
#if PH_ON(0)
        compute_mods(a, lds, tid, wave, lane);
#endif
        unsigned char* ws = (unsigned char*)inp(a, 31);
        bf16_t* CK = (bf16_t*)(ws + WS_CK); bf16_t* CV = (bf16_t*)(ws + WS_CV);
        for (int i = gtid; i < 2 * 524288; i += nthreads) {
            const int which = i >= 524288; const int j = which ? i - 524288 : i;
            const float* src = inp(a, which ? 3 : 2) + (size_t)j * 8; bf16_t* dst = (which ? CV : CK) + (size_t)j * 8;
            const f32x4 x0 = *(const f32x4*)src, x1 = *(const f32x4*)(src + 4);
            u32x4 w; w.x = pk2(x0[0], x0[1]); w.y = pk2(x0[2], x0[3]); w.z = pk2(x1[0], x1[1]); w.w = pk2(x1[2], x1[3]);
            *(u32x4*)dst = w;
        }
    }
    GSYNC();

    for (int l = 0; l < 2; ++l) {
        PHX(1) {
            TIDS BASES
#if PH_ON(1)
            convert_weights(a, lp, lds, gw, ngw, wave, lane);
#endif
#if PH_ON(2)
            const float* xin0 = lp == 0 ? inp(a, 0) : out;
            const float* xin1 = lp == 0 ? inp(a, 1) - (size_t)NCTX * DM : out;
            adaln_phase(xin0, xin1, inp(a, 8) + lp * DM, modl, 0, (bf16_t*)(ws + WS_U), gw, ngw, lane);
#endif
        }
        GSYNC();
#if PH_ON(3)
        PHX(2) { BASES
          pg8::Gemm g{(const bf16_t*)(ws + WS_U), (const bf16_t*)(ws + W_GU1), 0, 0, MTOK, 2 * DFF, DM}; pg8::Order S; S.init(MTOK, 2 * DFF, Gp, bxp, 1);
          pg8::EpiSwiGLU E{(bf16_t*)(ws + WS_H)}; pg8::gemm_phase<pg8::EpiSwiGLU, true, true>(ldsg, g, S, E); }
#endif
        GSYNC();
#if PH_ON(4)
        PHX(3) { BASES
          const float* xin0 = lp == 0 ? inp(a, 0) : out;
          const float* xin1 = lp == 0 ? inp(a, 1) - (size_t)NCTX * DM : out;
          pg8::Gemm g{(const bf16_t*)(ws + WS_H), (const bf16_t*)(ws + W_D1), 0, 0, MTOK, DM, DFF}; pg8::Order S; S.init(MTOK, DM, Gp, bxp, 1);
          pg8::EpiResid E{xin0, xin1, out, modl + 2 * DM, 0.5f}; pg8::gemm_phase<pg8::EpiResid, true, true>(ldsg, g, S, E); }
#endif
        GSYNC();
#if PH_ON(14)
        PHX(4) { TIDS BASES
          adaln_phase(out, out, inp(a, 12) + lp * DM, modl, 3, (bf16_t*)(ws + WS_U), gw, ngw, lane); }
#endif
        GSYNC();
#if PH_ON(5)
        PHX(5) { BASES
          float* newk = out + (size_t)MTOK * DM; float* newv = newk + (size_t)32 * 2 * 256 * 512;
          pg8::Gemm g{(const bf16_t*)(ws + WS_U), (const bf16_t*)(ws + W_IN), 0, 0, MTOK, 4096, DM}; pg8::Order S; S.init(MTOK, 4096, Gp, bxp, 1);
          pg8::EpiWin E{(bf16_t*)(ws + WS_GLU), (bf16_t*)(ws + WS_CH), (bf16_t*)(ws + WS_BG), (bf16_t*)(ws + WS_Q), (bf16_t*)(ws + WS_K), (bf16_t*)(ws + WS_V),
                        inp(a, 21) + lp * 64, inp(a, 22) + lp * 64, newk, newv, lp};
          pg8::gemm_phase<pg8::EpiWin, true, true>(ldsg, g, S, E); }
#endif
        GSYNC();
        PHX(6) {
            TIDS BASES
            bf16_t* Q = (bf16_t*)(ws + WS_Q); const bf16_t* Kb = (const bf16_t*)(ws + WS_K); const bf16_t* Vb = (const bf16_t*)(ws + WS_V);
#if PH_ON(11)
            {
            const bf16_t* CK = (const bf16_t*)(ws + WS_CK); const bf16_t* CV = (const bf16_t*)(ws + WS_CV);
            const float* rpb_l = inp(a, 23) + (size_t)lp * 8 * 15 * 31;
            for (int u = bxp; u < 2048; u += Gp) {
                const int b = u >> 8, hp = (u >> 6) & 3, r = u & 63;
                const size_t co = (size_t)((b * 2 + lp) * 512) * 512;
                att::unit<true>(lds, Q, Kb, Vb, CK + co, CV + co, rpb_l, NCTX + b * 4096 + r * 64, NCTX + b * 4096, hp, r, tid, wave, lane);
            }
            for (int u = bxp; u < 512; u += Gp) {
                const int b = u >> 4, hp = (u >> 2) & 3, qb = u & 3;
                att::unit<false>(lds, Q, Kb, Vb, nullptr, nullptr, nullptr, b * 256 + qb * 64, b * 256, hp, 0, tid, wave, lane);
            }
            }
#endif
#if PH_ON(12)
            {
            const float* cw = inp(a, 14) + (size_t)lp * 31 * 512; const float* cb = inp(a, 15) + lp * 512; const float* lg = inp(a, 16) + lp * 512; const float* lb = inp(a, 17) + lp * 512;
            for (int u = bxp; u < 1280; u += Gp) {
                int rowbase, len, t0;
                if (u < 256) { rowbase = (u >> 3) * 256; len = 256; t0 = (u & 7) * 32; }
                else { const int v = u - 256; rowbase = NCTX + (v >> 7) * 4096; len = 4096; t0 = (v & 127) * 32; }
                conva_unit(lds, (const bf16_t*)(ws + WS_GLU), (bf16_t*)(ws + WS_AOUT), cw, cb, lg, lb, rowbase, len, t0, tid, wave, lane);
            }
            }
#endif
#if PH_ON(13)
            convb_phase((bf16_t*)(ws + WS_BG), (const bf16_t*)(ws + WS_CH), inp(a, 19) + (size_t)lp * 3 * 512, gtid, nthreads);
#endif
        }
        GSYNC();
#if PH_ON(6)
        PHX(7) { BASES
          const bf16_t* Wg = (const bf16_t*)(ws + W_IN) + (size_t)4096 * DM;
          pg8::Gemm g{(const bf16_t*)(ws + WS_U), Wg, 0, 0, MTOK, 3072, DM}; pg8::Order S; S.init(MTOK, 3072, Gp, bxp, 1);
          pg8::EpiGates E{(bf16_t*)(ws + WS_GS)}; pg8::gemm_phase<pg8::EpiGates, true, true>(ldsg, g, S, E); }
#endif
        GSYNC();
#if PH_ON(7)
        PHX(8) { BASES
          pg8::Gemm g{(const bf16_t*)(ws + WS_BG), (const bf16_t*)(ws + W_B), BR_STRIDE, WO_STRIDE, MTOK, DM, 512}; pg8::Order S; S.init(MTOK, DM, Gp, bxp, 3);
          pg8::EpiM E{(const bf16_t*)(ws + WS_GS), (bf16_t*)(ws + WS_U)}; pg8::gemm_phase<pg8::EpiM, true, true>(ldsg, g, S, E); }
#endif
        GSYNC();
#if PH_ON(8)
        PHX(9) { BASES
          pg8::Gemm g{(const bf16_t*)(ws + WS_U), (const bf16_t*)(ws + W_M), 0, 0, MTOK, DM, DM}; pg8::Order S; S.init(MTOK, DM, Gp, bxp, 1);
          pg8::EpiResid E{out, out, out, modl + 5 * DM, 1.0f}; pg8::gemm_phase<pg8::EpiResid, true, true>(ldsg, g, S, E); }
#endif
        GSYNC();
#if PH_ON(14)
        PHX(10) { TIDS BASES
          adaln_phase(out, out, inp(a, 26) + lp * DM, modl, 6, (bf16_t*)(ws + WS_U), gw, ngw, lane); }
#endif
        GSYNC();
#if PH_ON(9)
        PHX(11) { BASES
          pg8::Gemm g{(const bf16_t*)(ws + WS_U), (const bf16_t*)(ws + W_GU2), 0, 0, MTOK, 2 * DFF, DM}; pg8::Order S; S.init(MTOK, 2 * DFF, Gp, bxp, 1);
          pg8::EpiSwiGLU E{(bf16_t*)(ws + WS_H)}; pg8::gemm_phase<pg8::EpiSwiGLU, true, true>(ldsg, g, S, E); }
#endif
        GSYNC();
#if PH_ON(10)
        PHX(12) { BASES
          pg8::Gemm g{(const bf16_t*)(ws + WS_H), (const bf16_t*)(ws + W_D2), 0, 0, MTOK, DM, DFF}; pg8::Order S; S.init(MTOK, DM, Gp, bxp, 1);
          pg8::EpiResid E{out, out, out, modl + 8 * DM, 0.5f}; pg8::gemm_phase<pg8::EpiResid, true, true>(ldsg, g, S, E); }
#endif
        if (l == 0) GSYNC();
    }
}

extern "C" void kernel_launch(void* const* d_in, const int* in_sizes, int n_in, void* d_out, int out_size, void* d_ws, size_t ws_size, hipStream_t stream) {
    static int grid = 0;
    if (grid == 0) {
        if (n_in != 30 || ws_size < WS_END) { fprintf(stderr, "kernel_launch: unexpected inputs (n_in %d, ws %zu)\n", n_in, ws_size); grid = -1; return; }
        int dev = 0, cus = 0, per_cu = 0;
        hipGetDevice(&dev);
        hipDeviceGetAttribute(&cus, hipDeviceAttributeMultiprocessorCount, dev);
        hipFuncSetAttribute((const void*)fwd_megakernel, hipFuncAttributeMaxDynamicSharedMemorySize, LDS_BYTES);
        hipOccupancyMaxActiveBlocksPerMultiprocessor(&per_cu, (const void*)fwd_megakernel, NTHR, LDS_BYTES);
        if (per_cu < 1) per_cu = 1;
        (void)hipGetLastError();
        grid = cus;
        if (grid > 256) grid = 256;
    }
    if (grid < 0) return;
    Args a{};
    for (int i = 0; i < 30; ++i) a.in[i] = (const float*)d_in[i];
    a.in[30] = (const float*)d_out; a.in[31] = (const float*)d_ws;
    (void)hipMemsetAsync(d_ws, 0, 16384, stream);
    void* args[] = {&a};
    hipError_t e = hipLaunchCooperativeKernel((const void*)fwd_megakernel, dim3(grid), dim3(NTHR), args, LDS_BYTES, stream);
    if (e != hipSuccess) fprintf(stderr, "cooperative launch failed: %s (grid %d)\n", hipGetErrorString(e), grid);
}
```

```cpp
#include <hip/hip_runtime.h>
#include <hip/hip_cooperative_groups.h>
#include <cstdio>
#include <cstdint>
namespace cg = cooperative_groups;

#define LAS __attribute__((address_space(3)))
typedef unsigned short bf16_t;
typedef short bf16x8 __attribute__((ext_vector_type(8)));
typedef short s16x4 __attribute__((ext_vector_type(4)));
typedef float f32x4 __attribute__((ext_vector_type(4)));
typedef unsigned u32x4 __attribute__((ext_vector_type(4)));
typedef unsigned u32x2 __attribute__((ext_vector_type(2)));

constexpr int DM = 1024, NCTX = 8192, NLAT = 32768, MTOK = NCTX + NLAT;
constexpr int DFF = 2816, NIN = 7168, NMODV = 9, MODW = 9 * 1024;
constexpr int NWAVES = 8, NTHR = 512;
constexpr float EPS = 1e-6f;

constexpr size_t MiB = 1u << 20;
constexpr size_t WS_MODS = 1 * MiB;
constexpr size_t WS_W = 2 * MiB;
constexpr size_t W_GU1 = WS_W, W_D1 = W_GU1 + 11 * MiB, W_IN = W_D1 + 11 * MiB / 2, W_B = W_IN + 14 * MiB, W_C = W_B + MiB, W_A = W_C + MiB,
                 W_M = W_A + MiB, W_GU2 = W_M + 2 * MiB, W_D2 = W_GU2 + 11 * MiB;
constexpr size_t WS_U = 54 * MiB, WS_H = 134 * MiB;
constexpr size_t WS_BG = 134 * MiB, WS_Q = 174 * MiB, WS_AOUT = 214 * MiB, WS_GLU = 254 * MiB, WS_CH = 294 * MiB, WS_K = 334 * MiB, WS_V = 374 * MiB;
constexpr size_t WS_GS = 254 * MiB;
constexpr size_t GS_STRIDE = 80 * MiB / 2, BR_STRIDE = 40 * MiB / 2, WO_STRIDE = MiB / 2;
constexpr size_t WS_CK = 494 * MiB, WS_CV = 502 * MiB, WS_END = 510 * MiB;
static_assert(W_D2 + 11 * MiB / 2 <= WS_U, "weights fit");
constexpr int LDS_BYTES = 147456;

__device__ __forceinline__ unsigned f2bf(float f) { unsigned u = __builtin_bit_cast(unsigned, f); return (u + 0x7fffu + ((u >> 16) & 1u)) >> 16; }
__device__ __forceinline__ unsigned pk2(float lo, float hi) { return f2bf(lo) | (f2bf(hi) << 16); }
typedef float f32x2_t __attribute__((ext_vector_type(2))); typedef __bf16 bf16x2_t __attribute__((ext_vector_type(2)));
__device__ __forceinline__ unsigned cvt_pk_bf16(float lo, float hi) { f32x2_t v = {lo, hi}; bf16x2_t b = __builtin_convertvector(v, bf16x2_t); return __builtin_bit_cast(unsigned, b); }
__device__ __forceinline__ float bflo(unsigned w) { return __uint_as_float(w << 16); }
__device__ __forceinline__ float bfhi(unsigned w) { return __uint_as_float(w & 0xffff0000u); }
__device__ __forceinline__ float sigmoidf_(float x) { return __builtin_amdgcn_rcpf(1.f + __expf(-x)); }
__device__ __forceinline__ float siluf_(float x) { return x * sigmoidf_(x); }
__device__ __forceinline__ float wave_sum(float v) {
#pragma unroll
    for (int o = 1; o < 64; o <<= 1) v += __shfl_xor(v, o);
    return v;
}
__device__ __forceinline__ int opaque_zero() { int z; asm volatile("s_mov_b32 %0, 0" : "=s"(z)); return z; }
__device__ __forceinline__ int opaque_vzero() { int z; asm volatile("v_mov_b32 %0, 0" : "=v"(z)); return z; }
template <class T> __device__ __forceinline__ T* launder_ptr(T* p) { T* r; asm volatile("s_mov_b64 %0, %1" : "=s"(r) : "s"(p)); return r; }
#define LDS_WAIT() asm volatile("s_waitcnt lgkmcnt(0)" ::: "memory")

namespace pg8 {
#define PG8_LAS __attribute__((address_space(3)))
constexpr int BM = 256, BK = 64, HALF = 128, HTB = HALF * BK * 2, STAGE_BYTES = 8 * HTB, NXCD = 8, WGM = 8;
__device__ __forceinline__ int lds_byte(int r, int c) { const int st = (r >> 4) * 2 + (c >> 5), rr = r & 15, cc = c & 31, ob = rr * 64 + cc * 2; return st * 1024 + (ob ^ (((ob >> 9) & 1) << 5)); }
__device__ __forceinline__ void stage_rc(int b, int& R, int& C) { const int st = b / 1024, sb = b % 1024, swz = sb ^ (((sb >> 9) & 1) << 5); R = (st >> 1) * 16 + swz / 64; C = (st & 1) * 32 + (swz % 64) / 2; }
__device__ __forceinline__ int perm32(int rho) { const int n = rho >> 4, i = rho & 15; return 8 * (i >> 2) + 4 * n + (i & 3); }

struct Unit { int pm, pn, seg; };
struct Gemm { const bf16_t* A; const bf16_t* Bt; size_t segA, segB; int M, N, K; };

struct Order {
    int nM, nN, nwg, G, c, nseg;
    __device__ void init(int M, int N, int G_, int c_, int nseg_) { nM = M / BM; nN = N / BM; nwg = nM * nN; G = G_; c = c_; nseg = nseg_; }
    __device__ bool next(int i, Unit& u) const {
        const int tile = i / nseg, seg = i - tile * nseg;
        const long L = (long)tile * G + c; if (L >= nwg) return false;
        int wgid = (int)L; { const int q = nwg / NXCD, r = nwg % NXCD, xcd = wgid % NXCD, off = wgid / NXCD; wgid = (xcd < r ? xcd * (q + 1) : r * (q + 1) + (xcd - r) * q) + off; }
        const int nig = WGM * nN, gid = wgid / nig, fm = gid * WGM, gsz = (nM - fm) < WGM ? (nM - fm) : WGM;
        u.pm = fm + ((wgid % nig) % gsz); u.pn = (wgid % nig) / gsz; u.seg = seg; return true;
    }
};

template <class Epi, bool ALIGN_EPI, bool SP2>
__device__ __forceinline__ void gemm_phase(PG8_LAS unsigned char* lds, const Gemm g, const Order& S, const Epi& E) {
    const int tid = threadIdx.x + opaque_vzero(), wid = __builtin_amdgcn_readfirstlane(tid >> 6), lane = tid & 63, wr = wid >> 2, wc = wid & 3, fr = lane & 15, fq = lane >> 4;
    const int K = g.K, nt = K / BK;
    unsigned voffA[2], voffB[2];
#pragma unroll
    for (int i = 0; i < 2; ++i) { int R, C; stage_rc(tid * 16 + i * 8192, R, C); const int Rb = Epi::PERM ? ((R & ~31) + perm32(R & 31)) : R;
        voffA[i] = (unsigned)(R * K + C) * 2u; voffB[i] = (unsigned)(Rb * K + C) * 2u; }
    const size_t kstep = (size_t)(BK * 2);
    const size_t hstep = (size_t)HALF * K * 2;
    const size_t tstep = 2 * hstep;
    const unsigned ldsw = (unsigned)wid * 1024u;
    const int aoff = lds_byte(wr * 64 + fr, fq * 8), boff = lds_byte(wc * 32 + fr, fq * 8);
#define PG8_SA(b, h) (((b) * 2 + (h)) * HTB)
#define PG8_SB(b, h) ((4 + (b) * 2 + (h)) * HTB)
#define PG8_STAGE(bufoff, gbase, voff) do { _Pragma("unroll") for (int _i = 0; _i < 2; ++_i) \
        __builtin_amdgcn_global_load_lds((const unsigned*)((const char*)(gbase) + (voff)[_i]), (PG8_LAS unsigned*)(lds + (bufoff) + ldsw + _i * 8192), 16, 0, 0); } while (0)
#define PG8_LDA(dst, b, h) do { _Pragma("unroll") for (int m = 0; m < 4; ++m) _Pragma("unroll") for (int k = 0; k < 2; ++k) dst[m][k] = *(const PG8_LAS bf16x8*)(lds + PG8_SA(b, h) + aoff + m * 2048 + k * 1024); } while (0)
#define PG8_LDB(dst, b, h) do { _Pragma("unroll") for (int n = 0; n < 2; ++n) _Pragma("unroll") for (int k = 0; k < 2; ++k) dst[n][k] = *(const PG8_LAS bf16x8*)(lds + PG8_SB(b, h) + boff + n * 2048 + k * 1024); } while (0)
#define PG8_MMA(ai, bj, At, Bt) do { __builtin_amdgcn_s_setprio(1); _Pragma("unroll") for (int m = 0; m < 4; ++m) _Pragma("unroll") for (int n = 0; n < 2; ++n) _Pragma("unroll") for (int k = 0; k < 2; ++k) \
        acc[ai][bj][m][n] = __builtin_amdgcn_mfma_f32_16x16x32_bf16(Bt[n][k], At[m][k], acc[ai][bj][m][n], 0, 0, 0); __builtin_amdgcn_s_setprio(0); } while (0)
#define PG8_WAIT_V(n) asm volatile("s_waitcnt vmcnt(" #n ")" ::: "memory")
#define PG8_WAIT_L(n) asm volatile("s_waitcnt lgkmcnt(" #n ")" ::: "memory")
#define PG8_BAR __builtin_amdgcn_s_barrier()
#define PG8_SCHED __builtin_amdgcn_sched_barrier(0)
    Unit cur, nxt; int ui = 0;
    if (!S.next(0, cur)) return;
    f32x4 acc[2][2][4][2];
#pragma unroll
    for (int a = 0; a < 2; ++a)
#pragma unroll
        for (int b = 0; b < 2; ++b)
#pragma unroll
            for (int m = 0; m < 4; ++m)
#pragma unroll
                for (int n = 0; n < 2; ++n) acc[a][b][m][n] = (f32x4){0.f, 0.f, 0.f, 0.f};
    bf16x8 At[4][2], B0[2][2], B1[2][2];
    const char* cA = (const char*)(g.A + cur.seg * g.segA) + (size_t)cur.pm * tstep; const char* cB = (const char*)(g.Bt + cur.seg * g.segB) + (size_t)cur.pn * tstep;
    if constexpr (SP2) {
        PG8_STAGE(PG8_SB(0, 0), cB, voffB); PG8_STAGE(PG8_SB(0, 1), cB + hstep, voffB); PG8_STAGE(PG8_SA(0, 0), cA, voffA); PG8_STAGE(PG8_SA(0, 1), cA + hstep, voffA);
        if (wr == 1) PG8_BAR;
        PG8_WAIT_V(2); PG8_BAR;
        PG8_STAGE(PG8_SB(1, 0), cB + kstep, voffB); PG8_STAGE(PG8_SA(1, 0), cA + kstep, voffA); PG8_STAGE(PG8_SB(1, 1), cB + hstep + kstep, voffB);
        PG8_WAIT_V(6); PG8_BAR;
    } else {
        PG8_STAGE(PG8_SB(0, 0), cB, voffB); PG8_STAGE(PG8_SA(0, 0), cA, voffA); PG8_STAGE(PG8_SB(0, 1), cB + hstep, voffB); PG8_STAGE(PG8_SA(0, 1), cA + hstep, voffA);
        if (wr == 1) PG8_BAR;
        PG8_WAIT_V(4); PG8_BAR;
        PG8_STAGE(PG8_SB(1, 0), cB + kstep, voffB); PG8_STAGE(PG8_SA(1, 0), cA + kstep, voffA); PG8_STAGE(PG8_SB(1, 1), cB + hstep + kstep, voffB);
        PG8_WAIT_V(6); PG8_BAR;
    }
    for (;;) {
        const bool has_next = S.next(ui + 1, nxt);
        const char* nA = has_next ? (const char*)(g.A + nxt.seg * g.segA) + (size_t)nxt.pm * tstep : cA; const char* nB = has_next ? (const char*)(g.Bt + nxt.seg * g.segB) + (size_t)nxt.pn * tstep : cB;
        for (int t = 0; t < nt; t += 2) {
            const bool last = (t == nt - 2);
            const char* a1 = cA + (size_t)(t + 1) * kstep;
            const char* a2 = last ? nA : cA + (size_t)(t + 2) * kstep; const char* b2 = last ? nB : cB + (size_t)(t + 2) * kstep;
            const char* a3 = a2 + kstep; const char* b3 = b2 + kstep;
            if constexpr (SP2) {
            PG8_LDB(B0, 0, 0); PG8_LDB(B1, 0, 1); PG8_SCHED; PG8_LDA(At, 0, 0); PG8_STAGE(PG8_SA(1, 1), a1 + hstep, voffA);
            PG8_WAIT_V(8); PG8_WAIT_L(0); PG8_BAR; PG8_MMA(0, 0, At, B0); PG8_MMA(0, 1, At, B1); PG8_BAR; PG8_SCHED;
            PG8_LDA(At, 0, 1); PG8_STAGE(PG8_SB(0, 0), b2, voffB); PG8_STAGE(PG8_SB(0, 1), b2 + hstep, voffB); PG8_STAGE(PG8_SA(0, 0), a2, voffA);
            PG8_WAIT_V(8); PG8_WAIT_L(0); PG8_BAR; PG8_MMA(1, 0, At, B0); PG8_MMA(1, 1, At, B1); PG8_BAR; PG8_SCHED;
            PG8_LDB(B0, 1, 0); PG8_LDB(B1, 1, 1); PG8_SCHED; PG8_LDA(At, 1, 0); PG8_STAGE(PG8_SA(0, 1), a2 + hstep, voffA);
            PG8_WAIT_V(8); PG8_WAIT_L(0); PG8_BAR; PG8_MMA(0, 0, At, B0); PG8_MMA(0, 1, At, B1); PG8_BAR; PG8_SCHED;
            PG8_LDA(At, 1, 1); PG8_STAGE(PG8_SB(1, 0), b3, voffB); PG8_STAGE(PG8_SB(1, 1), b3 + hstep, voffB); PG8_STAGE(PG8_SA(1, 0), a3, voffA);
            PG8_WAIT_V(8); PG8_WAIT_L(0); PG8_BAR; PG8_MMA(1, 0, At, B0); PG8_MMA(1, 1, At, B1); PG8_BAR; PG8_SCHED;
            } else {
            PG8_LDB(B0, 0, 0); PG8_SCHED; PG8_LDA(At, 0, 0); PG8_STAGE(PG8_SA(1, 1), a1 + hstep, voffA);
            PG8_WAIT_L(8); PG8_BAR; PG8_WAIT_L(0); PG8_MMA(0, 0, At, B0); PG8_BAR; PG8_SCHED;
            PG8_LDB(B1, 0, 1); PG8_STAGE(PG8_SB(0, 0), b2, voffB);
            PG8_BAR; PG8_WAIT_L(0); PG8_MMA(0, 1, At, B1); PG8_BAR;
            PG8_LDA(At, 0, 1); PG8_STAGE(PG8_SA(0, 0), a2, voffA);
            PG8_BAR; PG8_WAIT_L(0); PG8_MMA(1, 0, At, B0); PG8_BAR; PG8_SCHED;
            PG8_STAGE(PG8_SB(0, 1), b2 + hstep, voffB);
            PG8_WAIT_V(6); PG8_BAR; PG8_MMA(1, 1, At, B1); PG8_BAR;
            PG8_LDB(B0, 1, 0); PG8_SCHED; PG8_LDA(At, 1, 0); PG8_STAGE(PG8_SA(0, 1), a2 + hstep, voffA);
            PG8_WAIT_L(8); PG8_BAR; PG8_WAIT_L(0); PG8_MMA(0, 0, At, B0); PG8_BAR; PG8_SCHED;
            PG8_LDB(B1, 1, 1); PG8_STAGE(PG8_SB(1, 0), b3, voffB);
            PG8_BAR; PG8_WAIT_L(0); PG8_MMA(0, 1, At, B1); PG8_BAR;
            PG8_LDA(At, 1, 1); PG8_STAGE(PG8_SA(1, 0), a3, voffA);
            PG8_BAR; PG8_WAIT_L(0); PG8_MMA(1, 0, At, B0); PG8_BAR; PG8_SCHED;
            PG8_STAGE(PG8_SB(1, 1), b3 + hstep, voffB);
            PG8_WAIT_V(6); PG8_BAR; PG8_MMA(1, 1, At, B1); PG8_BAR;
            }
        }
        if constexpr (ALIGN_EPI) { if (wr == 0) PG8_BAR; }
        E(acc, cur, wr, wc, fr, fq);
        if (!has_next) break;
#pragma unroll
        for (int a = 0; a < 2; ++a)
#pragma unroll
            for (int b = 0; b < 2; ++b)
#pragma unroll
                for (int m = 0; m < 4; ++m)
#pragma unroll
                    for (int n = 0; n < 2; ++n) acc[a][b][m][n] = (f32x4){0.f, 0.f, 0.f, 0.f};
        cur = nxt; cA = nA; cB = nB; ++ui;
        if constexpr (ALIGN_EPI) { if (wr == 1) PG8_BAR; }
    }
    PG8_WAIT_V(0);
    if constexpr (!ALIGN_EPI) { if (wr == 0) PG8_BAR; }
    PG8_BAR;
#undef PG8_SA
#undef PG8_SB
#undef PG8_STAGE
#undef PG8_LDA
#undef PG8_LDB
#undef PG8_MMA
#undef PG8_WAIT_V
#undef PG8_WAIT_L
#undef PG8_BAR
#undef PG8_SCHED
}

typedef f32x4 Acc[2][2][4][2];

__device__ __forceinline__ u32x4 pack8(const f32x4 a, const f32x4 b) {
    u32x4 w; w.x = cvt_pk_bf16(a[0], a[1]); w.y = cvt_pk_bf16(a[2], a[3]); w.z = cvt_pk_bf16(b[0], b[1]); w.w = cvt_pk_bf16(b[2], b[3]); return w;
}

struct EpiSwiGLU {
    static constexpr bool PERM = true;
    bf16_t* H;
    __device__ __forceinline__ void operator()(const Acc& acc, const Unit& u, int wr, int wc, int fr, int fq) const {
        const int row0 = u.pm * BM + wr * 64 + fr, col0 = u.pn * HALF + wc * 32 + 8 * fq;
#pragma unroll
        for (int ai = 0; ai < 2; ++ai)
#pragma unroll
            for (int m = 0; m < 4; ++m) {
                bf16_t* rowp = H + (size_t)(row0 + ai * HALF + m * 16) * DFF + col0;
                f32x4 h0, h1;
#pragma unroll
                for (int j = 0; j < 4; ++j) { h0[j] = siluf_(acc[ai][0][m][0][j]) * acc[ai][1][m][0][j]; h1[j] = siluf_(acc[ai][0][m][1][j]) * acc[ai][1][m][1][j]; }
                *(u32x4*)rowp = pack8(h0, h1);
                __builtin_amdgcn_sched_barrier(0);
            }
    }
};

struct EpiResid {
    static constexpr bool PERM = false;
    const float* in0; const float* in1; float* out; const float* gate; float coef;
    __device__ __forceinline__ void operator()(const Acc& acc, const Unit& u, int wr, int wc, int fr, int fq) const {
        const int v = u.pm < 32 ? 0 : 1 + ((u.pm - 32) >> 4);
        const float* gv = gate + (size_t)v * MODW;
        const float* in = u.pm < 32 ? in0 : in1;
        const int col0 = u.pn * BM + wc * 32 + 4 * fq;
        f32x4 g[2][2];
#pragma unroll
        for (int bj = 0; bj < 2; ++bj)
#pragma unroll
            for (int n = 0; n < 2; ++n) g[bj][n] = *(const f32x4*)(gv + col0 + bj * HALF + n * 16) * coef;
#pragma unroll
        for (int ai = 0; ai < 2; ++ai) {
            f32x4 x[4][2][2];
#pragma unroll
            for (int m = 0; m < 4; ++m) {
                const size_t off = (size_t)(u.pm * BM + ai * HALF + wr * 64 + m * 16 + fr) * DM + col0;
#pragma unroll
                for (int bj = 0; bj < 2; ++bj)
#pragma unroll
                    for (int n = 0; n < 2; ++n) x[m][bj][n] = *(const f32x4*)(in + off + bj * HALF + n * 16);
            }
            __builtin_amdgcn_sched_barrier(0);
#pragma unroll
            for (int m = 0; m < 4; ++m) {
                const size_t off = (size_t)(u.pm * BM + ai * HALF + wr * 64 + m * 16 + fr) * DM + col0;
#pragma unroll
                for (int bj = 0; bj < 2; ++bj)
#pragma unroll
                    for (int n = 0; n < 2; ++n) *(f32x4*)(out + off + bj * HALF + n * 16) = x[m][bj][n] + g[bj][n] * acc[ai][bj][m][n];
            }
            __builtin_amdgcn_sched_barrier(0);
        }
    }
};

struct EpiWin {
    static constexpr bool PERM = true;
    bf16_t *GLU, *CH, *BG, *Q, *Kb, *Vb; const float *qg, *kg; float *newk, *newv; int layer;
    __device__ __forceinline__ void operator()(const Acc& acc, const Unit& u, int wr, int wc, int fr, int fq) const {
        const int row0 = u.pm * BM + wr * 64 + fr, cw = wc * 32 + 8 * fq, pn = u.pn;
        if (pn < 8) {
            bf16_t* O = (pn < 4 ? GLU : CH); const int col0 = (pn & 3) * HALF + cw;
#pragma unroll
            for (int ai = 0; ai < 2; ++ai)
#pragma unroll
                for (int m = 0; m < 4; ++m) {
                    f32x4 h0, h1;
                    if (pn < 4) {
#pragma unroll
                        for (int j = 0; j < 4; ++j) { h0[j] = acc[ai][0][m][0][j] * sigmoidf_(acc[ai][1][m][0][j]); h1[j] = acc[ai][0][m][1][j] * sigmoidf_(acc[ai][1][m][1][j]); }
                    } else { h0 = acc[ai][0][m][0] * acc[ai][1][m][0]; h1 = acc[ai][0][m][1] * acc[ai][1][m][1]; }
                    *(u32x4*)(O + (size_t)(row0 + ai * HALF + m * 16) * 512 + col0) = pack8(h0, h1);
                    __builtin_amdgcn_sched_barrier(0);
                }
        } else if (pn < 10 || pn >= 14) {
            bf16_t* O = (pn < 10 ? BG : Vb); const int colt = (pn < 10 ? pn - 8 : pn - 14) * BM + cw;
            const bool wnew = (pn >= 14) && (u.pm < 32);
#pragma unroll
            for (int ai = 0; ai < 2; ++ai)
#pragma unroll
                for (int m = 0; m < 4; ++m) {
                    const int row = row0 + ai * HALF + m * 16;
#pragma unroll
                    for (int bj = 0; bj < 2; ++bj) {
                        *(u32x4*)(O + (size_t)row * 512 + colt + bj * HALF) = pack8(acc[ai][bj][m][0], acc[ai][bj][m][1]);
                        if (wnew) { float* p = newv + ((size_t)(u.pm * 2 + layer) * 256 + (row - u.pm * BM)) * 512 + colt + bj * HALF;
                            *(f32x4*)p = acc[ai][bj][m][0]; *(f32x4*)(p + 4) = acc[ai][bj][m][1]; }
                    }
                    __builtin_amdgcn_sched_barrier(0);
                }
        } else {
            const bool isk = pn >= 12; bf16_t* O = isk ? Kb : Q; const float* gn = isk ? kg : qg;
            const int head = 4 * ((pn - 10) & 1) + wc; const bool wnew = isk && (u.pm < 32);
            f32x4 gv[2][2];
#pragma unroll
            for (int bj = 0; bj < 2; ++bj)
#pragma unroll
                for (int n = 0; n < 2; ++n) gv[bj][n] = *(const f32x4*)(gn + 32 * bj + 8 * fq + 4 * n);
#pragma unroll
            for (int ai = 0; ai < 2; ++ai)
#pragma unroll
                for (int m = 0; m < 4; ++m) {
                    const int row = row0 + ai * HALF + m * 16;
                    float ss = 0.f;
#pragma unroll
                    for (int bj = 0; bj < 2; ++bj)
#pragma unroll
                        for (int n = 0; n < 2; ++n) { const f32x4 x = acc[ai][bj][m][n]; ss += (x[0] * x[0] + x[1] * x[1]) + (x[2] * x[2] + x[3] * x[3]); }
                    ss += __shfl_xor(ss, 16); ss += __shfl_xor(ss, 32);
                    const float rinv = __builtin_amdgcn_rsqf(ss * (1.f / 64.f) + EPS);
#pragma unroll
                    for (int bj = 0; bj < 2; ++bj) {
                        const f32x4 y0 = acc[ai][bj][m][0] * rinv * gv[bj][0], y1 = acc[ai][bj][m][1] * rinv * gv[bj][1];
                        const int col = head * 64 + 32 * bj + 8 * fq;
                        *(u32x4*)(O + (size_t)row * 512 + col) = pack8(y0, y1);
                        if (wnew) { float* p = newk + ((size_t)(u.pm * 2 + layer) * 256 + (row - u.pm * BM)) * 512 + col; *(f32x4*)p = y0; *(f32x4*)(p + 4) = y1; }
                    }
                    __builtin_amdgcn_sched_barrier(0);
                }
        }
    }
};

struct EpiGates {
    static constexpr bool PERM = true;
    bf16_t* GS;
    __device__ __forceinline__ void operator()(const Acc& acc, const Unit& u, int wr, int wc, int fr, int fq) const {
        const int gi = u.pn >> 2; const int bi = gi == 0 ? 2 : gi - 1; bf16_t* O = GS + (size_t)bi * GS_STRIDE;
        const int row0 = u.pm * BM + wr * 64 + fr, col0 = (u.pn & 3) * BM + wc * 32 + 8 * fq;
#pragma unroll
        for (int ai = 0; ai < 2; ++ai)
#pragma unroll
            for (int m = 0; m < 4; ++m)
#pragma unroll
                for (int bj = 0; bj < 2; ++bj) {
                    f32x4 h0, h1;
#pragma unroll
                    for (int j = 0; j < 4; ++j) { h0[j] = sigmoidf_(acc[ai][bj][m][0][j]); h1[j] = sigmoidf_(acc[ai][bj][m][1][j]); }
                    *(u32x4*)(O + (size_t)(row0 + ai * HALF + m * 16) * DM + col0 + bj * HALF) = pack8(h0, h1);
                    __builtin_amdgcn_sched_barrier(0);
                }
    }
};

struct EpiM {
    static constexpr bool PERM = true;
    const bf16_t* GS; bf16_t* Mo;
    __device__ __forceinline__ void operator()(const Acc& acc, const Unit& u, int wr, int wc, int fr, int fq) const {
        const bf16_t* Gs = GS + (size_t)u.seg * GS_STRIDE;
        const int row0 = u.pm * BM + wr * 64 + fr, col0 = u.pn * BM + wc * 32 + 8 * fq;
#pragma unroll
        for (int ai = 0; ai < 2; ++ai) {
            u32x4 gw[4][2], mw[4][2];
#pragma unroll
            for (int m = 0; m < 4; ++m)
#pragma unroll
                for (int bj = 0; bj < 2; ++bj) {
                    const size_t off = (size_t)(row0 + ai * HALF + m * 16) * DM + col0 + bj * HALF;
                    gw[m][bj] = *(const u32x4*)(Gs + off);
                    mw[m][bj] = (u32x4){0u, 0u, 0u, 0u};
                    if (u.seg != 0) mw[m][bj] = *(const u32x4*)(Mo + off);
                }
            __builtin_amdgcn_sched_barrier(0);
#pragma unroll
            for (int m = 0; m < 4; ++m)
#pragma unroll
                for (int bj = 0; bj < 2; ++bj) {
                    const size_t off = (size_t)(row0 + ai * HALF + m * 16) * DM + col0 + bj * HALF;
                    const u32x4 g4 = gw[m][bj], m4 = mw[m][bj];
                    f32x4 h0, h1;
                    h0[0] = bflo(g4.x) * acc[ai][bj][m][0][0] + bflo(m4.x); h0[1] = bfhi(g4.x) * acc[ai][bj][m][0][1] + bfhi(m4.x);
                    h0[2] = bflo(g4.y) * acc[ai][bj][m][0][2] + bflo(m4.y); h0[3] = bfhi(g4.y) * acc[ai][bj][m][0][3] + bfhi(m4.y);
                    h1[0] = bflo(g4.z) * acc[ai][bj][m][1][0] + bflo(m4.z); h1[1] = bfhi(g4.z) * acc[ai][bj][m][1][1] + bfhi(m4.z);
                    h1[2] = bflo(g4.w) * acc[ai][bj][m][1][2] + bflo(m4.w); h1[3] = bfhi(g4.w) * acc[ai][bj][m][1][3] + bfhi(m4.w);
                    *(u32x4*)(Mo + off) = pack8(h0, h1);
                }
            __builtin_amdgcn_sched_barrier(0);
        }
    }
};
}

struct Args { const float* in[32]; };
__device__ __forceinline__ const float* inp(const Args& a, int i) { return a.in[i + opaque_zero()]; }

__device__ __forceinline__ void cvt_block(const float* W, int N, int K, int k0, int n0, bf16_t* WT, int dst_row0, float* scr, int lane) {
    const int kq = lane >> 3, n4 = (lane & 7) * 4;
    f32x4 v[8];
#pragma unroll
    for (int i = 0; i < 8; ++i) v[i] = *(const f32x4*)(W + (size_t)(k0 + kq + 8 * i) * N + n0 + n4);
#pragma unroll
    for (int i = 0; i < 8; ++i) { float* d = scr + (kq + 8 * i) * 33 + n4; d[0] = v[i][0]; d[1] = v[i][1]; d[2] = v[i][2]; d[3] = v[i][3]; }
    LDS_WAIT();
    const int c = lane & 7;
#pragma unroll
    for (int j = 0; j < 4; ++j) { const int n = (lane >> 3) + 8 * j; const float* s = scr + (8 * c) * 33 + n;
        u32x4 o; o.x = pk2(s[0 * 33], s[1 * 33]); o.y = pk2(s[2 * 33], s[3 * 33]); o.z = pk2(s[4 * 33], s[5 * 33]); o.w = pk2(s[6 * 33], s[7 * 33]);
        *(u32x4*)(WT + (size_t)(dst_row0 + n) * K + k0 + 8 * c) = o; }
    LDS_WAIT();
}
__device__ __forceinline__ int win_dst(int n) {
    if (n < 512) return 256 * (n >> 7) + (n & 127);
    if (n < 1024) { const int s = n - 512; return 256 * (s >> 7) + 128 + (s & 127); }
    if (n < 1536) return 2048 + (n - 1024);
    if (n < 2048) { const int s = n - 1536; return 1024 + 256 * (s >> 7) + (s & 127); }
    if (n < 2560) { const int s = n - 2048; return 1024 + 256 * (s >> 7) + 128 + (s & 127); }
    if (n < 3584) { const int base = n < 3072 ? 2560 : 3072; const int s = n - base, head = s >> 6, dim = s & 63;
        return base + 256 * (head >> 2) + 128 * (dim >> 5) + 32 * (head & 3) + (dim & 31); }
    return n;
}
__device__ __forceinline__ void convert_weights(const Args& a, int l, unsigned char* lds, int gw, int ngw, int wave, int lane) {
    float* scr = (float*)(lds + wave * 8448);
    unsigned char* ws = (unsigned char*)inp(a, 31);
    constexpr int I_GU = 16 * 88, I_D = 44 * 32, I_IN = 16 * 224, I_O = 8 * 32, I_M = 16 * 32;
    constexpr int NIT = 6 * I_GU + I_IN + 3 * I_O + I_M;
    static_assert(I_GU == I_D, "");
    for (int it = gw; it < NIT; it += ngw) {
        int r = it;
        if (r < 6 * I_GU) {
            const int which = r / I_GU; r -= which * I_GU;
            const int ff = which / 3, kind = which % 3;
            if (kind < 2) {
                const float* W = inp(a, (ff ? 27 : 9) + kind) + (size_t)l * DM * DFF;
                const int kb = r / 88, nb = r % 88, n0 = nb * 32;
                cvt_block(W, DFF, DM, kb * 64, n0, (bf16_t*)(ws + (ff ? W_GU2 : W_GU1)), 256 * (n0 >> 7) + 128 * kind + (n0 & 127), scr, lane);
            } else {
                const float* W = inp(a, ff ? 29 : 11) + (size_t)l * DFF * DM;
                const int kb = r / 32, nb = r % 32;
                cvt_block(W, DM, DFF, kb * 64, nb * 32, (bf16_t*)(ws + (ff ? W_D2 : W_D1)), nb * 32, scr, lane);
            }
            continue;
        }
        r -= 6 * I_GU;
        if (r < I_IN) { const int kb = r / 224, nb = r % 224; cvt_block(inp(a, 13) + (size_t)l * DM * NIN, NIN, DM, kb * 64, nb * 32, (bf16_t*)(ws + W_IN), win_dst(nb * 32), scr, lane); continue; }
        r -= I_IN;
        if (r < 3 * I_O) { const int which = r / I_O; r -= which * I_O; const int kb = r / 32, nb = r % 32;
            const float* W = inp(a, which == 0 ? 18 : (which == 1 ? 20 : 24)) + (size_t)l * 512 * DM;
            cvt_block(W, DM, 512, kb * 64, nb * 32, (bf16_t*)(ws + (which == 0 ? W_A : (which == 1 ? W_B : W_C))), nb * 32, scr, lane); continue; }
        r -= 3 * I_O;
        { const int kb = r / 32, nb = r % 32; cvt_block(inp(a, 25) + (size_t)l * DM * DM, DM, DM, kb * 64, nb * 32, (bf16_t*)(ws + W_M), nb * 32, scr, lane); }
    }
}

__device__ __forceinline__ void compute_mods(const Args& a, unsigned char* lds, int tid, int wave, int lane) {
    float* sT = (float*)lds;
    float* red = (float*)(lds + 49152);
    const float* c = inp(a, 4); const float* cctx = inp(a, 5);
    for (int k = tid; k < DM; k += NTHR) {
        sT[k * 12 + 0] = siluf_(cctx[k]);
#pragma unroll
        for (int v = 1; v < 9; ++v) sT[k * 12 + v] = siluf_(c[(v - 1) * DM + k]);
        sT[k * 12 + 9] = 0.f; sT[k * 12 + 10] = 0.f; sT[k * 12 + 11] = 0.f;
    }
    __syncthreads();
    float* mods = (float*)((unsigned char*)inp(a, 31) + WS_MODS);
    for (int unit = blockIdx.x; unit < 288; unit += gridDim.x) {
        const int l = unit / 144, cb = unit % 144, col = cb * 64 + lane;
        const float* W = inp(a, 6) + (size_t)l * DM * MODW + col;
        float acc[9];
#pragma unroll
        for (int v = 0; v < 9; ++v) acc[v] = 0.f;
#pragma unroll 32
        for (int kk = 0; kk < 128; ++kk) {
            const int k = wave * 128 + kk;
            const float w = W[(size_t)k * MODW];
            const f32x4 s0 = *(const f32x4*)(sT + k * 12), s1 = *(const f32x4*)(sT + k * 12 + 4), s2 = *(const f32x4*)(sT + k * 12 + 8);
            acc[0] += s0[0] * w; acc[1] += s0[1] * w; acc[2] += s0[2] * w; acc[3] += s0[3] * w;
            acc[4] += s1[0] * w; acc[5] += s1[1] * w; acc[6] += s1[2] * w; acc[7] += s1[3] * w; acc[8] += s2[0] * w;
        }
#pragma unroll
        for (int v = 0; v < 9; ++v) red[(wave * 9 + v) * 64 + lane] = acc[v];
        __syncthreads();
        for (int idx = tid; idx < 576; idx += NTHR) {
            const int v = idx >> 6, ln = idx & 63; float s = inp(a, 7)[(size_t)l * MODW + cb * 64 + ln];
#pragma unroll
            for (int w = 0; w < 8; ++w) s += red[(w * 9 + v) * 64 + ln];
            mods[((size_t)l * 9 + v) * MODW + cb * 64 + ln] = s;
        }
        __syncthreads();
    }
}

__device__ __forceinline__ void adaln_phase(const float* in0, const float* in1, const float* g, const float* modl, int ish, bf16_t* U, int gw, int ngw, int lane) {
    static_assert(MTOK % (2 * 256 * NWAVES) == 0, "row pairs");
    for (int row0 = gw; row0 < MTOK; row0 += 2 * ngw) {
        f32x4 x[2][4];
#pragma unroll
        for (int h = 0; h < 2; ++h) { const int row = min(row0 + h * ngw, MTOK - 1); const float* xr = (row < NCTX ? in0 : in1) + (size_t)row * DM;
#pragma unroll
            for (int j = 0; j < 4; ++j) x[h][j] = *(const f32x4*)(xr + 256 * j + 4 * lane); }
#pragma unroll
        for (int h = 0; h < 2; ++h) {
            const int row = row0 + h * ngw; if (row >= MTOK) break;
            const int v = row < NCTX ? 0 : 1 + ((row - NCTX) >> 12);
            const float* sh = modl + (size_t)v * MODW + ish * DM; const float* sc = sh + DM;
            float ss = 0.f;
#pragma unroll
            for (int j = 0; j < 4; ++j) ss += (x[h][j][0] * x[h][j][0] + x[h][j][1] * x[h][j][1]) + (x[h][j][2] * x[h][j][2] + x[h][j][3] * x[h][j][3]);
            const float rinv = __builtin_amdgcn_rsqf(wave_sum(ss) * (1.f / DM) + EPS);
#pragma unroll
            for (int j = 0; j < 4; ++j) {
                const int c = 256 * j + 4 * lane;
                const f32x4 gg = *(const f32x4*)(g + c), s1 = *(const f32x4*)(sc + c), s0 = *(const f32x4*)(sh + c);
                const f32x4 y = x[h][j] * rinv * gg * (s1 + 1.f) + s0;
                u32x2 w; w.x = pk2(y[0], y[1]); w.y = pk2(y[2], y[3]);
                *(u32x2*)(U + (size_t)row * DM + c) = w;
            }
        }
    }
}

namespace att {
constexpr int TK = 128, PITCH = 144, KS_OFF = 0, VS_OFF = TK * PITCH, RPB_OFF = 2 * TK * PITCH, CNT_OFF = RPB_OFF + 15 * 32 * 4, HALF_BYTES = 39936;
static_assert(CNT_OFF + 64 <= HALF_BYTES, "attention LDS map");
typedef short v4i16_t __attribute__((ext_vector_type(4)));
__device__ __forceinline__ s16x4 vtr(const LAS char* p) { return __builtin_bit_cast(s16x4, __builtin_amdgcn_ds_read_tr16_b64_v4i16((LAS v4i16_t*)p)); }

struct TileSrc { const bf16_t* k; const bf16_t* v; };

template <bool LOCAL>
__device__ __forceinline__ void tile_compute(const LAS char* ldsb, const bf16x8 (&qf)[2], f32x4 (&O)[4], float& mrun, float& lrun,
                                             int hl, int kbase, int koff, int fr, int fq, int lane, const float* rpbrow, const int (&dci)[8], unsigned vmask) {
    constexpr int NMT = LOCAL ? 2 : 4;
#define ATT_KEYOFF(mt) (kbase + (LOCAL ? koff : 0) + 16 * (mt))
    f32x4 s[NMT];
#pragma unroll
    for (int mt = 0; mt < NMT; ++mt) {
        s[mt] = (f32x4){0.f, 0.f, 0.f, 0.f};
#pragma unroll
        for (int ks = 0; ks < 2; ++ks) {
            const bf16x8 kf = *(const LAS bf16x8*)(ldsb + KS_OFF + (ATT_KEYOFF(mt) + fr) * PITCH + hl * 128 + ks * 64 + fq * 16);
            s[mt] = __builtin_amdgcn_mfma_f32_16x16x32_bf16(kf, qf[ks], s[mt], 0, 0, 0);
        }
    }
    constexpr float C1 = 0.125f * 1.4426950408889634f;
    float tmax = -1e30f;
    if (LOCAL) {
#pragma unroll
        for (int mt = 0; mt < NMT; ++mt)
#pragma unroll
            for (int j = 0; j < 4; ++j) {
                float v = __builtin_fmaf(s[mt][j], C1, rpbrow[dci[mt * 4 + j]]);
                if (!((vmask >> (mt * 4 + j)) & 1u)) v = -1e30f;
                s[mt][j] = v; tmax = fmaxf(tmax, v);
            }
    } else {
#pragma unroll
        for (int mt = 0; mt < NMT; ++mt)
#pragma unroll
            for (int j = 0; j < 4; ++j) tmax = fmaxf(tmax, s[mt][j]);
        tmax *= C1;
    }
    tmax = fmaxf(tmax, __shfl_xor(tmax, 16)); tmax = fmaxf(tmax, __shfl_xor(tmax, 32));
    const float mnew = fmaxf(mrun, tmax), alpha = __builtin_amdgcn_exp2f(mrun - mnew);
    float psum = 0.f;
#pragma unroll
    for (int mt = 0; mt < NMT; ++mt)
#pragma unroll
        for (int j = 0; j < 4; ++j) { const float p = __builtin_amdgcn_exp2f(LOCAL ? s[mt][j] - mnew : __builtin_fmaf(s[mt][j], C1, -mnew)); s[mt][j] = p; psum += p; }
    lrun = lrun * alpha + psum; mrun = mnew;
#pragma unroll
    for (int dt = 0; dt < 4; ++dt) O[dt] = O[dt] * alpha;
    const int g = lane >> 4, q = (lane & 15) >> 2, p4 = lane & 3;
#pragma unroll
    for (int kk = 0; kk < NMT / 2; ++kk) {
        bf16x8 pb;
        { const u32x4 w = pg8::pack8(s[2 * kk], s[2 * kk + 1]); pb = __builtin_bit_cast(bf16x8, w); }
#pragma unroll
        for (int dt = 0; dt < 4; ++dt) {
            const LAS char* vb = ldsb + VS_OFF + hl * 128 + 32 * dt + 8 * p4;
            const s16x4 v0 = vtr(vb + (ATT_KEYOFF(2 * kk) + 4 * g + q) * PITCH);
            const s16x4 v1 = vtr(vb + (ATT_KEYOFF(2 * kk + 1) + 4 * g + q) * PITCH);
            bf16x8 vf; vf[0] = v0[0]; vf[1] = v0[1]; vf[2] = v0[2]; vf[3] = v0[3]; vf[4] = v1[0]; vf[5] = v1[1]; vf[6] = v1[2]; vf[7] = v1[3];
            O[dt] = __builtin_amdgcn_mfma_f32_16x16x32_bf16(vf, pb, O[dt], 0, 0, 0);
        }
    }
#undef ATT_KEYOFF
}

__device__ __forceinline__ void hbar(unsigned char* hl_lds, unsigned& target, int lane) {
    asm volatile("s_waitcnt lgkmcnt(0)" ::: "memory");
    target += 4u;
    volatile LAS unsigned* cnt = (volatile LAS unsigned*)(LAS unsigned char*)(hl_lds + CNT_OFF);
    if (lane == 0) (void)__hip_atomic_fetch_add((LAS unsigned*)(LAS unsigned char*)(hl_lds + CNT_OFF), 1u, __ATOMIC_RELAXED, __HIP_MEMORY_SCOPE_WORKGROUP);
    while ((int)(*cnt - target) < 0) __builtin_amdgcn_s_sleep(0);
    asm volatile("" ::: "memory");
}

template <bool LATENT>
__device__ __forceinline__ void unit(unsigned char* hlds, unsigned& btarget, bf16_t* QO, const bf16_t* Kb, const bf16_t* Vb, const bf16_t* CK, const bf16_t* CV, const float* rpb_l,
                                     int qrow0  , int keyrow0  , int head, int r  ,
                                     int ht, int J, int lane) {
    unsigned char* lds = hlds;
    const LAS char* ldsb = (const LAS char*)(LAS unsigned char*)hlds;
    const int fr = lane & 15, fq = lane >> 4;
    const int rs = LATENT ? min(max(r - 4, 0), 56) : 0;
    constexpr int NT = LATENT ? 8 : 2;
    int dci[8]; unsigned vmask = 0u; int koff = 0;
    if (LATENT) {
        const int qc = 16 * J + fr, wstart = min(max(qc - 8, 0), 48);
        koff = min(max(16 * J - 8, 0), 32);
#pragma unroll
        for (int mt = 0; mt < 2; ++mt)
#pragma unroll
            for (int j = 0; j < 4; ++j) { const int kc = koff + 16 * mt + 4 * fq + j;
                dci[mt * 4 + j] = min(max(kc - qc, -15), 15) + 15;
                if (kc >= wstart && kc < wstart + 16) vmask |= 1u << (mt * 4 + j); }
        float* tb = (float*)(lds + RPB_OFF);
        for (int i = ht; i < 15 * 32; i += 256) { const int dr = i >> 5, dc = i & 31; tb[i] = dc < 31 ? rpb_l[(head * 15 + dr) * 31 + dc] * 1.4426950408889634f : 0.f; }
    } else {
#pragma unroll
        for (int i = 0; i < 8; ++i) dci[i] = 0;
    }
    bf16x8 qf[2];
    { const bf16_t* qp = QO + (size_t)(qrow0 + 16 * J + fr) * 512 + head * 64 + 8 * fq;
      qf[0] = *(const bf16x8*)qp; qf[1] = *(const bf16x8*)(qp + 32); }
    f32x4 O[4], OB[4];
#pragma unroll
    for (int dt = 0; dt < 4; ++dt) { O[dt] = (f32x4){0.f, 0.f, 0.f, 0.f}; OB[dt] = (f32x4){0.f, 0.f, 0.f, 0.f}; }
    float mrun = -1e30f, lrun = 0.f, mrunB = -1e30f, lrunB = 0.f;
    const int key0 = ht >> 3, part = ht & 7;
    u32x4 kA[4], vA[4], kB[4], vB[4];
    auto tsrc = [&](int t) -> TileSrc {
        TileSrc s;
        if (LATENT) {
            if (t < 4) { s.k = CK + (size_t)(t * TK) * 512 + head * 64; s.v = CV + (size_t)(t * TK) * 512 + head * 64; }
            else { const size_t ro = (size_t)(keyrow0 + (rs + 2 * (t - 4)) * 64) * 512 + head * 64; s.k = Kb + ro; s.v = Vb + ro; }
        } else { const size_t ro = (size_t)(keyrow0 + t * TK) * 512 + head * 64; s.k = Kb + ro; s.v = Vb + ro; }
        return s;
    };
#define ATT_GLOAD(KR, VR, t) do { const TileSrc s_ = tsrc(t); _Pragma("unroll") for (int i = 0; i < 4; ++i) { const size_t o = (size_t)(key0 + 32 * i) * 512 + part * 8; \
        KR[i] = *(const u32x4*)(s_.k + o); VR[i] = *(const u32x4*)(s_.v + o); } } while (0)
#define ATT_BAR() hbar(hlds, btarget, lane)
#define ATT_LSTORE(KR, VR) do { _Pragma("unroll") for (int i = 0; i < 4; ++i) { const int lo = (key0 + 32 * i) * PITCH + part * 16; \
        *(u32x4*)(lds + KS_OFF + lo) = KR[i]; *(u32x4*)(lds + VS_OFF + lo) = VR[i]; } } while (0)
#define ATT_COMPUTE(t) do { if (LATENT && (t) >= 4) { const int dr = (rs + 2 * ((t) - 4)) - r + 7; \
            const float* rpbrow = (const float*)(lds + RPB_OFF) + dr * 32; \
            tile_compute<true>(ldsb, qf, O, mrun, lrun, 0, 0, koff, fr, fq, lane, rpbrow, dci, vmask); \
            tile_compute<true>(ldsb, qf, OB, mrunB, lrunB, 0, 64, koff, fr, fq, lane, rpbrow + 32, dci, vmask); \
        } else { tile_compute<false>(ldsb, qf, O, mrun, lrun, 0, 0, 0, fr, fq, lane, nullptr, dci, 0u); \
                 tile_compute<false>(ldsb, qf, OB, mrunB, lrunB, 0, 64, 0, fr, fq, lane, nullptr, dci, 0u); } } while (0)
    ATT_GLOAD(kA, vA, 0); ATT_GLOAD(kB, vB, 1);
    for (int t = 0; t < NT; t += 2) {
        ATT_BAR();
        ATT_LSTORE(kA, vA);
        ATT_BAR();
        if (t + 2 < NT) ATT_GLOAD(kA, vA, t + 2);
        ATT_COMPUTE(t);
        ATT_BAR();
        ATT_LSTORE(kB, vB);
        ATT_BAR();
        if (t + 3 < NT) ATT_GLOAD(kB, vB, t + 3);
        ATT_COMPUTE(t + 1);
    }
#undef ATT_GLOAD
#undef ATT_BAR
#undef ATT_LSTORE
#undef ATT_COMPUTE
    { const float mm = fmaxf(mrun, mrunB), aA = __builtin_amdgcn_exp2f(mrun - mm), aB = __builtin_amdgcn_exp2f(mrunB - mm);
      lrun = lrun * aA + lrunB * aB;
#pragma unroll
      for (int dt = 0; dt < 4; ++dt) O[dt] = O[dt] * aA + OB[dt] * aB; }
    lrun += __shfl_xor(lrun, 16); lrun += __shfl_xor(lrun, 32);
    const float linv = 1.f / lrun;
    bf16_t* op = QO + (size_t)(qrow0 + 16 * J + fr) * 512 + head * 64 + 4 * fq;
#pragma unroll
    for (int dt = 0; dt < 4; ++dt) { u32x2 w; w.x = cvt_pk_bf16(O[dt][0] * linv, O[dt][1] * linv); w.y = cvt_pk_bf16(O[dt][2] * linv, O[dt][3] * linv); *(u32x2*)(op + 16 * dt) = w; }
    hbar(hlds, btarget, lane);
}
}

__device__ __forceinline__ void conva_unit(unsigned char* lds, const bf16_t* GLU, bf16_t* AOUT, const float* cw, const float* cb, const float* lg, const float* lb,
                                           int rowbase, int len, int t0, int tid, int wave, int lane) {
    bf16_t* in_s = (bf16_t*)lds;
    float* hs = (float*)(lds + 62 * 512 * 2);
    for (int idx = tid; idx < 62 * 64; idx += NTHR) {
        const int i = idx >> 6, ch = idx & 63, p = t0 - 15 + i;
        u32x4 v = (u32x4){0u, 0u, 0u, 0u};
        if (p >= 0 && p < len) v = *(const u32x4*)(GLU + (size_t)(rowbase + p) * 512 + ch * 8);
        *(u32x4*)(in_s + i * 512 + ch * 8) = v;
    }
    float w[31];
#pragma unroll
    for (int j = 0; j < 31; ++j) w[j] = cw[j * 512 + tid];
    const float bias = cb[tid];
    __syncthreads();
    float col[62];
#pragma unroll
    for (int i = 0; i < 62; ++i) col[i] = __uint_as_float((unsigned)in_s[i * 512 + tid] << 16);
#pragma unroll
    for (int tt = 0; tt < 32; ++tt) {
        float acc = bias;
#pragma unroll
        for (int j = 0; j < 31; ++j) acc += col[tt + j] * w[j];
        hs[tt * 512 + tid] = acc;
    }
    __syncthreads();
#pragma unroll
    for (int q = 0; q < 4; ++q) {
        const int tt = wave * 4 + q;
        const f32x4 a = *(const f32x4*)(hs + tt * 512 + lane * 8), b = *(const f32x4*)(hs + tt * 512 + lane * 8 + 4);
        const float mean = wave_sum((a[0] + a[1]) + (a[2] + a[3]) + (b[0] + b[1]) + (b[2] + b[3])) * (1.f / 512.f);
        const f32x4 da = a - mean, db = b - mean;
        const float var = wave_sum((da[0] * da[0] + da[1] * da[1]) + (da[2] * da[2] + da[3] * da[3]) + (db[0] * db[0] + db[1] * db[1]) + (db[2] * db[2] + db[3] * db[3])) * (1.f / 512.f);
        const float rstd = __builtin_amdgcn_rsqf(var + EPS);
        const f32x4 g0 = *(const f32x4*)(lg + lane * 8), g1 = *(const f32x4*)(lg + lane * 8 + 4), b0 = *(const f32x4*)(lb + lane * 8), b1 = *(const f32x4*)(lb + lane * 8 + 4);
        f32x4 y0 = da * rstd * g0 + b0, y1 = db * rstd * g1 + b1;
#pragma unroll
        for (int j = 0; j < 4; ++j) { y0[j] = siluf_(y0[j]); y1[j] = siluf_(y1[j]); }
        *(u32x4*)(AOUT + (size_t)(rowbase + t0 + tt) * 512 + lane * 8) = pg8::pack8(y0, y1);
    }
    __syncthreads();
}

__device__ __forceinline__ f32x4 cb_lo(u32x4 v) { return (f32x4){bflo(v.x), bfhi(v.x), bflo(v.y), bfhi(v.y)}; }
__device__ __forceinline__ f32x4 cb_hi(u32x4 v) { return (f32x4){bflo(v.z), bfhi(v.z), bflo(v.w), bfhi(v.w)}; }
__device__ __forceinline__ void convb_phase(bf16_t* BG, const bf16_t* CH, const float* w3, int gtid, int nthreads) {
    const u32x4 z = (u32x4){0u, 0u, 0u, 0u};
    for (int idx = gtid; idx < (MTOK / 2) * 64; idx += nthreads) {
        const int row = (idx >> 6) * 2, ch = idx & 63;
        int pos, len; if (row < NCTX) { pos = row & 255; len = 256; } else { pos = (row - NCTX) & 4095; len = 4096; }
        const bf16_t* cp = CH + (size_t)row * 512 + ch * 8; bf16_t* bp = BG + (size_t)row * 512 + ch * 8;
        const u32x4 c1 = *(const u32x4*)cp, c2 = *(const u32x4*)(cp + 512);
        const u32x4 c0 = pos > 0 ? *(const u32x4*)(cp - 512) : z;
        const u32x4 c3 = pos + 2 < len ? *(const u32x4*)(cp + 1024) : z;
        const u32x4 b0 = *(const u32x4*)bp, b1 = *(const u32x4*)(bp + 512);
        f32x4 wa[3], wb[3];
#pragma unroll
        for (int j = 0; j < 3; ++j) { wa[j] = *(const f32x4*)(w3 + j * 512 + ch * 8); wb[j] = *(const f32x4*)(w3 + j * 512 + ch * 8 + 4); }
        const f32x4 y0a = cb_lo(b0) * (cb_lo(c0) * wa[0] + cb_lo(c1) * wa[1] + cb_lo(c2) * wa[2]), y0b = cb_hi(b0) * (cb_hi(c0) * wb[0] + cb_hi(c1) * wb[1] + cb_hi(c2) * wb[2]);
        const f32x4 y1a = cb_lo(b1) * (cb_lo(c1) * wa[0] + cb_lo(c2) * wa[1] + cb_lo(c3) * wa[2]), y1b = cb_hi(b1) * (cb_hi(c1) * wb[0] + cb_hi(c2) * wb[1] + cb_hi(c3) * wb[2]);
        *(u32x4*)bp = pg8::pack8(y0a, y0b); *(u32x4*)(bp + 512) = pg8::pack8(y1a, y1b);
    }
}

#define XB_TMO      128
#define XB_XCNT(j)  (256  + 64 * (j))
#define XB_XSUB(j)  (1280 + 64 * (j))
#define XB_XGEN(j)  (2304 + 64 * (j))
#define XB_TOP      3328
#define XB_TOPGEN   3392
#define XCD_BAR_WORDS 3456
#define XB_SPIN_CAP (1u << 18)

__device__ __forceinline__ unsigned xb_ld(unsigned* p)              { return __hip_atomic_load(p, __ATOMIC_RELAXED, __HIP_MEMORY_SCOPE_AGENT); }
__device__ __forceinline__ unsigned xb_add(unsigned* p, unsigned v) { return __hip_atomic_fetch_add(p, v, __ATOMIC_RELAXED, __HIP_MEMORY_SCOPE_AGENT); }
__device__ __forceinline__ unsigned xb_xcc_id() { return (unsigned)__builtin_amdgcn_s_getreg((3 << 11) | 20) & 0xFu; }
#define XB_SPIN(cond, bar) do { unsigned _sp = 0; while (cond) { __builtin_amdgcn_s_sleep(1); \
    if ((++_sp & 255u) == 0u) { if (xb_ld(&(bar)[XB_TMO])) break; if (_sp > XB_SPIN_CAP) { atomicAdd(&(bar)[XB_TMO], 1u); break; } } } } while (0)

struct XcdBarrier {
    unsigned* bar; unsigned x;
    volatile LAS unsigned* st;
};

__device__ __forceinline__ XcdBarrier xcd_barrier_post(unsigned* bar, volatile LAS unsigned* st) {
    XcdBarrier b; b.bar = bar; b.x = xb_xcc_id(); b.st = st;
    if (threadIdx.x == 0) (void)xb_add(&bar[XB_XCNT(b.x)], 1u);
    return b;
}
__device__ __forceinline__ void xcd_barrier_complete(unsigned* bar, unsigned x, unsigned& nloc, unsigned& nx) {
    const unsigned G = gridDim.x * gridDim.y * gridDim.z;
    unsigned sum, cnt, mine, sp = 0u;
    for (;;) {
        sum = 0u; cnt = 0u; mine = 0u;
#pragma unroll
        for (unsigned j = 0; j < 16; ++j) { const unsigned c = xb_ld(&bar[XB_XCNT(j)]); sum += c; cnt += (c > 0u) ? 1u : 0u; mine = (j == x) ? c : mine; }
        if (sum == G) break;
        __builtin_amdgcn_s_sleep(1);
        if ((++sp & 255u) == 0u) { if (xb_ld(&bar[XB_TMO])) break; if (sp > XB_SPIN_CAP) { atomicAdd(&bar[XB_TMO], 1u); break; } }
    }
    nloc = mine > 0u ? mine : 1u; nx = cnt > 0u ? cnt : 1u;
}

__device__ __forceinline__ void xcd_barrier(const XcdBarrier& b) {
    asm volatile("s_waitcnt vmcnt(0)" ::: "memory");
    __syncthreads();
    if (threadIdx.x == 0) {
        unsigned* bar = b.bar;
        __builtin_amdgcn_s_waitcnt(0);
        unsigned nloc = b.st[0], nx = b.st[1];
        if (nloc == 0u) { xcd_barrier_complete(bar, b.x, nloc, nx); b.st[0] = nloc; b.st[1] = nx; }
        const unsigned old = xb_add(&bar[XB_XSUB(b.x)], 1u);
        const unsigned gen = old / nloc;
        if (old + 1u == (gen + 1u) * nloc) {
            __builtin_amdgcn_fence(__ATOMIC_RELEASE, "agent");
            asm volatile("s_waitcnt vmcnt(0)" ::: "memory");
            const unsigned og = xb_add(&bar[XB_TOP], 1u);
            const unsigned tg = og / nx;
            if (og + 1u == (tg + 1u) * nx) xb_add(&bar[XB_TOPGEN], 1u);
            else XB_SPIN(xb_ld(&bar[XB_TOPGEN]) == tg, bar);
            __builtin_amdgcn_fence(__ATOMIC_ACQUIRE, "agent");
            xb_add(&bar[XB_XGEN(b.x)], 1u);
            asm volatile("s_waitcnt vmcnt(0)" ::: "memory");
        } else {
            XB_SPIN(xb_ld(&bar[XB_XGEN(b.x)]) == gen, bar);
            __builtin_amdgcn_fence(__ATOMIC_ACQUIRE, "agent");
            asm volatile("s_waitcnt vmcnt(0)" ::: "memory");
        }
    }
    __syncthreads();
}


#ifndef PHASE_MASK
#define PHASE_MASK 0xFFFFF
#endif
#define PH_ON(n) ((PHASE_MASK >> (n)) & 1)
#ifndef LAST_PHASE
#define LAST_PHASE 99
#endif
#define PHX(n) if (l * 12 + (n) <= LAST_PHASE)

__global__ void __launch_bounds__(NTHR, 2) fwd_megakernel(Args a) {
    extern __shared__ __attribute__((aligned(16))) unsigned char lds[];
    cg::grid_group grid = cg::this_grid();
    const int G = gridDim.x, bx = blockIdx.x;
    PG8_LAS unsigned char* ldsg = (PG8_LAS unsigned char*)lds;
    grid.sync();
    volatile LAS unsigned* bst = (volatile LAS unsigned*)((LAS unsigned char*)lds + LDS_BYTES - 64);
    if (threadIdx.x < 16) bst[threadIdx.x] = 0u;
    __syncthreads();
    (void)xcd_barrier_post((unsigned*)inp(a, 31), bst);
#define GSYNC() do { XcdBarrier b_; b_.bar = (unsigned*)inp(a, 31); b_.x = xb_xcc_id(); b_.st = (volatile LAS unsigned*)((LAS unsigned char*)lds + LDS_BYTES - 64); xcd_barrier(b_); } while (0)
#define TIDS const int tid = threadIdx.x + opaque_vzero(), lane = tid & 63, wave = __builtin_amdgcn_readfirstlane(tid >> 6); \
             const int gw = bx * NWAVES + wave, ngw = G * NWAVES, gtid = bx * NTHR + tid, nthreads = G * NTHR; (void)gw; (void)ngw; (void)gtid; (void)nthreads; (void)lane;
#define BASES const int z_ = opaque_zero(); unsigned char* ws = (unsigned char*)inp(a, 31); float* out = (float*)inp(a, 30); const int lp = l + z_; const int bxp = bx + z_, Gp = G + z_; (void)bxp; (void)Gp; \
              const float* modl = (const float*)(ws + WS_MODS) + (size_t)lp * 9 * MODW; (void)modl; (void)out;

    {
        TIDS
#if PH_ON(0)
        compute_mods(a, lds, tid, wave, lane);
#endif
        unsigned char* ws = (unsigned char*)inp(a, 31);
        bf16_t* CK = (bf16_t*)(ws + WS_CK); bf16_t* CV = (bf16_t*)(ws + WS_CV);
        for (int i = gtid; i < 2 * 524288; i += nthreads) {
            const int which = i >= 524288; const int j = which ? i - 524288 : i;
            const float* src = inp(a, which ? 3 : 2) + (size_t)j * 8; bf16_t* dst = (which ? CV : CK) + (size_t)j * 8;
            const f32x4 x0 = *(const f32x4*)src, x1 = *(const f32x4*)(src + 4);
            u32x4 w; w.x = pk2(x0[0], x0[1]); w.y = pk2(x0[2], x0[3]); w.z = pk2(x1[0], x1[1]); w.w = pk2(x1[2], x1[3]);
            *(u32x4*)dst = w;
        }
    }
    GSYNC();

    for (int l = 0; l < 2; ++l) {
        PHX(1) {
            TIDS BASES
#if PH_ON(1)
            convert_weights(a, lp, lds, gw, ngw, wave, lane);
#endif
#if PH_ON(2)
            const float* xin0 = lp == 0 ? inp(a, 0) : out;
            const float* xin1 = lp == 0 ? inp(a, 1) - (size_t)NCTX * DM : out;
            adaln_phase(xin0, xin1, inp(a, 8) + lp * DM, modl, 0, (bf16_t*)(ws + WS_U), gw, ngw, lane);
#endif
        }
        GSYNC();
#if PH_ON(3)
        PHX(2) { BASES
          pg8::Gemm g{(const bf16_t*)(ws + WS_U), (const bf16_t*)(ws + W_GU1), 0, 0, MTOK, 2 * DFF, DM}; pg8::Order S; S.init(MTOK, 2 * DFF, Gp, bxp, 1);
          pg8::EpiSwiGLU E{(bf16_t*)(ws + WS_H)}; pg8::gemm_phase<pg8::EpiSwiGLU, true, true>(ldsg, g, S, E); }
#endif
        GSYNC();
#if PH_ON(4)
        PHX(3) { BASES
          const float* xin0 = lp == 0 ? inp(a, 0) : out;
          const float* xin1 = lp == 0 ? inp(a, 1) - (size_t)NCTX * DM : out;
          pg8::Gemm g{(const bf16_t*)(ws + WS_H), (const bf16_t*)(ws + W_D1), 0, 0, MTOK, DM, DFF}; pg8::Order S; S.init(MTOK, DM, Gp, bxp, 1);
          pg8::EpiResid E{xin0, xin1, out, modl + 2 * DM, 0.5f}; pg8::gemm_phase<pg8::EpiResid, true, true>(ldsg, g, S, E); }
#endif
        GSYNC();
#if PH_ON(14)
        PHX(4) { TIDS BASES
          adaln_phase(out, out, inp(a, 12) + lp * DM, modl, 3, (bf16_t*)(ws + WS_U), gw, ngw, lane); }
#endif
        GSYNC();
#if PH_ON(5)
        PHX(5) { BASES
          float* newk = out + (size_t)MTOK * DM; float* newv = newk + (size_t)32 * 2 * 256 * 512;
          pg8::Gemm g{(const bf16_t*)(ws + WS_U), (const bf16_t*)(ws + W_IN), 0, 0, MTOK, 4096, DM}; pg8::Order S; S.init(MTOK, 4096, Gp, bxp, 1);
          pg8::EpiWin E{(bf16_t*)(ws + WS_GLU), (bf16_t*)(ws + WS_CH), (bf16_t*)(ws + WS_BG), (bf16_t*)(ws + WS_Q), (bf16_t*)(ws + WS_K), (bf16_t*)(ws + WS_V),
                        inp(a, 21) + lp * 64, inp(a, 22) + lp * 64, newk, newv, lp};
          pg8::gemm_phase<pg8::EpiWin, true, true>(ldsg, g, S, E); }
#endif
        GSYNC();
        PHX(6) {
            TIDS BASES
            bf16_t* Q = (bf16_t*)(ws + WS_Q); const bf16_t* Kb = (const bf16_t*)(ws + WS_K); const bf16_t* Vb = (const bf16_t*)(ws + WS_V);
#if PH_ON(11)
            {
            const bf16_t* CK = (const bf16_t*)(ws + WS_CK); const bf16_t* CV = (const bf16_t*)(ws + WS_CV);
            const float* rpb_l = inp(a, 23) + (size_t)lp * 8 * 15 * 31;
            {
                const int half = wave >> 2, ht = tid & 255, J = wave & 3;
                unsigned char* hlds = lds + half * att::HALF_BYTES;
                if (ht == 0) *(volatile LAS unsigned*)(LAS unsigned char*)(hlds + att::CNT_OFF) = 0u;
                __syncthreads();
                unsigned btarget = 0u;
                const int hw = bxp * 2 + half, nhw = Gp * 2;
                for (int u = hw; u < 4096; u += nhw) {
                    const int b = u >> 9, head = (u >> 6) & 7, r = u & 63;
                    const size_t co = (size_t)((b * 2 + lp) * 512) * 512;
                    att::unit<true>(hlds, btarget, Q, Kb, Vb, CK + co, CV + co, rpb_l, NCTX + b * 4096 + r * 64, NCTX + b * 4096, head, r, ht, J, lane);
                }
                for (int u = hw; u < 1024; u += nhw) {
                    const int b = u >> 5, head = (u >> 2) & 7, qb = u & 3;
                    att::unit<false>(hlds, btarget, Q, Kb, Vb, nullptr, nullptr, nullptr, b * 256 + qb * 64, b * 256, head, 0, ht, J, lane);
                }
                __syncthreads();
            }
            }
#endif
#if PH_ON(12)
            {
            const float* cw = inp(a, 14) + (size_t)lp * 31 * 512; const float* cb = inp(a, 15) + lp * 512; const float* lg = inp(a, 16) + lp * 512; const float* lb = inp(a, 17) + lp * 512;
            for (int u = bxp; u < 1280; u += Gp) {
                int rowbase, len, t0;
                if (u < 256) { rowbase = (u >> 3) * 256; len = 256; t0 = (u & 7) * 32; }
                else { const int v = u - 256; rowbase = NCTX + (v >> 7) * 4096; len = 4096; t0 = (v & 127) * 32; }
                conva_unit(lds, (const bf16_t*)(ws + WS_GLU), (bf16_t*)(ws + WS_AOUT), cw, cb, lg, lb, rowbase, len, t0, tid, wave, lane);
            }
            }
#endif
#if PH_ON(13)
            convb_phase((bf16_t*)(ws + WS_BG), (const bf16_t*)(ws + WS_CH), inp(a, 19) + (size_t)lp * 3 * 512, gtid, nthreads);
#endif
        }
        GSYNC();
#if PH_ON(6)
        PHX(7) { BASES
          const bf16_t* Wg = (const bf16_t*)(ws + W_IN) + (size_t)4096 * DM;
          pg8::Gemm g{(const bf16_t*)(ws + WS_U), Wg, 0, 0, MTOK, 3072, DM}; pg8::Order S; S.init(MTOK, 3072, Gp, bxp, 1);
          pg8::EpiGates E{(bf16_t*)(ws + WS_GS)}; pg8::gemm_phase<pg8::EpiGates, true, true>(ldsg, g, S, E); }
#endif
        GSYNC();
#if PH_ON(7)
        PHX(8) { BASES
          pg8::Gemm g{(const bf16_t*)(ws + WS_BG), (const bf16_t*)(ws + W_B), BR_STRIDE, WO_STRIDE, MTOK, DM, 512}; pg8::Order S; S.init(MTOK, DM, Gp, bxp, 3);
          pg8::EpiM E{(const bf16_t*)(ws + WS_GS), (bf16_t*)(ws + WS_U)}; pg8::gemm_phase<pg8::EpiM, true, true>(ldsg, g, S, E); }
#endif
        GSYNC();
#if PH_ON(8)
        PHX(9) { BASES
          pg8::Gemm g{(const bf16_t*)(ws + WS_U), (const bf16_t*)(ws + W_M), 0, 0, MTOK, DM, DM}; pg8::Order S; S.init(MTOK, DM, Gp, bxp, 1);
          pg8::EpiResid E{out, out, out, modl + 5 * DM, 1.0f}; pg8::gemm_phase<pg8::EpiResid, true, true>(ldsg, g, S, E); }
#endif
        GSYNC();
#if PH_ON(14)
        PHX(10) { TIDS BASES
          adaln_phase(out, out, inp(a, 26) + lp * DM, modl, 6, (bf16_t*)(ws + WS_U), gw, ngw, lane); }
#endif
        GSYNC();
#if PH_ON(9)
        PHX(11) { BASES
          pg8::Gemm g{(const bf16_t*)(ws + WS_U), (const bf16_t*)(ws + W_GU2), 0, 0, MTOK, 2 * DFF, DM}; pg8::Order S; S.init(MTOK, 2 * DFF, Gp, bxp, 1);
          pg8::EpiSwiGLU E{(bf16_t*)(ws + WS_H)}; pg8::gemm_phase<pg8::EpiSwiGLU, true, true>(ldsg, g, S, E); }
#endif
        GSYNC();
#if PH_ON(10)
        PHX(12) { BASES
          pg8::Gemm g{(const bf16_t*)(ws + WS_H), (const bf16_t*)(ws + W_D2), 0, 0, MTOK, DM, DFF}; pg8::Order S; S.init(MTOK, DM, Gp, bxp, 1);
          pg8::EpiResid E{out, out, out, modl + 8 * DM, 0.5f}; pg8::gemm_phase<pg8::EpiResid, true, true>(ldsg, g, S, E); }
#endif
        if (l == 0) GSYNC();
    }
}

extern "C" void kernel_launch(void* const* d_in, const int* in_sizes, int n_in, void* d_out, int out_size, void* d_ws, size_t ws_size, hipStream_t stream) {
    static int grid = 0;
    if (grid == 0) {
        if (n_in != 30 || ws_size < WS_END) { fprintf(stderr, "kernel_launch: unexpected inputs (n_in %d, ws %zu)\n", n_in, ws_size); grid = -1; return; }
        int dev = 0, cus = 0, per_cu = 0;
        hipGetDevice(&dev);
        hipDeviceGetAttribute(&cus, hipDeviceAttributeMultiprocessorCount, dev);
        hipFuncSetAttribute((const void*)fwd_megakernel, hipFuncAttributeMaxDynamicSharedMemorySize, LDS_BYTES);
        hipOccupancyMaxActiveBlocksPerMultiprocessor(&per_cu, (const void*)fwd_megakernel, NTHR, LDS_BYTES);
        if (per_cu < 1) per_cu = 1;
        (void)hipGetLastError();
        grid = cus;
        if (grid > 256) grid = 256;
    }
    if (grid < 0) return;
    Args a{};
    for (int i = 0; i < 30; ++i) a.in[i] = (const float*)d_in[i];
    a.in[30] = (const float*)d_out; a.in[31] = (const float*)d_ws;
    (void)hipMemsetAsync(d_ws, 0, 16384, stream);
    void* args[] = {&a};
    hipError_t e = hipLaunchCooperativeKernel((const void*)fwd_megakernel, dim3(grid), dim3(NTHR), args, LDS_BYTES, stream);
    if (e != hipSuccess) fprintf(stderr, "cooperative launch failed: %s (grid %d)\n", hipGetErrorString(e), grid);
}
```

```cpp
#include <hip/hip_runtime.h>
#include <hip/hip_cooperative_groups.h>
#include <cstdio>
#include <cstdint>
namespace cg = cooperative_groups;

#define LAS __attribute__((address_space(3)))
typedef unsigned short bf16_t;
typedef short bf16x8 __attribute__((ext_vector_type(8)));
typedef short s16x4 __attribute__((ext_vector_type(4)));
typedef float f32x4 __attribute__((ext_vector_type(4)));
typedef unsigned u32x4 __attribute__((ext_vector_type(4)));
typedef unsigned u32x2 __attribute__((ext_vector_type(2)));

constexpr int DM = 1024, NCTX = 8192, NLAT = 32768, MTOK = NCTX + NLAT;
constexpr int DFF = 2816, NIN = 7168, NMODV = 9, MODW = 9 * 1024;
constexpr int NWAVES = 8, NTHR = 512;
constexpr float EPS = 1e-6f;

constexpr size_t MiB = 1u << 20;
constexpr size_t WS_MODS = 1 * MiB;
constexpr size_t WS_W = 2 * MiB;
constexpr size_t W_GU1 = WS_W, W_D1 = W_GU1 + 11 * MiB, W_IN = W_D1 + 11 * MiB / 2, W_B = W_IN + 14 * MiB, W_C = W_B + MiB, W_A = W_C + MiB,
                 W_M = W_A + MiB, W_GU2 = W_M + 2 * MiB, W_D2 = W_GU2 + 11 * MiB;
constexpr size_t WS_U = 54 * MiB, WS_H = 134 * MiB;
constexpr size_t WS_BG = 134 * MiB, WS_Q = 174 * MiB, WS_AOUT = 214 * MiB, WS_GLU = 254 * MiB, WS_CH = 294 * MiB, WS_K = 334 * MiB, WS_V = 374 * MiB;
constexpr size_t WS_GS = 254 * MiB;
constexpr size_t GS_STRIDE = 80 * MiB / 2, BR_STRIDE = 40 * MiB / 2, WO_STRIDE = MiB / 2;
constexpr size_t WS_CK = 494 * MiB, WS_CV = 502 * MiB, WS_END = 510 * MiB;
static_assert(W_D2 + 11 * MiB / 2 <= WS_U, "weights fit");
constexpr int LDS_BYTES = 147456;

__device__ __forceinline__ unsigned f2bf(float f) { unsigned u = __builtin_bit_cast(unsigned, f); return (u + 0x7fffu + ((u >> 16) & 1u)) >> 16; }
__device__ __forceinline__ unsigned pk2(float lo, float hi) { return f2bf(lo) | (f2bf(hi) << 16); }
typedef float f32x2_t __attribute__((ext_vector_type(2))); typedef __bf16 bf16x2_t __attribute__((ext_vector_type(2)));
__device__ __forceinline__ unsigned cvt_pk_bf16(float lo, float hi) { f32x2_t v = {lo, hi}; bf16x2_t b = __builtin_convertvector(v, bf16x2_t); return __builtin_bit_cast(unsigned, b); }
__device__ __forceinline__ float bflo(unsigned w) { return __uint_as_float(w << 16); }
__device__ __forceinline__ float bfhi(unsigned w) { return __uint_as_float(w & 0xffff0000u); }
__device__ __forceinline__ float sigmoidf_(float x) { return __builtin_amdgcn_rcpf(1.f + __expf(-x)); }
__device__ __forceinline__ float siluf_(float x) { return x * sigmoidf_(x); }
__device__ __forceinline__ float wave_sum(float v) {
#pragma unroll
    for (int o = 1; o < 64; o <<= 1) v += __shfl_xor(v, o);
    return v;
}
__device__ __forceinline__ int opaque_zero() { int z; asm volatile("s_mov_b32 %0, 0" : "=s"(z)); return z; }
__device__ __forceinline__ int opaque_vzero() { int z; asm volatile("v_mov_b32 %0, 0" : "=v"(z)); return z; }
template <class T> __device__ __forceinline__ T* launder_ptr(T* p) { T* r; asm volatile("s_mov_b64 %0, %1" : "=s"(r) : "s"(p)); return r; }
#define LDS_WAIT() asm volatile("s_waitcnt lgkmcnt(0)" ::: "memory")

namespace pg8 {
#define PG8_LAS __attribute__((address_space(3)))
constexpr int BM = 256, BK = 64, HALF = 128, HTB = HALF * BK * 2, STAGE_BYTES = 8 * HTB, NXCD = 8, WGM = 8;
__device__ __forceinline__ int lds_byte(int r, int c) { const int st = (r >> 4) * 2 + (c >> 5), rr = r & 15, cc = c & 31, ob = rr * 64 + cc * 2; return st * 1024 + (ob ^ (((ob >> 9) & 1) << 5)); }
__device__ __forceinline__ void stage_rc(int b, int& R, int& C) { const int st = b / 1024, sb = b % 1024, swz = sb ^ (((sb >> 9) & 1) << 5); R = (st >> 1) * 16 + swz / 64; C = (st & 1) * 32 + (swz % 64) / 2; }
__device__ __forceinline__ int perm32(int rho) { const int n = rho >> 4, i = rho & 15; return 8 * (i >> 2) + 4 * n + (i & 3); }

struct Unit { int pm, pn, seg; };
struct Gemm { const bf16_t* A; const bf16_t* Bt; size_t segA, segB; int M, N, K; };

struct Order {
    int nM, nN, nwg, G, c, nseg, tail, nMf, i0, imax;
    __device__ void init(int M, int N, int G_, int c_, int nseg_) { nM = M / BM; nN = N / BM; nwg = nM * nN; G = G_; c = c_; nseg = nseg_; tail = 0; nMf = nM; i0 = 0; imax = 1 << 30; }
    __device__ void window(int i0_, int imax_, int want_tail) {
        if (want_tail && nseg == 1 && (nwg % G) * 2 == G && ((G / 2) % nN) == 0) { tail = 1; nMf = nM - (G / 2) / nN; }
        i0 = i0_; imax = imax_; }
    __device__ bool next(int i, Unit& u) const {
        i += i0; if (i >= imax) return false;
        const int tile = i / nseg, seg = i - tile * nseg;
        const int nwf = nMf * nN;
        if (tail && tile == nwf / G) { if (c >= G / 2) return false; u.pm = nMf + c / nN; u.pn = c % nN; u.seg = 0; return true; }
        const long L = (long)tile * G + c; if (L >= nwf) return false;
        int wgid = (int)L; { const int q = nwf / NXCD, r = nwf % NXCD, xcd = wgid % NXCD, off = wgid / NXCD; wgid = (xcd < r ? xcd * (q + 1) : r * (q + 1) + (xcd - r) * q) + off; }
        const int nig = WGM * nN, gid = wgid / nig, fm = gid * WGM, gsz = (nMf - fm) < WGM ? (nMf - fm) : WGM;
        u.pm = fm + ((wgid % nig) % gsz); u.pn = (wgid % nig) / gsz; u.seg = seg; return true;
    }
};

template <class Epi, bool ALIGN_EPI, bool SP2>
__device__ __forceinline__ void gemm_phase(PG8_LAS unsigned char* lds, const Gemm g, const Order& S, const Epi& E) {
    const int tid = threadIdx.x + opaque_vzero(), wid = __builtin_amdgcn_readfirstlane(tid >> 6), lane = tid & 63, wr = wid >> 2, wc = wid & 3, fr = lane & 15, fq = lane >> 4;
    const int K = g.K, nt = K / BK;
    unsigned voffA[2], voffB[2];
#pragma unroll
    for (int i = 0; i < 2; ++i) { int R, C; stage_rc(tid * 16 + i * 8192, R, C); const int Rb = Epi::PERM ? ((R & ~31) + perm32(R & 31)) : R;
        voffA[i] = (unsigned)(R * K + C) * 2u; voffB[i] = (unsigned)(Rb * K + C) * 2u; }
    const size_t kstep = (size_t)(BK * 2);
    const size_t hstep = (size_t)HALF * K * 2;
    const size_t tstep = 2 * hstep;
    const unsigned ldsw = (unsigned)wid * 1024u;
    const int aoff = lds_byte(wr * 64 + fr, fq * 8), boff = lds_byte(wc * 32 + fr, fq * 8);
#define PG8_SA(b, h) (((b) * 2 + (h)) * HTB)
#define PG8_SB(b, h) ((4 + (b) * 2 + (h)) * HTB)
#define PG8_STAGE(bufoff, gbase, voff) do { _Pragma("unroll") for (int _i = 0; _i < 2; ++_i) \
        __builtin_amdgcn_global_load_lds((const unsigned*)((const char*)(gbase) + (voff)[_i]), (PG8_LAS unsigned*)(lds + (bufoff) + ldsw + _i * 8192), 16, 0, 0); } while (0)
#define PG8_LDA(dst, b, h) do { _Pragma("unroll") for (int m = 0; m < 4; ++m) _Pragma("unroll") for (int k = 0; k < 2; ++k) dst[m][k] = *(const PG8_LAS bf16x8*)(lds + PG8_SA(b, h) + aoff + m * 2048 + k * 1024); } while (0)
#define PG8_LDB(dst, b, h) do { _Pragma("unroll") for (int n = 0; n < 2; ++n) _Pragma("unroll") for (int k = 0; k < 2; ++k) dst[n][k] = *(const PG8_LAS bf16x8*)(lds + PG8_SB(b, h) + boff + n * 2048 + k * 1024); } while (0)
#define PG8_MMA(ai, bj, At, Bt) do { __builtin_amdgcn_s_setprio(1); _Pragma("unroll") for (int m = 0; m < 4; ++m) _Pragma("unroll") for (int n = 0; n < 2; ++n) _Pragma("unroll") for (int k = 0; k < 2; ++k) \
        acc[ai][bj][m][n] = __builtin_amdgcn_mfma_f32_16x16x32_bf16(Bt[n][k], At[m][k], acc[ai][bj][m][n], 0, 0, 0); __builtin_amdgcn_s_setprio(0); } while (0)
#define PG8_WAIT_V(n) asm volatile("s_waitcnt vmcnt(" #n ")" ::: "memory")
#define PG8_WAIT_L(n) asm volatile("s_waitcnt lgkmcnt(" #n ")" ::: "memory")
#define PG8_BAR __builtin_amdgcn_s_barrier()
#define PG8_SCHED __builtin_amdgcn_sched_barrier(0)
    Unit cur, nxt; int ui = 0;
    if (!S.next(0, cur)) return;
    f32x4 acc[2][2][4][2];
#pragma unroll
    for (int a = 0; a < 2; ++a)
#pragma unroll
        for (int b = 0; b < 2; ++b)
#pragma unroll
            for (int m = 0; m < 4; ++m)
#pragma unroll
                for (int n = 0; n < 2; ++n) acc[a][b][m][n] = (f32x4){0.f, 0.f, 0.f, 0.f};
    bf16x8 At[4][2], B0[2][2], B1[2][2];
    const char* cA = (const char*)(g.A + cur.seg * g.segA) + (size_t)cur.pm * tstep; const char* cB = (const char*)(g.Bt + cur.seg * g.segB) + (size_t)cur.pn * tstep;
    if constexpr (SP2) {
        PG8_STAGE(PG8_SB(0, 0), cB, voffB); PG8_STAGE(PG8_SB(0, 1), cB + hstep, voffB); PG8_STAGE(PG8_SA(0, 0), cA, voffA); PG8_STAGE(PG8_SA(0, 1), cA + hstep, voffA);
        if (wr == 1) PG8_BAR;
        PG8_WAIT_V(2); PG8_BAR;
        PG8_STAGE(PG8_SB(1, 0), cB + kstep, voffB); PG8_STAGE(PG8_SA(1, 0), cA + kstep, voffA); PG8_STAGE(PG8_SB(1, 1), cB + hstep + kstep, voffB);
        PG8_WAIT_V(6); PG8_BAR;
    } else {
        PG8_STAGE(PG8_SB(0, 0), cB, voffB); PG8_STAGE(PG8_SA(0, 0), cA, voffA); PG8_STAGE(PG8_SB(0, 1), cB + hstep, voffB); PG8_STAGE(PG8_SA(0, 1), cA + hstep, voffA);
        if (wr == 1) PG8_BAR;
        PG8_WAIT_V(4); PG8_BAR;
        PG8_STAGE(PG8_SB(1, 0), cB + kstep, voffB); PG8_STAGE(PG8_SA(1, 0), cA + kstep, voffA); PG8_STAGE(PG8_SB(1, 1), cB + hstep + kstep, voffB);
        PG8_WAIT_V(6); PG8_BAR;
    }
    for (;;) {
        const bool has_next = S.next(ui + 1, nxt);
        const char* nA = has_next ? (const char*)(g.A + nxt.seg * g.segA) + (size_t)nxt.pm * tstep : cA; const char* nB = has_next ? (const char*)(g.Bt + nxt.seg * g.segB) + (size_t)nxt.pn * tstep : cB;
        for (int t = 0; t < nt; t += 2) {
            const bool last = (t == nt - 2);
            const char* a1 = cA + (size_t)(t + 1) * kstep;
            const char* a2 = last ? nA : cA + (size_t)(t + 2) * kstep; const char* b2 = last ? nB : cB + (size_t)(t + 2) * kstep;
            const char* a3 = a2 + kstep; const char* b3 = b2 + kstep;
            if constexpr (SP2) {
            PG8_LDB(B0, 0, 0); PG8_LDB(B1, 0, 1); PG8_SCHED; PG8_LDA(At, 0, 0); PG8_STAGE(PG8_SA(1, 1), a1 + hstep, voffA);
            PG8_WAIT_V(8); PG8_WAIT_L(0); PG8_BAR; PG8_MMA(0, 0, At, B0); PG8_MMA(0, 1, At, B1); PG8_BAR; PG8_SCHED;
            PG8_LDA(At, 0, 1); PG8_STAGE(PG8_SB(0, 0), b2, voffB); PG8_STAGE(PG8_SB(0, 1), b2 + hstep, voffB); PG8_STAGE(PG8_SA(0, 0), a2, voffA);
            PG8_WAIT_V(8); PG8_WAIT_L(0); PG8_BAR; PG8_MMA(1, 0, At, B0); PG8_MMA(1, 1, At, B1); PG8_BAR; PG8_SCHED;
            PG8_LDB(B0, 1, 0); PG8_LDB(B1, 1, 1); PG8_SCHED; PG8_LDA(At, 1, 0); PG8_STAGE(PG8_SA(0, 1), a2 + hstep, voffA);
            PG8_WAIT_V(8); PG8_WAIT_L(0); PG8_BAR; PG8_MMA(0, 0, At, B0); PG8_MMA(0, 1, At, B1); PG8_BAR; PG8_SCHED;
            PG8_LDA(At, 1, 1); PG8_STAGE(PG8_SB(1, 0), b3, voffB); PG8_STAGE(PG8_SB(1, 1), b3 + hstep, voffB); PG8_STAGE(PG8_SA(1, 0), a3, voffA);
            PG8_WAIT_V(8); PG8_WAIT_L(0); PG8_BAR; PG8_MMA(1, 0, At, B0); PG8_MMA(1, 1, At, B1); PG8_BAR; PG8_SCHED;
            } else {
            PG8_LDB(B0, 0, 0); PG8_SCHED; PG8_LDA(At, 0, 0); PG8_STAGE(PG8_SA(1, 1), a1 + hstep, voffA);
            PG8_WAIT_L(8); PG8_BAR; PG8_WAIT_L(0); PG8_MMA(0, 0, At, B0); PG8_BAR; PG8_SCHED;
            PG8_LDB(B1, 0, 1); PG8_STAGE(PG8_SB(0, 0), b2, voffB);
            PG8_BAR; PG8_WAIT_L(0); PG8_MMA(0, 1, At, B1); PG8_BAR;
            PG8_LDA(At, 0, 1); PG8_STAGE(PG8_SA(0, 0), a2, voffA);
            PG8_BAR; PG8_WAIT_L(0); PG8_MMA(1, 0, At, B0); PG8_BAR; PG8_SCHED;
            PG8_STAGE(PG8_SB(0, 1), b2 + hstep, voffB);
            PG8_WAIT_V(6); PG8_BAR; PG8_MMA(1, 1, At, B1); PG8_BAR;
            PG8_LDB(B0, 1, 0); PG8_SCHED; PG8_LDA(At, 1, 0); PG8_STAGE(PG8_SA(0, 1), a2 + hstep, voffA);
            PG8_WAIT_L(8); PG8_BAR; PG8_WAIT_L(0); PG8_MMA(0, 0, At, B0); PG8_BAR; PG8_SCHED;
            PG8_LDB(B1, 1, 1); PG8_STAGE(PG8_SB(1, 0), b3, voffB);
            PG8_BAR; PG8_WAIT_L(0); PG8_MMA(0, 1, At, B1); PG8_BAR;
            PG8_LDA(At, 1, 1); PG8_STAGE(PG8_SA(1, 0), a3, voffA);
            PG8_BAR; PG8_WAIT_L(0); PG8_MMA(1, 0, At, B0); PG8_BAR; PG8_SCHED;
            PG8_STAGE(PG8_SB(1, 1), b3 + hstep, voffB);
            PG8_WAIT_V(6); PG8_BAR; PG8_MMA(1, 1, At, B1); PG8_BAR;
            }
        }
        if constexpr (ALIGN_EPI) { if (wr == 0) PG8_BAR; }
        E(acc, cur, wr, wc, fr, fq);
        if (!has_next) break;
#pragma unroll
        for (int a = 0; a < 2; ++a)
#pragma unroll
            for (int b = 0; b < 2; ++b)
#pragma unroll
                for (int m = 0; m < 4; ++m)
#pragma unroll
                    for (int n = 0; n < 2; ++n) acc[a][b][m][n] = (f32x4){0.f, 0.f, 0.f, 0.f};
        cur = nxt; cA = nA; cB = nB; ++ui;
        if constexpr (ALIGN_EPI) { if (wr == 1) PG8_BAR; }
    }
    PG8_WAIT_V(0);
    if constexpr (!ALIGN_EPI) { if (wr == 0) PG8_BAR; }
    PG8_BAR;
#undef PG8_SA
#undef PG8_SB
#undef PG8_STAGE
#undef PG8_LDA
#undef PG8_LDB
#undef PG8_MMA
#undef PG8_WAIT_V
#undef PG8_WAIT_L
#undef PG8_BAR
#undef PG8_SCHED
}

typedef f32x4 Acc[2][2][4][2];

__device__ __forceinline__ u32x4 pack8(const f32x4 a, const f32x4 b) {
    u32x4 w; w.x = cvt_pk_bf16(a[0], a[1]); w.y = cvt_pk_bf16(a[2], a[3]); w.z = cvt_pk_bf16(b[0], b[1]); w.w = cvt_pk_bf16(b[2], b[3]); return w;
}

struct EpiSwiGLU {
    static constexpr bool PERM = true;
    bf16_t* H;
    __device__ __forceinline__ void operator()(const Acc& acc, const Unit& u, int wr, int wc, int fr, int fq) const {
        const int row0 = u.pm * BM + wr * 64 + fr, col0 = u.pn * HALF + wc * 32 + 8 * fq;
#pragma unroll
        for (int ai = 0; ai < 2; ++ai)
#pragma unroll
            for (int m = 0; m < 4; ++m) {
                bf16_t* rowp = H + (size_t)(row0 + ai * HALF + m * 16) * DFF + col0;
                f32x4 h0, h1;
#pragma unroll
                for (int j = 0; j < 4; ++j) { h0[j] = siluf_(acc[ai][0][m][0][j]) * acc[ai][1][m][0][j]; h1[j] = siluf_(acc[ai][0][m][1][j]) * acc[ai][1][m][1][j]; }
                *(u32x4*)rowp = pack8(h0, h1);
                __builtin_amdgcn_sched_barrier(0);
            }
    }
};

struct EpiResid {
    static constexpr bool PERM = false;
    const float* in0; const float* in1; float* out; const float* gate; float coef;
    __device__ __forceinline__ void operator()(const Acc& acc, const Unit& u, int wr, int wc, int fr, int fq) const {
        const int v = u.pm < 32 ? 0 : 1 + ((u.pm - 32) >> 4);
        const float* gv = gate + (size_t)v * MODW;
        const float* in = u.pm < 32 ? in0 : in1;
        const int col0 = u.pn * BM + wc * 32 + 4 * fq;
        f32x4 g[2][2];
#pragma unroll
        for (int bj = 0; bj < 2; ++bj)
#pragma unroll
            for (int n = 0; n < 2; ++n) g[bj][n] = *(const f32x4*)(gv + col0 + bj * HALF + n * 16) * coef;
#pragma unroll
        for (int ai = 0; ai < 2; ++ai) {
            f32x4 x[4][2][2];
#pragma unroll
            for (int m = 0; m < 4; ++m) {
                const size_t off = (size_t)(u.pm * BM + ai * HALF + wr * 64 + m * 16 + fr) * DM + col0;
#pragma unroll
                for (int bj = 0; bj < 2; ++bj)
#pragma unroll
                    for (int n = 0; n < 2; ++n) x[m][bj][n] = *(const f32x4*)(in + off + bj * HALF + n * 16);
            }
            __builtin_amdgcn_sched_barrier(0);
#pragma unroll
            for (int m = 0; m < 4; ++m) {
                const size_t off = (size_t)(u.pm * BM + ai * HALF + wr * 64 + m * 16 + fr) * DM + col0;
#pragma unroll
                for (int bj = 0; bj < 2; ++bj)
#pragma unroll
                    for (int n = 0; n < 2; ++n) *(f32x4*)(out + off + bj * HALF + n * 16) = x[m][bj][n] + g[bj][n] * acc[ai][bj][m][n];
            }
            __builtin_amdgcn_sched_barrier(0);
        }
    }
};

struct EpiWin {
    static constexpr bool PERM = true;
    bf16_t *GLU, *CH, *BG, *Q, *Kb, *Vb; const float *qg, *kg; float *newk, *newv; int layer;
    __device__ __forceinline__ void operator()(const Acc& acc, const Unit& u, int wr, int wc, int fr, int fq) const {
        const int row0 = u.pm * BM + wr * 64 + fr, cw = wc * 32 + 8 * fq, pn = u.pn;
        if (pn < 8) {
            bf16_t* O = (pn < 4 ? GLU : CH); const int col0 = (pn & 3) * HALF + cw;
#pragma unroll
            for (int ai = 0; ai < 2; ++ai)
#pragma unroll
                for (int m = 0; m < 4; ++m) {
                    f32x4 h0, h1;
                    if (pn < 4) {
#pragma unroll
                        for (int j = 0; j < 4; ++j) { h0[j] = acc[ai][0][m][0][j] * sigmoidf_(acc[ai][1][m][0][j]); h1[j] = acc[ai][0][m][1][j] * sigmoidf_(acc[ai][1][m][1][j]); }
                    } else { h0 = acc[ai][0][m][0] * acc[ai][1][m][0]; h1 = acc[ai][0][m][1] * acc[ai][1][m][1]; }
                    *(u32x4*)(O + (size_t)(row0 + ai * HALF + m * 16) * 512 + col0) = pack8(h0, h1);
                    __builtin_amdgcn_sched_barrier(0);
                }
        } else if (pn < 10 || pn >= 14) {
            bf16_t* O = (pn < 10 ? BG : Vb); const int colt = (pn < 10 ? pn - 8 : pn - 14) * BM + cw;
            const bool wnew = (pn >= 14) && (u.pm < 32);
#pragma unroll
            for (int ai = 0; ai < 2; ++ai)
#pragma unroll
                for (int m = 0; m < 4; ++m) {
                    const int row = row0 + ai * HALF + m * 16;
#pragma unroll
                    for (int bj = 0; bj < 2; ++bj) {
                        *(u32x4*)(O + (size_t)row * 512 + colt + bj * HALF) = pack8(acc[ai][bj][m][0], acc[ai][bj][m][1]);
                        if (wnew) { float* p = newv + ((size_t)(u.pm * 2 + layer) * 256 + (row - u.pm * BM)) * 512 + colt + bj * HALF;
                            *(f32x4*)p = acc[ai][bj][m][0]; *(f32x4*)(p + 4) = acc[ai][bj][m][1]; }
                    }
                    __builtin_amdgcn_sched_barrier(0);
                }
        } else {
            const bool isk = pn >= 12; bf16_t* O = isk ? Kb : Q; const float* gn = isk ? kg : qg;
            const int head = 4 * ((pn - 10) & 1) + wc; const bool wnew = isk && (u.pm < 32);
            f32x4 gv[2][2];
#pragma unroll
            for (int bj = 0; bj < 2; ++bj)
#pragma unroll
                for (int n = 0; n < 2; ++n) gv[bj][n] = *(const f32x4*)(gn + 32 * bj + 8 * fq + 4 * n);
#pragma unroll
            for (int ai = 0; ai < 2; ++ai)
#pragma unroll
                for (int m = 0; m < 4; ++m) {
                    const int row = row0 + ai * HALF + m * 16;
                    float ss = 0.f;
#pragma unroll
                    for (int bj = 0; bj < 2; ++bj)
#pragma unroll
                        for (int n = 0; n < 2; ++n) { const f32x4 x = acc[ai][bj][m][n]; ss += (x[0] * x[0] + x[1] * x[1]) + (x[2] * x[2] + x[3] * x[3]); }
                    ss += __shfl_xor(ss, 16); ss += __shfl_xor(ss, 32);
                    const float rinv = __builtin_amdgcn_rsqf(ss * (1.f / 64.f) + EPS);
#pragma unroll
                    for (int bj = 0; bj < 2; ++bj) {
                        const f32x4 y0 = acc[ai][bj][m][0] * rinv * gv[bj][0], y1 = acc[ai][bj][m][1] * rinv * gv[bj][1];
                        const int col = head * 64 + 32 * bj + 8 * fq;
                        *(u32x4*)(O + (size_t)row * 512 + col) = pack8(y0, y1);
                        if (wnew) { float* p = newk + ((size_t)(u.pm * 2 + layer) * 256 + (row - u.pm * BM)) * 512 + col; *(f32x4*)p = y0; *(f32x4*)(p + 4) = y1; }
                    }
                    __builtin_amdgcn_sched_barrier(0);
                }
        }
    }
};

struct EpiGates {
    static constexpr bool PERM = true;
    bf16_t* GS;
    __device__ __forceinline__ void operator()(const Acc& acc, const Unit& u, int wr, int wc, int fr, int fq) const {
        const int gi = u.pn >> 2; const int bi = gi == 0 ? 2 : gi - 1; bf16_t* O = GS + (size_t)bi * GS_STRIDE;
        const int row0 = u.pm * BM + wr * 64 + fr, col0 = (u.pn & 3) * BM + wc * 32 + 8 * fq;
#pragma unroll
        for (int ai = 0; ai < 2; ++ai)
#pragma unroll
            for (int m = 0; m < 4; ++m)
#pragma unroll
                for (int bj = 0; bj < 2; ++bj) {
                    f32x4 h0, h1;
#pragma unroll
                    for (int j = 0; j < 4; ++j) { h0[j] = sigmoidf_(acc[ai][bj][m][0][j]); h1[j] = sigmoidf_(acc[ai][bj][m][1][j]); }
                    *(u32x4*)(O + (size_t)(row0 + ai * HALF + m * 16) * DM + col0 + bj * HALF) = pack8(h0, h1);
                    __builtin_amdgcn_sched_barrier(0);
                }
    }
};

struct EpiM {
    static constexpr bool PERM = true;
    const bf16_t* GS; bf16_t* Mo;
    __device__ __forceinline__ void operator()(const Acc& acc, const Unit& u, int wr, int wc, int fr, int fq) const {
        const bf16_t* Gs = GS + (size_t)u.seg * GS_STRIDE;
        const int row0 = u.pm * BM + wr * 64 + fr, col0 = u.pn * BM + wc * 32 + 8 * fq;
#pragma unroll
        for (int ai = 0; ai < 2; ++ai) {
            u32x4 gw[4][2], mw[4][2];
#pragma unroll
            for (int m = 0; m < 4; ++m)
#pragma unroll
                for (int bj = 0; bj < 2; ++bj) {
                    const size_t off = (size_t)(row0 + ai * HALF + m * 16) * DM + col0 + bj * HALF;
                    gw[m][bj] = *(const u32x4*)(Gs + off);
                    mw[m][bj] = (u32x4){0u, 0u, 0u, 0u};
                    if (u.seg != 0) mw[m][bj] = *(const u32x4*)(Mo + off);
                }
            __builtin_amdgcn_sched_barrier(0);
#pragma unroll
            for (int m = 0; m < 4; ++m)
#pragma unroll
                for (int bj = 0; bj < 2; ++bj) {
                    const size_t off = (size_t)(row0 + ai * HALF + m * 16) * DM + col0 + bj * HALF;
                    const u32x4 g4 = gw[m][bj], m4 = mw[m][bj];
                    f32x4 h0, h1;
                    h0[0] = bflo(g4.x) * acc[ai][bj][m][0][0] + bflo(m4.x); h0[1] = bfhi(g4.x) * acc[ai][bj][m][0][1] + bfhi(m4.x);
                    h0[2] = bflo(g4.y) * acc[ai][bj][m][0][2] + bflo(m4.y); h0[3] = bfhi(g4.y) * acc[ai][bj][m][0][3] + bfhi(m4.y);
                    h1[0] = bflo(g4.z) * acc[ai][bj][m][1][0] + bflo(m4.z); h1[1] = bfhi(g4.z) * acc[ai][bj][m][1][1] + bfhi(m4.z);
                    h1[2] = bflo(g4.w) * acc[ai][bj][m][1][2] + bflo(m4.w); h1[3] = bfhi(g4.w) * acc[ai][bj][m][1][3] + bfhi(m4.w);
                    *(u32x4*)(Mo + off) = pack8(h0, h1);
                }
            __builtin_amdgcn_sched_barrier(0);
        }
    }
};
}

struct Args { const float* in[32]; };
__device__ __forceinline__ const float* inp(const Args& a, int i) { return a.in[i + opaque_zero()]; }

__device__ __forceinline__ void cvt_block(const float* W, int N, int K, int k0, int n0, bf16_t* WT, int dst_row0, float* scr, int lane) {
    const int kq = lane >> 3, n4 = (lane & 7) * 4;
    f32x4 v[8];
#pragma unroll
    for (int i = 0; i < 8; ++i) v[i] = *(const f32x4*)(W + (size_t)(k0 + kq + 8 * i) * N + n0 + n4);
#pragma unroll
    for (int i = 0; i < 8; ++i) { float* d = scr + (kq + 8 * i) * 33 + n4; d[0] = v[i][0]; d[1] = v[i][1]; d[2] = v[i][2]; d[3] = v[i][3]; }
    LDS_WAIT();
    const int c = lane & 7;
#pragma unroll
    for (int j = 0; j < 4; ++j) { const int n = (lane >> 3) + 8 * j; const float* s = scr + (8 * c) * 33 + n;
        u32x4 o; o.x = pk2(s[0 * 33], s[1 * 33]); o.y = pk2(s[2 * 33], s[3 * 33]); o.z = pk2(s[4 * 33], s[5 * 33]); o.w = pk2(s[6 * 33], s[7 * 33]);
        *(u32x4*)(WT + (size_t)(dst_row0 + n) * K + k0 + 8 * c) = o; }
    LDS_WAIT();
}
__device__ __forceinline__ int win_dst(int n) {
    if (n < 512) return 256 * (n >> 7) + (n & 127);
    if (n < 1024) { const int s = n - 512; return 256 * (s >> 7) + 128 + (s & 127); }
    if (n < 1536) return 2048 + (n - 1024);
    if (n < 2048) { const int s = n - 1536; return 1024 + 256 * (s >> 7) + (s & 127); }
    if (n < 2560) { const int s = n - 2048; return 1024 + 256 * (s >> 7) + 128 + (s & 127); }
    if (n < 3584) { const int base = n < 3072 ? 2560 : 3072; const int s = n - base, head = s >> 6, dim = s & 63;
        return base + 256 * (head >> 2) + 128 * (dim >> 5) + 32 * (head & 3) + (dim & 31); }
    return n;
}
__device__ __forceinline__ void convert_weights(const Args& a, int l, unsigned char* lds, int gw, int ngw, int wave, int lane) {
    float* scr = (float*)(lds + wave * 8448);
    unsigned char* ws = (unsigned char*)inp(a, 31);
    constexpr int I_GU = 16 * 88, I_D = 44 * 32, I_IN = 16 * 224, I_O = 8 * 32, I_M = 16 * 32;
    constexpr int NIT = 6 * I_GU + I_IN + 3 * I_O + I_M;
    static_assert(I_GU == I_D, "");
    for (int it = gw; it < NIT; it += ngw) {
        int r = it;
        if (r < 6 * I_GU) {
            const int which = r / I_GU; r -= which * I_GU;
            const int ff = which / 3, kind = which % 3;
            if (kind < 2) {
                const float* W = inp(a, (ff ? 27 : 9) + kind) + (size_t)l * DM * DFF;
                const int kb = r / 88, nb = r % 88, n0 = nb * 32;
                cvt_block(W, DFF, DM, kb * 64, n0, (bf16_t*)(ws + (ff ? W_GU2 : W_GU1)), 256 * (n0 >> 7) + 128 * kind + (n0 & 127), scr, lane);
            } else {
                const float* W = inp(a, ff ? 29 : 11) + (size_t)l * DFF * DM;
                const int kb = r / 32, nb = r % 32;
                cvt_block(W, DM, DFF, kb * 64, nb * 32, (bf16_t*)(ws + (ff ? W_D2 : W_D1)), nb * 32, scr, lane);
            }
            continue;
        }
        r -= 6 * I_GU;
        if (r < I_IN) { const int kb = r / 224, nb = r % 224; cvt_block(inp(a, 13) + (size_t)l * DM * NIN, NIN, DM, kb * 64, nb * 32, (bf16_t*)(ws + W_IN), win_dst(nb * 32), scr, lane); continue; }
        r -= I_IN;
        if (r < 3 * I_O) { const int which = r / I_O; r -= which * I_O; const int kb = r / 32, nb = r % 32;
            const float* W = inp(a, which == 0 ? 18 : (which == 1 ? 20 : 24)) + (size_t)l * 512 * DM;
            cvt_block(W, DM, 512, kb * 64, nb * 32, (bf16_t*)(ws + (which == 0 ? W_A : (which == 1 ? W_B : W_C))), nb * 32, scr, lane); continue; }
        r -= 3 * I_O;
        { const int kb = r / 32, nb = r % 32; cvt_block(inp(a, 25) + (size_t)l * DM * DM, DM, DM, kb * 64, nb * 32, (bf16_t*)(ws + W_M), nb * 32, scr, lane); }
    }
}

__device__ __forceinline__ void compute_mods(const Args& a, unsigned char* lds, int tid, int wave, int lane) {
    float* sT = (float*)lds;
    float* red = (float*)(lds + 49152);
    const float* c = inp(a, 4); const float* cctx = inp(a, 5);
    for (int k = tid; k < DM; k += NTHR) {
        sT[k * 12 + 0] = siluf_(cctx[k]);
#pragma unroll
        for (int v = 1; v < 9; ++v) sT[k * 12 + v] = siluf_(c[(v - 1) * DM + k]);
        sT[k * 12 + 9] = 0.f; sT[k * 12 + 10] = 0.f; sT[k * 12 + 11] = 0.f;
    }
    __syncthreads();
    float* mods = (float*)((unsigned char*)inp(a, 31) + WS_MODS);
    for (int unit = blockIdx.x; unit < 288; unit += gridDim.x) {
        const int l = unit / 144, cb = unit % 144, col = cb * 64 + lane;
        const float* W = inp(a, 6) + (size_t)l * DM * MODW + col;
        float acc[9];
#pragma unroll
        for (int v = 0; v < 9; ++v) acc[v] = 0.f;
#pragma unroll 32
        for (int kk = 0; kk < 128; ++kk) {
            const int k = wave * 128 + kk;
            const float w = W[(size_t)k * MODW];
            const f32x4 s0 = *(const f32x4*)(sT + k * 12), s1 = *(const f32x4*)(sT + k * 12 + 4), s2 = *(const f32x4*)(sT + k * 12 + 8);
            acc[0] += s0[0] * w; acc[1] += s0[1] * w; acc[2] += s0[2] * w; acc[3] += s0[3] * w;
            acc[4] += s1[0] * w; acc[5] += s1[1] * w; acc[6] += s1[2] * w; acc[7] += s1[3] * w; acc[8] += s2[0] * w;
        }
#pragma unroll
        for (int v = 0; v < 9; ++v) red[(wave * 9 + v) * 64 + lane] = acc[v];
        __syncthreads();
        for (int idx = tid; idx < 576; idx += NTHR) {
            const int v = idx >> 6, ln = idx & 63; float s = inp(a, 7)[(size_t)l * MODW + cb * 64 + ln];
#pragma unroll
            for (int w = 0; w < 8; ++w) s += red[(w * 9 + v) * 64 + ln];
            mods[((size_t)l * 9 + v) * MODW + cb * 64 + ln] = s;
        }
        __syncthreads();
    }
}

__device__ __forceinline__ void adaln_phase(const float* in0, const float* in1, const float* g, const float* modl, int ish, bf16_t* U, int rb, int re, int gw, int ngw, int lane) {
    static_assert(MTOK % (2 * 256 * NWAVES) == 0, "row pairs");
    for (int row0 = rb + gw; row0 < re; row0 += 2 * ngw) {
        f32x4 x[2][4];
#pragma unroll
        for (int h = 0; h < 2; ++h) { const int row = min(row0 + h * ngw, re - 1); const float* xr = (row < NCTX ? in0 : in1) + (size_t)row * DM;
#pragma unroll
            for (int j = 0; j < 4; ++j) x[h][j] = *(const f32x4*)(xr + 256 * j + 4 * lane); }
#pragma unroll
        for (int h = 0; h < 2; ++h) {
            const int row = row0 + h * ngw; if (row >= re) break;
            const int v = row < NCTX ? 0 : 1 + ((row - NCTX) >> 12);
            const float* sh = modl + (size_t)v * MODW + ish * DM; const float* sc = sh + DM;
            float ss = 0.f;
#pragma unroll
            for (int j = 0; j < 4; ++j) ss += (x[h][j][0] * x[h][j][0] + x[h][j][1] * x[h][j][1]) + (x[h][j][2] * x[h][j][2] + x[h][j][3] * x[h][j][3]);
            const float rinv = __builtin_amdgcn_rsqf(wave_sum(ss) * (1.f / DM) + EPS);
#pragma unroll
            for (int j = 0; j < 4; ++j) {
                const int c = 256 * j + 4 * lane;
                const f32x4 gg = *(const f32x4*)(g + c), s1 = *(const f32x4*)(sc + c), s0 = *(const f32x4*)(sh + c);
                const f32x4 y = x[h][j] * rinv * gg * (s1 + 1.f) + s0;
                u32x2 w; w.x = pk2(y[0], y[1]); w.y = pk2(y[2], y[3]);
                *(u32x2*)(U + (size_t)row * DM + c) = w;
            }
        }
    }
}

namespace att {
constexpr int TK = 128, PITCH = 144, KS_OFF = 0, VS_OFF = TK * PITCH, RPB_OFF = 2 * TK * PITCH, CNT_OFF = RPB_OFF + 15 * 32 * 4, HALF_BYTES = 39936;
static_assert(CNT_OFF + 64 <= HALF_BYTES, "attention LDS map");
typedef short v4i16_t __attribute__((ext_vector_type(4)));
__device__ __forceinline__ s16x4 vtr(const LAS char* p) { return __builtin_bit_cast(s16x4, __builtin_amdgcn_ds_read_tr16_b64_v4i16((LAS v4i16_t*)p)); }

struct TileSrc { const bf16_t* k; const bf16_t* v; };

template <bool LOCAL>
__device__ __forceinline__ void tile_compute(const LAS char* ldsb, const bf16x8 (&qf)[2], f32x4 (&O)[4], float& mrun, float& lrun,
                                             int hl, int kbase, int koff, int fr, int fq, int lane, const float* rpbrow, const int (&dci)[8], unsigned vmask) {
    constexpr int NMT = LOCAL ? 2 : 4;
#define ATT_KEYOFF(mt) (kbase + (LOCAL ? koff : 0) + 16 * (mt))
    f32x4 s[NMT];
#pragma unroll
    for (int mt = 0; mt < NMT; ++mt) {
        s[mt] = (f32x4){0.f, 0.f, 0.f, 0.f};
#pragma unroll
        for (int ks = 0; ks < 2; ++ks) {
            const bf16x8 kf = *(const LAS bf16x8*)(ldsb + KS_OFF + (ATT_KEYOFF(mt) + fr) * PITCH + hl * 128 + ks * 64 + fq * 16);
            s[mt] = __builtin_amdgcn_mfma_f32_16x16x32_bf16(kf, qf[ks], s[mt], 0, 0, 0);
        }
    }
    constexpr float C1 = 0.125f * 1.4426950408889634f;
    float tmax = -1e30f;
    if (LOCAL) {
#pragma unroll
        for (int mt = 0; mt < NMT; ++mt)
#pragma unroll
            for (int j = 0; j < 4; ++j) {
                float v = __builtin_fmaf(s[mt][j], C1, rpbrow[dci[mt * 4 + j]]);
                if (!((vmask >> (mt * 4 + j)) & 1u)) v = -1e30f;
                s[mt][j] = v; tmax = fmaxf(tmax, v);
            }
    } else {
#pragma unroll
        for (int mt = 0; mt < NMT; ++mt)
#pragma unroll
            for (int j = 0; j < 4; ++j) tmax = fmaxf(tmax, s[mt][j]);
        tmax *= C1;
    }
    tmax = fmaxf(tmax, __shfl_xor(tmax, 16)); tmax = fmaxf(tmax, __shfl_xor(tmax, 32));
    const float mnew = fmaxf(mrun, tmax), alpha = __builtin_amdgcn_exp2f(mrun - mnew);
    float psum = 0.f;
#pragma unroll
    for (int mt = 0; mt < NMT; ++mt)
#pragma unroll
        for (int j = 0; j < 4; ++j) { const float p = __builtin_amdgcn_exp2f(LOCAL ? s[mt][j] - mnew : __builtin_fmaf(s[mt][j], C1, -mnew)); s[mt][j] = p; psum += p; }
    lrun = lrun * alpha + psum; mrun = mnew;
#pragma unroll
    for (int dt = 0; dt < 4; ++dt) O[dt] = O[dt] * alpha;
    const int g = lane >> 4, q = (lane & 15) >> 2, p4 = lane & 3;
#pragma unroll
    for (int kk = 0; kk < NMT / 2; ++kk) {
        bf16x8 pb;
        { const u32x4 w = pg8::pack8(s[2 * kk], s[2 * kk + 1]); pb = __builtin_bit_cast(bf16x8, w); }
#pragma unroll
        for (int dt = 0; dt < 4; ++dt) {
            const LAS char* vb = ldsb + VS_OFF + hl * 128 + 32 * dt + 8 * p4;
            const s16x4 v0 = vtr(vb + (ATT_KEYOFF(2 * kk) + 4 * g + q) * PITCH);
            const s16x4 v1 = vtr(vb + (ATT_KEYOFF(2 * kk + 1) + 4 * g + q) * PITCH);
            bf16x8 vf; vf[0] = v0[0]; vf[1] = v0[1]; vf[2] = v0[2]; vf[3] = v0[3]; vf[4] = v1[0]; vf[5] = v1[1]; vf[6] = v1[2]; vf[7] = v1[3];
            O[dt] = __builtin_amdgcn_mfma_f32_16x16x32_bf16(vf, pb, O[dt], 0, 0, 0);
        }
    }
#undef ATT_KEYOFF
}

__device__ __forceinline__ void hbar(unsigned char* hl_lds, unsigned& target, int lane) {
    asm volatile("s_waitcnt lgkmcnt(0)" ::: "memory");
    target += 4u;
    volatile LAS unsigned* cnt = (volatile LAS unsigned*)(LAS unsigned char*)(hl_lds + CNT_OFF);
    if (lane == 0) (void)__hip_atomic_fetch_add((LAS unsigned*)(LAS unsigned char*)(hl_lds + CNT_OFF), 1u, __ATOMIC_RELAXED, __HIP_MEMORY_SCOPE_WORKGROUP);
    while ((int)(*cnt - target) < 0) __builtin_amdgcn_s_sleep(0);
    asm volatile("" ::: "memory");
}

template <bool LATENT>
__device__ __forceinline__ void unit(unsigned char* hlds, unsigned& btarget, bf16_t* QO, const bf16_t* Kb, const bf16_t* Vb, const bf16_t* CK, const bf16_t* CV, const float* rpb_l,
                                     int qrow0  , int keyrow0  , int head, int r  ,
                                     int ht, int J, int lane) {
    unsigned char* lds = hlds;
    const LAS char* ldsb = (const LAS char*)(LAS unsigned char*)hlds;
    const int fr = lane & 15, fq = lane >> 4;
    const int rs = LATENT ? min(max(r - 4, 0), 56) : 0;
    constexpr int NT = LATENT ? 8 : 2;
    int dci[8]; unsigned vmask = 0u; int koff = 0;
    if (LATENT) {
        const int qc = 16 * J + fr, wstart = min(max(qc - 8, 0), 48);
        koff = min(max(16 * J - 8, 0), 32);
#pragma unroll
        for (int mt = 0; mt < 2; ++mt)
#pragma unroll
            for (int j = 0; j < 4; ++j) { const int kc = koff + 16 * mt + 4 * fq + j;
                dci[mt * 4 + j] = min(max(kc - qc, -15), 15) + 15;
                if (kc >= wstart && kc < wstart + 16) vmask |= 1u << (mt * 4 + j); }
        float* tb = (float*)(lds + RPB_OFF);
        for (int i = ht; i < 15 * 32; i += 256) { const int dr = i >> 5, dc = i & 31; tb[i] = dc < 31 ? rpb_l[(head * 15 + dr) * 31 + dc] * 1.4426950408889634f : 0.f; }
    } else {
#pragma unroll
        for (int i = 0; i < 8; ++i) dci[i] = 0;
    }
    bf16x8 qf[2];
    { const bf16_t* qp = QO + (size_t)(qrow0 + 16 * J + fr) * 512 + head * 64 + 8 * fq;
      qf[0] = *(const bf16x8*)qp; qf[1] = *(const bf16x8*)(qp + 32); }
    f32x4 O[4], OB[4];
#pragma unroll
    for (int dt = 0; dt < 4; ++dt) { O[dt] = (f32x4){0.f, 0.f, 0.f, 0.f}; OB[dt] = (f32x4){0.f, 0.f, 0.f, 0.f}; }
    float mrun = -1e30f, lrun = 0.f, mrunB = -1e30f, lrunB = 0.f;
    const int key0 = ht >> 3, part = ht & 7;
    u32x4 kA[4], vA[4], kB[4], vB[4];
    auto tsrc = [&](int t) -> TileSrc {
        TileSrc s;
        if (LATENT) {
            if (t < 4) { s.k = CK + (size_t)(t * TK) * 512 + head * 64; s.v = CV + (size_t)(t * TK) * 512 + head * 64; }
            else { const size_t ro = (size_t)(keyrow0 + (rs + 2 * (t - 4)) * 64) * 512 + head * 64; s.k = Kb + ro; s.v = Vb + ro; }
        } else { const size_t ro = (size_t)(keyrow0 + t * TK) * 512 + head * 64; s.k = Kb + ro; s.v = Vb + ro; }
        return s;
    };
#define ATT_GLOAD(KR, VR, t) do { const TileSrc s_ = tsrc(t); _Pragma("unroll") for (int i = 0; i < 4; ++i) { const size_t o = (size_t)(key0 + 32 * i) * 512 + part * 8; \
        KR[i] = *(const u32x4*)(s_.k + o); VR[i] = *(const u32x4*)(s_.v + o); } } while (0)
#define ATT_BAR() hbar(hlds, btarget, lane)
#define ATT_LSTORE(KR, VR) do { _Pragma("unroll") for (int i = 0; i < 4; ++i) { const int lo = (key0 + 32 * i) * PITCH + part * 16; \
        *(u32x4*)(lds + KS_OFF + lo) = KR[i]; *(u32x4*)(lds + VS_OFF + lo) = VR[i]; } } while (0)
#define ATT_COMPUTE(t) do { if (LATENT && (t) >= 4) { const int dr = (rs + 2 * ((t) - 4)) - r + 7; \
            const float* rpbrow = (const float*)(lds + RPB_OFF) + dr * 32; \
            tile_compute<true>(ldsb, qf, O, mrun, lrun, 0, 0, koff, fr, fq, lane, rpbrow, dci, vmask); \
            tile_compute<true>(ldsb, qf, OB, mrunB, lrunB, 0, 64, koff, fr, fq, lane, rpbrow + 32, dci, vmask); \
        } else { tile_compute<false>(ldsb, qf, O, mrun, lrun, 0, 0, 0, fr, fq, lane, nullptr, dci, 0u); \
                 tile_compute<false>(ldsb, qf, OB, mrunB, lrunB, 0, 64, 0, fr, fq, lane, nullptr, dci, 0u); } } while (0)
    ATT_GLOAD(kA, vA, 0); ATT_GLOAD(kB, vB, 1);
    for (int t = 0; t < NT; t += 2) {
        ATT_BAR();
        ATT_LSTORE(kA, vA);
        ATT_BAR();
        if (t + 2 < NT) ATT_GLOAD(kA, vA, t + 2);
        ATT_COMPUTE(t);
        ATT_BAR();
        ATT_LSTORE(kB, vB);
        ATT_BAR();
        if (t + 3 < NT) ATT_GLOAD(kB, vB, t + 3);
        ATT_COMPUTE(t + 1);
    }
#undef ATT_GLOAD
#undef ATT_BAR
#undef ATT_LSTORE
#undef ATT_COMPUTE
    { const float mm = fmaxf(mrun, mrunB), aA = __builtin_amdgcn_exp2f(mrun - mm), aB = __builtin_amdgcn_exp2f(mrunB - mm);
      lrun = lrun * aA + lrunB * aB;
#pragma unroll
      for (int dt = 0; dt < 4; ++dt) O[dt] = O[dt] * aA + OB[dt] * aB; }
    lrun += __shfl_xor(lrun, 16); lrun += __shfl_xor(lrun, 32);
    const float linv = 1.f / lrun;
    bf16_t* op = QO + (size_t)(qrow0 + 16 * J + fr) * 512 + head * 64 + 4 * fq;
#pragma unroll
    for (int dt = 0; dt < 4; ++dt) { u32x2 w; w.x = cvt_pk_bf16(O[dt][0] * linv, O[dt][1] * linv); w.y = cvt_pk_bf16(O[dt][2] * linv, O[dt][3] * linv); *(u32x2*)(op + 16 * dt) = w; }
    hbar(hlds, btarget, lane);
}
}

__device__ __forceinline__ void conva_unit(unsigned char* lds, const bf16_t* GLU, bf16_t* AOUT, const float* cw, const float* cb, const float* lg, const float* lb,
                                           int rowbase, int len, int t0, int tid, int wave, int lane) {
    bf16_t* in_s = (bf16_t*)lds;
    float* hs = (float*)(lds + 62 * 512 * 2);
    for (int idx = tid; idx < 62 * 64; idx += NTHR) {
        const int i = idx >> 6, ch = idx & 63, p = t0 - 15 + i;
        u32x4 v = (u32x4){0u, 0u, 0u, 0u};
        if (p >= 0 && p < len) v = *(const u32x4*)(GLU + (size_t)(rowbase + p) * 512 + ch * 8);
        *(u32x4*)(in_s + i * 512 + ch * 8) = v;
    }
    float w[31];
#pragma unroll
    for (int j = 0; j < 31; ++j) w[j] = cw[j * 512 + tid];
    const float bias = cb[tid];
    __syncthreads();
    float col[62];
#pragma unroll
    for (int i = 0; i < 62; ++i) col[i] = __uint_as_float((unsigned)in_s[i * 512 + tid] << 16);
#pragma unroll
    for (int tt = 0; tt < 32; ++tt) {
        float acc = bias;
#pragma unroll
        for (int j = 0; j < 31; ++j) acc += col[tt + j] * w[j];
        hs[tt * 512 + tid] = acc;
    }
    __syncthreads();
#pragma unroll
    for (int q = 0; q < 4; ++q) {
        const int tt = wave * 4 + q;
        const f32x4 a = *(const f32x4*)(hs + tt * 512 + lane * 8), b = *(const f32x4*)(hs + tt * 512 + lane * 8 + 4);
        const float mean = wave_sum((a[0] + a[1]) + (a[2] + a[3]) + (b[0] + b[1]) + (b[2] + b[3])) * (1.f / 512.f);
        const f32x4 da = a - mean, db = b - mean;
        const float var = wave_sum((da[0] * da[0] + da[1] * da[1]) + (da[2] * da[2] + da[3] * da[3]) + (db[0] * db[0] + db[1] * db[1]) + (db[2] * db[2] + db[3] * db[3])) * (1.f / 512.f);
        const float rstd = __builtin_amdgcn_rsqf(var + EPS);
        const f32x4 g0 = *(const f32x4*)(lg + lane * 8), g1 = *(const f32x4*)(lg + lane * 8 + 4), b0 = *(const f32x4*)(lb + lane * 8), b1 = *(const f32x4*)(lb + lane * 8 + 4);
        f32x4 y0 = da * rstd * g0 + b0, y1 = db * rstd * g1 + b1;
#pragma unroll
        for (int j = 0; j < 4; ++j) { y0[j] = siluf_(y0[j]); y1[j] = siluf_(y1[j]); }
        *(u32x4*)(AOUT + (size_t)(rowbase + t0 + tt) * 512 + lane * 8) = pg8::pack8(y0, y1);
    }
    __syncthreads();
}

__device__ __forceinline__ f32x4 cb_lo(u32x4 v) { return (f32x4){bflo(v.x), bfhi(v.x), bflo(v.y), bfhi(v.y)}; }
__device__ __forceinline__ f32x4 cb_hi(u32x4 v) { return (f32x4){bflo(v.z), bfhi(v.z), bflo(v.w), bfhi(v.w)}; }
__device__ __forceinline__ void convb_phase(bf16_t* BG, const bf16_t* CH, const float* w3, int gtid, int nthreads) {
    const u32x4 z = (u32x4){0u, 0u, 0u, 0u};
    for (int idx = gtid; idx < (MTOK / 2) * 64; idx += nthreads) {
        const int row = (idx >> 6) * 2, ch = idx & 63;
        int pos, len; if (row < NCTX) { pos = row & 255; len = 256; } else { pos = (row - NCTX) & 4095; len = 4096; }
        const bf16_t* cp = CH + (size_t)row * 512 + ch * 8; bf16_t* bp = BG + (size_t)row * 512 + ch * 8;
        const u32x4 c1 = *(const u32x4*)cp, c2 = *(const u32x4*)(cp + 512);
        const u32x4 c0 = pos > 0 ? *(const u32x4*)(cp - 512) : z;
        const u32x4 c3 = pos + 2 < len ? *(const u32x4*)(cp + 1024) : z;
        const u32x4 b0 = *(const u32x4*)bp, b1 = *(const u32x4*)(bp + 512);
        f32x4 wa[3], wb[3];
#pragma unroll
        for (int j = 0; j < 3; ++j) { wa[j] = *(const f32x4*)(w3 + j * 512 + ch * 8); wb[j] = *(const f32x4*)(w3 + j * 512 + ch * 8 + 4); }
        const f32x4 y0a = cb_lo(b0) * (cb_lo(c0) * wa[0] + cb_lo(c1) * wa[1] + cb_lo(c2) * wa[2]), y0b = cb_hi(b0) * (cb_hi(c0) * wb[0] + cb_hi(c1) * wb[1] + cb_hi(c2) * wb[2]);
        const f32x4 y1a = cb_lo(b1) * (cb_lo(c1) * wa[0] + cb_lo(c2) * wa[1] + cb_lo(c3) * wa[2]), y1b = cb_hi(b1) * (cb_hi(c1) * wb[0] + cb_hi(c2) * wb[1] + cb_hi(c3) * wb[2]);
        *(u32x4*)bp = pg8::pack8(y0a, y0b); *(u32x4*)(bp + 512) = pg8::pack8(y1a, y1b);
    }
}

#define XB_TMO      128
#define XB_XCNT(j)  (256  + 64 * (j))
#define XB_XSUB(j)  (1280 + 64 * (j))
#define XB_XGEN(j)  (2304 + 64 * (j))
#define XB_TOP      3328
#define XB_TOPGEN   3392
#define XCD_BAR_WORDS 3456
#define XB_SPIN_CAP (1u << 18)

__device__ __forceinline__ unsigned xb_ld(unsigned* p)              { return __hip_atomic_load(p, __ATOMIC_RELAXED, __HIP_MEMORY_SCOPE_AGENT); }
__device__ __forceinline__ unsigned xb_add(unsigned* p, unsigned v) { return __hip_atomic_fetch_add(p, v, __ATOMIC_RELAXED, __HIP_MEMORY_SCOPE_AGENT); }
__device__ __forceinline__ unsigned xb_xcc_id() { return (unsigned)__builtin_amdgcn_s_getreg((3 << 11) | 20) & 0xFu; }
#define XB_SPIN(cond, bar) do { unsigned _sp = 0; while (cond) { __builtin_amdgcn_s_sleep(1); \
    if ((++_sp & 255u) == 0u) { if (xb_ld(&(bar)[XB_TMO])) break; if (_sp > XB_SPIN_CAP) { atomicAdd(&(bar)[XB_TMO], 1u); break; } } } } while (0)

struct XcdBarrier {
    unsigned* bar; unsigned x;
    volatile LAS unsigned* st;
};

__device__ __forceinline__ XcdBarrier xcd_barrier_post(unsigned* bar, volatile LAS unsigned* st) {
    XcdBarrier b; b.bar = bar; b.x = xb_xcc_id(); b.st = st;
    if (threadIdx.x == 0) (void)xb_add(&bar[XB_XCNT(b.x)], 1u);
    return b;
}
__device__ __forceinline__ void xcd_barrier_complete(unsigned* bar, unsigned x, unsigned& nloc, unsigned& nx) {
    const unsigned G = gridDim.x * gridDim.y * gridDim.z;
    unsigned sum, cnt, mine, sp = 0u;
    for (;;) {
        sum = 0u; cnt = 0u; mine = 0u;
#pragma unroll
        for (unsigned j = 0; j < 16; ++j) { const unsigned c = xb_ld(&bar[XB_XCNT(j)]); sum += c; cnt += (c > 0u) ? 1u : 0u; mine = (j == x) ? c : mine; }
        if (sum == G) break;
        __builtin_amdgcn_s_sleep(1);
        if ((++sp & 255u) == 0u) { if (xb_ld(&bar[XB_TMO])) break; if (sp > XB_SPIN_CAP) { atomicAdd(&bar[XB_TMO], 1u); break; } }
    }
    nloc = mine > 0u ? mine : 1u; nx = cnt > 0u ? cnt : 1u;
}

__device__ __forceinline__ void xcd_barrier(const XcdBarrier& b) {
    asm volatile("s_waitcnt vmcnt(0)" ::: "memory");
    __syncthreads();
    if (threadIdx.x == 0) {
        unsigned* bar = b.bar;
        __builtin_amdgcn_s_waitcnt(0);
        unsigned nloc = b.st[0], nx = b.st[1];
        if (nloc == 0u) { xcd_barrier_complete(bar, b.x, nloc, nx); b.st[0] = nloc; b.st[1] = nx; }
        const unsigned old = xb_add(&bar[XB_XSUB(b.x)], 1u);
        const unsigned gen = old / nloc;
        if (old + 1u == (gen + 1u) * nloc) {
            __builtin_amdgcn_fence(__ATOMIC_RELEASE, "agent");
            asm volatile("s_waitcnt vmcnt(0)" ::: "memory");
            const unsigned og = xb_add(&bar[XB_TOP], 1u);
            const unsigned tg = og / nx;
            if (og + 1u == (tg + 1u) * nx) xb_add(&bar[XB_TOPGEN], 1u);
            else XB_SPIN(xb_ld(&bar[XB_TOPGEN]) == tg, bar);
            __builtin_amdgcn_fence(__ATOMIC_ACQUIRE, "agent");
            xb_add(&bar[XB_XGEN(b.x)], 1u);
            asm volatile("s_waitcnt vmcnt(0)" ::: "memory");
        } else {
            XB_SPIN(xb_ld(&bar[XB_XGEN(b.x)]) == gen, bar);
            __builtin_amdgcn_fence(__ATOMIC_ACQUIRE, "agent");
            asm volatile("s_waitcnt vmcnt(0)" ::: "memory");
        }
    }
    __syncthreads();
}


constexpr int EARLY_ROWS = 128 * 256;
__device__ __forceinline__ bool tail_ok(int G) { return ((MTOK / 256 * 4) % G) * 2 == G && ((G / 2) % 4) == 0 && (MTOK / 256 - (G / 2) / 4) * 256 == EARLY_ROWS; }
__device__ __forceinline__ void handoff_signal(unsigned* ctr) {
    asm volatile("s_waitcnt vmcnt(0)" ::: "memory"); __syncthreads();
    if (threadIdx.x == 0) { __builtin_amdgcn_fence(__ATOMIC_RELEASE, "agent"); asm volatile("s_waitcnt vmcnt(0)" ::: "memory");
        (void)__hip_atomic_fetch_add(ctr, 1u, __ATOMIC_RELAXED, __HIP_MEMORY_SCOPE_AGENT); }
}
__device__ __forceinline__ void handoff_wait(unsigned* ctr, unsigned want) {
    if (threadIdx.x == 0) { unsigned sp = 0;
        while (__hip_atomic_load(ctr, __ATOMIC_RELAXED, __HIP_MEMORY_SCOPE_AGENT) < want && ++sp < (1u << 22)) __builtin_amdgcn_s_sleep(8);
        __builtin_amdgcn_fence(__ATOMIC_ACQUIRE, "agent"); asm volatile("s_waitcnt vmcnt(0)" ::: "memory"); }
    __syncthreads();
}

#ifndef PHASE_MASK
#define PHASE_MASK 0xFFFFF
#endif
#define PH_ON(n) ((PHASE_MASK >> (n)) & 1)
#ifndef LAST_PHASE
#define LAST_PHASE 99
#endif
#define PHX(n) if (l * 12 + (n) <= LAST_PHASE)

__global__ void __launch_bounds__(NTHR, 2) fwd_megakernel(Args a) {
    extern __shared__ __attribute__((aligned(16))) unsigned char lds[];
    cg::grid_group grid = cg::this_grid();
    const int G = gridDim.x, bx = blockIdx.x;
    PG8_LAS unsigned char* ldsg = (PG8_LAS unsigned char*)lds;
    grid.sync();
    volatile LAS unsigned* bst = (volatile LAS unsigned*)((LAS unsigned char*)lds + LDS_BYTES - 64);
    if (threadIdx.x < 16) bst[threadIdx.x] = 0u;
    __syncthreads();
    (void)xcd_barrier_post((unsigned*)inp(a, 31), bst);
#define GSYNC() do { XcdBarrier b_; b_.bar = (unsigned*)inp(a, 31); b_.x = xb_xcc_id(); b_.st = (volatile LAS unsigned*)((LAS unsigned char*)lds + LDS_BYTES - 64); xcd_barrier(b_); } while (0)
#define TIDS const int tid = threadIdx.x + opaque_vzero(), lane = tid & 63, wave = __builtin_amdgcn_readfirstlane(tid >> 6); \
             const int gw = bx * NWAVES + wave, ngw = G * NWAVES, gtid = bx * NTHR + tid, nthreads = G * NTHR; (void)gw; (void)ngw; (void)gtid; (void)nthreads; (void)lane;
#define BASES const int z_ = opaque_zero(); unsigned char* ws = (unsigned char*)inp(a, 31); float* out = (float*)inp(a, 30); const int lp = l + z_; const int bxp = bx + z_, Gp = G + z_; (void)bxp; (void)Gp; \
              const float* modl = (const float*)(ws + WS_MODS) + (size_t)lp * 9 * MODW; (void)modl; (void)out;

    {
        TIDS
#if PH_ON(0)
        compute_mods(a, lds, tid, wave, lane);
#endif
        unsigned char* ws = (unsigned char*)inp(a, 31);
        bf16_t* CK = (bf16_t*)(ws + WS_CK); bf16_t* CV = (bf16_t*)(ws + WS_CV);
        for (int i = gtid; i < 2 * 524288; i += nthreads) {
            const int which = i >= 524288; const int j = which ? i - 524288 : i;
            const float* src = inp(a, which ? 3 : 2) + (size_t)j * 8; bf16_t* dst = (which ? CV : CK) + (size_t)j * 8;
            const f32x4 x0 = *(const f32x4*)src, x1 = *(const f32x4*)(src + 4);
            u32x4 w; w.x = pk2(x0[0], x0[1]); w.y = pk2(x0[2], x0[3]); w.z = pk2(x1[0], x1[1]); w.w = pk2(x1[2], x1[3]);
            *(u32x4*)dst = w;
        }
    }
    GSYNC();

    for (int l = 0; l < 2; ++l) {
        PHX(1) {
            TIDS BASES
#if PH_ON(1)
            convert_weights(a, lp, lds, gw, ngw, wave, lane);
#endif
#if PH_ON(2)
            const float* xin0 = lp == 0 ? inp(a, 0) : out;
            const float* xin1 = lp == 0 ? inp(a, 1) - (size_t)NCTX * DM : out;
            adaln_phase(xin0, xin1, inp(a, 8) + lp * DM, modl, 0, (bf16_t*)(ws + WS_U), (lp != 0 && tail_ok(Gp)) ? EARLY_ROWS : 0, MTOK, gw, ngw, lane);
#endif
        }
        GSYNC();
#if PH_ON(3)
        PHX(2) { BASES
          pg8::Gemm g{(const bf16_t*)(ws + WS_U), (const bf16_t*)(ws + W_GU1), 0, 0, MTOK, 2 * DFF, DM}; pg8::Order S; S.init(MTOK, 2 * DFF, Gp, bxp, 1);
          pg8::EpiSwiGLU E{(bf16_t*)(ws + WS_H)}; pg8::gemm_phase<pg8::EpiSwiGLU, true, true>(ldsg, g, S, E); }
#endif
        GSYNC();
#if PH_ON(4)
        PHX(3) { BASES
          const float* xin0 = lp == 0 ? inp(a, 0) : out;
          const float* xin1 = lp == 0 ? inp(a, 1) - (size_t)NCTX * DM : out;
          pg8::Gemm g{(const bf16_t*)(ws + WS_H), (const bf16_t*)(ws + W_D1), 0, 0, MTOK, DM, DFF}; pg8::Order S; S.init(MTOK, DM, Gp, bxp, 1);
          pg8::EpiResid E{xin0, xin1, out, modl + 2 * DM, 0.5f};
          unsigned* hctr = (unsigned*)ws + 3600 + 64 * (lp * 2);
#pragma nounroll
          for (int pass = 0; pass < 2; ++pass) {
              S.window(pass * 2, pass ? (1 << 30) : 2, 1);
              pg8::gemm_phase<pg8::EpiResid, true, true>(ldsg, g, S, E);
              if (pass == 0) handoff_signal(hctr);
          }
          if (S.tail && bxp >= Gp / 2) {
              TIDS
              handoff_wait(hctr, (unsigned)Gp);
              adaln_phase(out, out, inp(a, 12) + lp * DM, modl, 3, (bf16_t*)(ws + WS_U), 0, EARLY_ROWS, (bxp - Gp / 2) * NWAVES + wave, (Gp / 2) * NWAVES, lane);
          } }
#endif
        GSYNC();
#if PH_ON(14)
        PHX(4) { TIDS BASES
          adaln_phase(out, out, inp(a, 12) + lp * DM, modl, 3, (bf16_t*)(ws + WS_U), tail_ok(Gp) ? EARLY_ROWS : 0, MTOK, gw, ngw, lane); }
#endif
        GSYNC();
#if PH_ON(5)
        PHX(5) { BASES
          float* newk = out + (size_t)MTOK * DM; float* newv = newk + (size_t)32 * 2 * 256 * 512;
          pg8::Gemm g{(const bf16_t*)(ws + WS_U), (const bf16_t*)(ws + W_IN), 0, 0, MTOK, 4096, DM}; pg8::Order S; S.init(MTOK, 4096, Gp, bxp, 1);
          pg8::EpiWin E{(bf16_t*)(ws + WS_GLU), (bf16_t*)(ws + WS_CH), (bf16_t*)(ws + WS_BG), (bf16_t*)(ws + WS_Q), (bf16_t*)(ws + WS_K), (bf16_t*)(ws + WS_V),
                        inp(a, 21) + lp * 64, inp(a, 22) + lp * 64, newk, newv, lp};
          pg8::gemm_phase<pg8::EpiWin, true, true>(ldsg, g, S, E); }
#endif
        GSYNC();
        PHX(6) {
            TIDS BASES
            bf16_t* Q = (bf16_t*)(ws + WS_Q); const bf16_t* Kb = (const bf16_t*)(ws + WS_K); const bf16_t* Vb = (const bf16_t*)(ws + WS_V);
#if PH_ON(11)
            {
            const bf16_t* CK = (const bf16_t*)(ws + WS_CK); const bf16_t* CV = (const bf16_t*)(ws + WS_CV);
            const float* rpb_l = inp(a, 23) + (size_t)lp * 8 * 15 * 31;
            {
                const int half = wave >> 2, ht = tid & 255, J = wave & 3;
                unsigned char* hlds = lds + half * att::HALF_BYTES;
                if (ht == 0) *(volatile LAS unsigned*)(LAS unsigned char*)(hlds + att::CNT_OFF) = 0u;
                __syncthreads();
                unsigned btarget = 0u;
                const int hw = bxp * 2 + half, nhw = Gp * 2;
                for (int u = hw; u < 4096; u += nhw) {
                    const int b = u >> 9, head = (u >> 6) & 7, r = u & 63;
                    const size_t co = (size_t)((b * 2 + lp) * 512) * 512;
                    att::unit<true>(hlds, btarget, Q, Kb, Vb, CK + co, CV + co, rpb_l, NCTX + b * 4096 + r * 64, NCTX + b * 4096, head, r, ht, J, lane);
                }
                for (int u = hw; u < 1024; u += nhw) {
                    const int b = u >> 5, head = (u >> 2) & 7, qb = u & 3;
                    att::unit<false>(hlds, btarget, Q, Kb, Vb, nullptr, nullptr, nullptr, b * 256 + qb * 64, b * 256, head, 0, ht, J, lane);
                }
                __syncthreads();
            }
            }
#endif
#if PH_ON(12)
            {
            const float* cw = inp(a, 14) + (size_t)lp * 31 * 512; const float* cb = inp(a, 15) + lp * 512; const float* lg = inp(a, 16) + lp * 512; const float* lb = inp(a, 17) + lp * 512;
            for (int u = bxp; u < 1280; u += Gp) {
                int rowbase, len, t0;
                if (u < 256) { rowbase = (u >> 3) * 256; len = 256; t0 = (u & 7) * 32; }
                else { const int v = u - 256; rowbase = NCTX + (v >> 7) * 4096; len = 4096; t0 = (v & 127) * 32; }
                conva_unit(lds, (const bf16_t*)(ws + WS_GLU), (bf16_t*)(ws + WS_AOUT), cw, cb, lg, lb, rowbase, len, t0, tid, wave, lane);
            }
            }
#endif
#if PH_ON(13)
            convb_phase((bf16_t*)(ws + WS_BG), (const bf16_t*)(ws + WS_CH), inp(a, 19) + (size_t)lp * 3 * 512, gtid, nthreads);
#endif
        }
        GSYNC();
#if PH_ON(6)
        PHX(7) { BASES
          const bf16_t* Wg = (const bf16_t*)(ws + W_IN) + (size_t)4096 * DM;
          pg8::Gemm g{(const bf16_t*)(ws + WS_U), Wg, 0, 0, MTOK, 3072, DM}; pg8::Order S; S.init(MTOK, 3072, Gp, bxp, 1);
          pg8::EpiGates E{(bf16_t*)(ws + WS_GS)}; pg8::gemm_phase<pg8::EpiGates, true, true>(ldsg, g, S, E); }
#endif
        GSYNC();
#if PH_ON(7)
        PHX(8) { BASES
          pg8::Gemm g{(const bf16_t*)(ws + WS_BG), (const bf16_t*)(ws + W_B), BR_STRIDE, WO_STRIDE, MTOK, DM, 512}; pg8::Order S; S.init(MTOK, DM, Gp, bxp, 3);
          pg8::EpiM E{(const bf16_t*)(ws + WS_GS), (bf16_t*)(ws + WS_U)}; pg8::gemm_phase<pg8::EpiM, true, true>(ldsg, g, S, E); }
#endif
        GSYNC();
#if PH_ON(8)
        PHX(9) { BASES
          pg8::Gemm g{(const bf16_t*)(ws + WS_U), (const bf16_t*)(ws + W_M), 0, 0, MTOK, DM, DM}; pg8::Order S; S.init(MTOK, DM, Gp, bxp, 1);
          pg8::EpiResid E{out, out, out, modl + 5 * DM, 1.0f}; pg8::gemm_phase<pg8::EpiResid, true, true>(ldsg, g, S, E); }
#endif
        GSYNC();
#if PH_ON(14)
        PHX(10) { TIDS BASES
          adaln_phase(out, out, inp(a, 26) + lp * DM, modl, 6, (bf16_t*)(ws + WS_U), 0, MTOK, gw, ngw, lane); }
#endif
        GSYNC();
#if PH_ON(9)
        PHX(11) { BASES
          pg8::Gemm g{(const bf16_t*)(ws + WS_U), (const bf16_t*)(ws + W_GU2), 0, 0, MTOK, 2 * DFF, DM}; pg8::Order S; S.init(MTOK, 2 * DFF, Gp, bxp, 1);
          pg8::EpiSwiGLU E{(bf16_t*)(ws + WS_H)}; pg8::gemm_phase<pg8::EpiSwiGLU, true, true>(ldsg, g, S, E); }
#endif
        GSYNC();
#if PH_ON(10)
        PHX(12) { BASES
          pg8::Gemm g{(const bf16_t*)(ws + WS_H), (const bf16_t*)(ws + W_D2), 0, 0, MTOK, DM, DFF}; pg8::Order S; S.init(MTOK, DM, Gp, bxp, 1);
          pg8::EpiResid E{out, out, out, modl + 8 * DM, 0.5f};
          unsigned* hctr = (unsigned*)ws + 3600 + 64 * (lp * 2 + 1);
          const int npass = lp == 0 ? 2 : 1;
#pragma nounroll
          for (int pass = 0; pass < npass; ++pass) {
              S.window(pass * 2, (npass == 2 && pass == 0) ? 2 : (1 << 30), npass == 2);
              pg8::gemm_phase<pg8::EpiResid, true, true>(ldsg, g, S, E);
              if (npass == 2 && pass == 0) handoff_signal(hctr);
          }
          if (npass == 2 && S.tail && bxp >= Gp / 2) {
              TIDS
              handoff_wait(hctr, (unsigned)Gp);
              adaln_phase(out, out, inp(a, 8) + (lp + 1) * DM, modl + 9 * MODW, 0, (bf16_t*)(ws + WS_U), 0, EARLY_ROWS, (bxp - Gp / 2) * NWAVES + wave, (Gp / 2) * NWAVES, lane);
          } }
#endif
        if (l == 0) GSYNC();
    }
}

extern "C" void kernel_launch(void* const* d_in, const int* in_sizes, int n_in, void* d_out, int out_size, void* d_ws, size_t ws_size, hipStream_t stream) {
    static int grid = 0;
    if (grid == 0) {
        if (n_in != 30 || ws_size < WS_END) { fprintf(stderr, "kernel_launch: unexpected inputs (n_in %d, ws %zu)\n", n_in, ws_size); grid = -1; return; }
        int dev = 0, cus = 0, per_cu = 0;
        hipGetDevice(&dev);
        hipDeviceGetAttribute(&cus, hipDeviceAttributeMultiprocessorCount, dev);
        hipFuncSetAttribute((const void*)fwd_megakernel, hipFuncAttributeMaxDynamicSharedMemorySize, LDS_BYTES);
        hipOccupancyMaxActiveBlocksPerMultiprocessor(&per_cu, (const void*)fwd_megakernel, NTHR, LDS_BYTES);
        if (per_cu < 1) per_cu = 1;
        (void)hipGetLastError();
        grid = cus;
        if (grid > 256) grid = 256;
    }
    if (grid < 0) return;
    Args a{};
    for (int i = 0; i < 30; ++i) a.in[i] = (const float*)d_in[i];
    a.in[30] = (const float*)d_out; a.in[31] = (const float*)d_ws;
    (void)hipMemsetAsync(d_ws, 0, 16384, stream);
    void* args[] = {&a};
    hipError_t e = hipLaunchCooperativeKernel((const void*)fwd_megakernel, dim3(grid), dim3(NTHR), args, LDS_BYTES, stream);
    if (e != hipSuccess) fprintf(stderr, "cooperative launch failed: %s (grid %d)\n", hipGetErrorString(e), grid);
}
```

```cpp
#include <hip/hip_runtime.h>
#include <hip/hip_cooperative_groups.h>
#include <cstdio>
#include <cstdint>
namespace cg = cooperative_groups;

#define LAS __attribute__((address_space(3)))
typedef unsigned short bf16_t;
typedef short bf16x8 __attribute__((ext_vector_type(8)));
typedef short s16x4 __attribute__((ext_vector_type(4)));
typedef float f32x4 __attribute__((ext_vector_type(4)));
typedef unsigned u32x4 __attribute__((ext_vector_type(4)));
typedef unsigned u32x2 __attribute__((ext_vector_type(2)));

constexpr int DM = 1024, NCTX = 8192, NLAT = 32768, MTOK = NCTX + NLAT;
constexpr int DFF = 2816, NIN = 7168, NMODV = 9, MODW = 9 * 1024;
constexpr int NWAVES = 8, NTHR = 512;
constexpr float EPS = 1e-6f;

constexpr size_t MiB = 1u << 20;
constexpr size_t WS_MODS = 1 * MiB;
constexpr size_t WS_W = 2 * MiB;
constexpr size_t W_GU1 = WS_W, W_D1 = W_GU1 + 11 * MiB, W_IN = W_D1 + 11 * MiB / 2, W_B = W_IN + 14 * MiB, W_C = W_B + MiB, W_A = W_C + MiB,
                 W_M = W_A + MiB, W_GU2 = W_M + 2 * MiB, W_D2 = W_GU2 + 11 * MiB;
constexpr size_t WS_U = 54 * MiB, WS_H = 134 * MiB;
constexpr size_t WS_BG = 134 * MiB, WS_Q = 174 * MiB, WS_AOUT = 214 * MiB, WS_GLU = 254 * MiB, WS_CH = 294 * MiB, WS_K = 334 * MiB, WS_V = 374 * MiB;
constexpr size_t WS_GS = 254 * MiB;
constexpr size_t GS_STRIDE = 80 * MiB / 2, BR_STRIDE = 40 * MiB / 2, WO_STRIDE = MiB / 2;
constexpr size_t WS_CK = 494 * MiB, WS_CV = 502 * MiB, WS_END = 510 * MiB;
static_assert(W_D2 + 11 * MiB / 2 <= WS_U, "weights fit");
constexpr int LDS_BYTES = 147456;

__device__ __forceinline__ unsigned f2bf(float f) { unsigned u = __builtin_bit_cast(unsigned, f); return (u + 0x7fffu + ((u >> 16) & 1u)) >> 16; }
__device__ __forceinline__ unsigned pk2(float lo, float hi) { return f2bf(lo) | (f2bf(hi) << 16); }
typedef float f32x2_t __attribute__((ext_vector_type(2))); typedef __bf16 bf16x2_t __attribute__((ext_vector_type(2)));
__device__ __forceinline__ unsigned cvt_pk_bf16(float lo, float hi) { f32x2_t v = {lo, hi}; bf16x2_t b = __builtin_convertvector(v, bf16x2_t); return __builtin_bit_cast(unsigned, b); }
__device__ __forceinline__ float bflo(unsigned w) { return __uint_as_float(w << 16); }
__device__ __forceinline__ float bfhi(unsigned w) { return __uint_as_float(w & 0xffff0000u); }
__device__ __forceinline__ float sigmoidf_(float x) { return __builtin_amdgcn_rcpf(1.f + __expf(-x)); }
__device__ __forceinline__ float siluf_(float x) { return x * sigmoidf_(x); }
__device__ __forceinline__ float wave_sum(float v) {
#pragma unroll
    for (int o = 1; o < 64; o <<= 1) v += __shfl_xor(v, o);
    return v;
}
__device__ __forceinline__ int opaque_zero() { int z; asm volatile("s_mov_b32 %0, 0" : "=s"(z)); return z; }
__device__ __forceinline__ int opaque_vzero() { int z; asm volatile("v_mov_b32 %0, 0" : "=v"(z)); return z; }
template <class T> __device__ __forceinline__ T* launder_ptr(T* p) { T* r; asm volatile("s_mov_b64 %0, %1" : "=s"(r) : "s"(p)); return r; }
#define LDS_WAIT() asm volatile("s_waitcnt lgkmcnt(0)" ::: "memory")

namespace pg8 {
#define PG8_LAS __attribute__((address_space(3)))
constexpr int BM = 256, BK = 64, HALF = 128, HTB = HALF * BK * 2, STAGE_BYTES = 8 * HTB, NXCD = 8, WGM = 8;
__device__ __forceinline__ int lds_byte(int r, int c) { const int st = (r >> 4) * 2 + (c >> 5), rr = r & 15, cc = c & 31, ob = rr * 64 + cc * 2; return st * 1024 + (ob ^ (((ob >> 9) & 1) << 5)); }
__device__ __forceinline__ void stage_rc(int b, int& R, int& C) { const int st = b / 1024, sb = b % 1024, swz = sb ^ (((sb >> 9) & 1) << 5); R = (st >> 1) * 16 + swz / 64; C = (st & 1) * 32 + (swz % 64) / 2; }
__device__ __forceinline__ int perm32(int rho) { const int n = rho >> 4, i = rho & 15; return 8 * (i >> 2) + 4 * n + (i & 3); }

struct Unit { int pm, pn, seg; };
struct Gemm { const bf16_t* A; const bf16_t* Bt; size_t segA, segB; int M, N, K; };

struct Order {
    int nM, nN, nwg, G, c, nseg, tail, nMf, i0, imax;
    __device__ void init(int M, int N, int G_, int c_, int nseg_) { nM = M / BM; nN = N / BM; nwg = nM * nN; G = G_; c = c_; nseg = nseg_; tail = 0; nMf = nM; i0 = 0; imax = 1 << 30; }
    __device__ void window(int i0_, int imax_, int want_tail) {
        if (want_tail && nseg == 1 && (nwg % G) * 2 == G && ((G / 2) % nN) == 0) { tail = 1; nMf = nM - (G / 2) / nN; }
        i0 = i0_; imax = imax_; }
    __device__ bool next(int i, Unit& u) const {
        i += i0; if (i >= imax) return false;
        const int tile = i / nseg, seg = i - tile * nseg;
        const int nwf = nMf * nN;
        if (tail && tile == nwf / G) { if (c >= G / 2) return false; u.pm = nMf + c / nN; u.pn = c % nN; u.seg = 0; return true; }
        const long L = (long)tile * G + c; if (L >= nwf) return false;
        int wgid = (int)L; { const int q = nwf / NXCD, r = nwf % NXCD, xcd = wgid % NXCD, off = wgid / NXCD; wgid = (xcd < r ? xcd * (q + 1) : r * (q + 1) + (xcd - r) * q) + off; }
        const int nig = WGM * nN, gid = wgid / nig, fm = gid * WGM, gsz = (nMf - fm) < WGM ? (nMf - fm) : WGM;
        u.pm = fm + ((wgid % nig) % gsz); u.pn = (wgid % nig) / gsz; u.seg = seg; return true;
    }
};

template <class Epi, bool ALIGN_EPI, bool SP2>
__device__ __forceinline__ void gemm_phase(PG8_LAS unsigned char* lds, const Gemm g, const Order& S, const Epi& E) {
    const int tid = threadIdx.x + opaque_vzero(), wid = __builtin_amdgcn_readfirstlane(tid >> 6), lane = tid & 63, wr = wid >> 2, wc = wid & 3, fr = lane & 15, fq = lane >> 4;
    const int K = g.K, nt = K / BK;
    unsigned voffA[2], voffB[2];
#pragma unroll
    for (int i = 0; i < 2; ++i) { int R, C; stage_rc(tid * 16 + i * 8192, R, C); const int Rb = Epi::PERM ? ((R & ~31) + perm32(R & 31)) : R;
        voffA[i] = (unsigned)(R * K + C) * 2u; voffB[i] = (unsigned)(Rb * K + C) * 2u; }
    const size_t kstep = (size_t)(BK * 2);
    const size_t hstep = (size_t)HALF * K * 2;
    const size_t tstep = 2 * hstep;
    const unsigned ldsw = (unsigned)wid * 1024u;
    const int aoff = lds_byte(wr * 64 + fr, fq * 8), boff = lds_byte(wc * 32 + fr, fq * 8);
#define PG8_SA(b, h) (((b) * 2 + (h)) * HTB)
#define PG8_SB(b, h) ((4 + (b) * 2 + (h)) * HTB)
#define PG8_STAGE(bufoff, gbase, voff) do { _Pragma("unroll") for (int _i = 0; _i < 2; ++_i) \
        __builtin_amdgcn_global_load_lds((const unsigned*)((const char*)(gbase) + (voff)[_i]), (PG8_LAS unsigned*)(lds + (bufoff) + ldsw + _i * 8192), 16, 0, 0); } while (0)
#define PG8_LDA(dst, b, h) do { _Pragma("unroll") for (int m = 0; m < 4; ++m) _Pragma("unroll") for (int k = 0; k < 2; ++k) dst[m][k] = *(const PG8_LAS bf16x8*)(lds + PG8_SA(b, h) + aoff + m * 2048 + k * 1024); } while (0)
#define PG8_LDB(dst, b, h) do { _Pragma("unroll") for (int n = 0; n < 2; ++n) _Pragma("unroll") for (int k = 0; k < 2; ++k) dst[n][k] = *(const PG8_LAS bf16x8*)(lds + PG8_SB(b, h) + boff + n * 2048 + k * 1024); } while (0)
#define PG8_MMA(ai, bj, At, Bt) do { __builtin_amdgcn_s_setprio(1); _Pragma("unroll") for (int m = 0; m < 4; ++m) _Pragma("unroll") for (int n = 0; n < 2; ++n) _Pragma("unroll") for (int k = 0; k < 2; ++k) \
        acc[ai][bj][m][n] = __builtin_amdgcn_mfma_f32_16x16x32_bf16(Bt[n][k], At[m][k], acc[ai][bj][m][n], 0, 0, 0); __builtin_amdgcn_s_setprio(0); } while (0)
#define PG8_WAIT_V(n) asm volatile("s_waitcnt vmcnt(" #n ")" ::: "memory")
#define PG8_WAIT_L(n) asm volatile("s_waitcnt lgkmcnt(" #n ")" ::: "memory")
#define PG8_BAR __builtin_amdgcn_s_barrier()
#define PG8_SCHED __builtin_amdgcn_sched_barrier(0)
    Unit cur, nxt; int ui = 0;
    if (!S.next(0, cur)) return;
    f32x4 acc[2][2][4][2];
#pragma unroll
    for (int a = 0; a < 2; ++a)
#pragma unroll
        for (int b = 0; b < 2; ++b)
#pragma unroll
            for (int m = 0; m < 4; ++m)
#pragma unroll
                for (int n = 0; n < 2; ++n) acc[a][b][m][n] = (f32x4){0.f, 0.f, 0.f, 0.f};
    bf16x8 At[4][2], B0[2][2], B1[2][2];
    const char* cA = (const char*)(g.A + cur.seg * g.segA) + (size_t)cur.pm * tstep; const char* cB = (const char*)(g.Bt + cur.seg * g.segB) + (size_t)cur.pn * tstep;
    if constexpr (SP2) {
        PG8_STAGE(PG8_SB(0, 0), cB, voffB); PG8_STAGE(PG8_SB(0, 1), cB + hstep, voffB); PG8_STAGE(PG8_SA(0, 0), cA, voffA); PG8_STAGE(PG8_SA(0, 1), cA + hstep, voffA);
        if (wr == 1) PG8_BAR;
        PG8_WAIT_V(2); PG8_BAR;
        PG8_STAGE(PG8_SB(1, 0), cB + kstep, voffB); PG8_STAGE(PG8_SA(1, 0), cA + kstep, voffA); PG8_STAGE(PG8_SB(1, 1), cB + hstep + kstep, voffB);
        PG8_WAIT_V(6); PG8_BAR;
    } else {
        PG8_STAGE(PG8_SB(0, 0), cB, voffB); PG8_STAGE(PG8_SA(0, 0), cA, voffA); PG8_STAGE(PG8_SB(0, 1), cB + hstep, voffB); PG8_STAGE(PG8_SA(0, 1), cA + hstep, voffA);
        if (wr == 1) PG8_BAR;
        PG8_WAIT_V(4); PG8_BAR;
        PG8_STAGE(PG8_SB(1, 0), cB + kstep, voffB); PG8_STAGE(PG8_SA(1, 0), cA + kstep, voffA); PG8_STAGE(PG8_SB(1, 1), cB + hstep + kstep, voffB);
        PG8_WAIT_V(6); PG8_BAR;
    }
    for (;;) {
        const bool has_next = S.next(ui + 1, nxt);
        const char* nA = has_next ? (const char*)(g.A + nxt.seg * g.segA) + (size_t)nxt.pm * tstep : cA; const char* nB = has_next ? (const char*)(g.Bt + nxt.seg * g.segB) + (size_t)nxt.pn * tstep : cB;
        for (int t = 0; t < nt; t += 2) {
            const bool last = (t == nt - 2);
            const char* a1 = cA + (size_t)(t + 1) * kstep;
            const char* a2 = last ? nA : cA + (size_t)(t + 2) * kstep; const char* b2 = last ? nB : cB + (size_t)(t + 2) * kstep;
            const char* a3 = a2 + kstep; const char* b3 = b2 + kstep;
            if constexpr (SP2) {
            PG8_LDB(B0, 0, 0); PG8_LDB(B1, 0, 1); PG8_SCHED; PG8_LDA(At, 0, 0); PG8_STAGE(PG8_SA(1, 1), a1 + hstep, voffA);
            PG8_WAIT_V(8); PG8_WAIT_L(0); PG8_BAR; PG8_MMA(0, 0, At, B0); PG8_MMA(0, 1, At, B1); PG8_BAR; PG8_SCHED;
            PG8_LDA(At, 0, 1); PG8_STAGE(PG8_SB(0, 0), b2, voffB); PG8_STAGE(PG8_SB(0, 1), b2 + hstep, voffB); PG8_STAGE(PG8_SA(0, 0), a2, voffA);
            PG8_WAIT_V(8); PG8_WAIT_L(0); PG8_BAR; PG8_MMA(1, 0, At, B0); PG8_MMA(1, 1, At, B1); PG8_BAR; PG8_SCHED;
            PG8_LDB(B0, 1, 0); PG8_LDB(B1, 1, 1); PG8_SCHED; PG8_LDA(At, 1, 0); PG8_STAGE(PG8_SA(0, 1), a2 + hstep, voffA);
            PG8_WAIT_V(8); PG8_WAIT_L(0); PG8_BAR; PG8_MMA(0, 0, At, B0); PG8_MMA(0, 1, At, B1); PG8_BAR; PG8_SCHED;
            PG8_LDA(At, 1, 1); PG8_STAGE(PG8_SB(1, 0), b3, voffB); PG8_STAGE(PG8_SB(1, 1), b3 + hstep, voffB); PG8_STAGE(PG8_SA(1, 0), a3, voffA);
            PG8_WAIT_V(8); PG8_WAIT_L(0); PG8_BAR; PG8_MMA(1, 0, At, B0); PG8_MMA(1, 1, At, B1); PG8_BAR; PG8_SCHED;
            } else {
            PG8_LDB(B0, 0, 0); PG8_SCHED; PG8_LDA(At, 0, 0); PG8_STAGE(PG8_SA(1, 1), a1 + hstep, voffA);
            PG8_WAIT_L(8); PG8_BAR; PG8_WAIT_L(0); PG8_MMA(0, 0, At, B0); PG8_BAR; PG8_SCHED;
            PG8_LDB(B1, 0, 1); PG8_STAGE(PG8_SB(0, 0), b2, voffB);
            PG8_BAR; PG8_WAIT_L(0); PG8_MMA(0, 1, At, B1); PG8_BAR;
            PG8_LDA(At, 0, 1); PG8_STAGE(PG8_SA(0, 0), a2, voffA);
            PG8_BAR; PG8_WAIT_L(0); PG8_MMA(1, 0, At, B0); PG8_BAR; PG8_SCHED;
            PG8_STAGE(PG8_SB(0, 1), b2 + hstep, voffB);
            PG8_WAIT_V(6); PG8_BAR; PG8_MMA(1, 1, At, B1); PG8_BAR;
            PG8_LDB(B0, 1, 0); PG8_SCHED; PG8_LDA(At, 1, 0); PG8_STAGE(PG8_SA(0, 1), a2 + hstep, voffA);
            PG8_WAIT_L(8); PG8_BAR; PG8_WAIT_L(0); PG8_MMA(0, 0, At, B0); PG8_BAR; PG8_SCHED;
            PG8_LDB(B1, 1, 1); PG8_STAGE(PG8_SB(1, 0), b3, voffB);
            PG8_BAR; PG8_WAIT_L(0); PG8_MMA(0, 1, At, B1); PG8_BAR;
            PG8_LDA(At, 1, 1); PG8_STAGE(PG8_SA(1, 0), a3, voffA);
            PG8_BAR; PG8_WAIT_L(0); PG8_MMA(1, 0, At, B0); PG8_BAR; PG8_SCHED;
            PG8_STAGE(PG8_SB(1, 1), b3 + hstep, voffB);
            PG8_WAIT_V(6); PG8_BAR; PG8_MMA(1, 1, At, B1); PG8_BAR;
            }
        }
        if constexpr (ALIGN_EPI) { if (wr == 0) PG8_BAR; }
        E(acc, cur, wr, wc, fr, fq);
        if (!has_next) break;
#pragma unroll
        for (int a = 0; a < 2; ++a)
#pragma unroll
            for (int b = 0; b < 2; ++b)
#pragma unroll
                for (int m = 0; m < 4; ++m)
#pragma unroll
                    for (int n = 0; n < 2; ++n) acc[a][b][m][n] = (f32x4){0.f, 0.f, 0.f, 0.f};
        cur = nxt; cA = nA; cB = nB; ++ui;
        if constexpr (ALIGN_EPI) { if (wr == 1) PG8_BAR; }
    }
    PG8_WAIT_V(0);
    if constexpr (!ALIGN_EPI) { if (wr == 0) PG8_BAR; }
    PG8_BAR;
#undef PG8_SA
#undef PG8_SB
#undef PG8_STAGE
#undef PG8_LDA
#undef PG8_LDB
#undef PG8_MMA
#undef PG8_WAIT_V
#undef PG8_WAIT_L
#undef PG8_BAR
#undef PG8_SCHED
}

typedef f32x4 Acc[2][2][4][2];

__device__ __forceinline__ u32x4 pack8(const f32x4 a, const f32x4 b) {
    u32x4 w; w.x = cvt_pk_bf16(a[0], a[1]); w.y = cvt_pk_bf16(a[2], a[3]); w.z = cvt_pk_bf16(b[0], b[1]); w.w = cvt_pk_bf16(b[2], b[3]); return w;
}

struct EpiSwiGLU {
    static constexpr bool PERM = true;
    bf16_t* H;
    __device__ __forceinline__ void operator()(const Acc& acc, const Unit& u, int wr, int wc, int fr, int fq) const {
        const int row0 = u.pm * BM + wr * 64 + fr, col0 = u.pn * HALF + wc * 32 + 8 * fq;
#pragma unroll
        for (int ai = 0; ai < 2; ++ai)
#pragma unroll
            for (int m = 0; m < 4; ++m) {
                bf16_t* rowp = H + (size_t)(row0 + ai * HALF + m * 16) * DFF + col0;
                f32x4 h0, h1;
#pragma unroll
                for (int j = 0; j < 4; ++j) { h0[j] = siluf_(acc[ai][0][m][0][j]) * acc[ai][1][m][0][j]; h1[j] = siluf_(acc[ai][0][m][1][j]) * acc[ai][1][m][1][j]; }
                *(u32x4*)rowp = pack8(h0, h1);
                __builtin_amdgcn_sched_barrier(0);
            }
    }
};

struct EpiResid {
    static constexpr bool PERM = false;
    const float* in0; const float* in1; float* out; const float* gate; float coef;
    __device__ __forceinline__ void operator()(const Acc& acc, const Unit& u, int wr, int wc, int fr, int fq) const {
        const int v = u.pm < 32 ? 0 : 1 + ((u.pm - 32) >> 4);
        const float* gv = gate + (size_t)v * MODW;
        const float* in = u.pm < 32 ? in0 : in1;
        const int col0 = u.pn * BM + wc * 32 + 4 * fq;
        f32x4 g[2][2];
#pragma unroll
        for (int bj = 0; bj < 2; ++bj)
#pragma unroll
            for (int n = 0; n < 2; ++n) g[bj][n] = *(const f32x4*)(gv + col0 + bj * HALF + n * 16) * coef;
#pragma unroll
        for (int ai = 0; ai < 2; ++ai) {
            f32x4 x[4][2][2];
#pragma unroll
            for (int m = 0; m < 4; ++m) {
                const size_t off = (size_t)(u.pm * BM + ai * HALF + wr * 64 + m * 16 + fr) * DM + col0;
#pragma unroll
                for (int bj = 0; bj < 2; ++bj)
#pragma unroll
                    for (int n = 0; n < 2; ++n) x[m][bj][n] = *(const f32x4*)(in + off + bj * HALF + n * 16);
            }
            __builtin_amdgcn_sched_barrier(0);
#pragma unroll
            for (int m = 0; m < 4; ++m) {
                const size_t off = (size_t)(u.pm * BM + ai * HALF + wr * 64 + m * 16 + fr) * DM + col0;
#pragma unroll
                for (int bj = 0; bj < 2; ++bj)
#pragma unroll
                    for (int n = 0; n < 2; ++n) *(f32x4*)(out + off + bj * HALF + n * 16) = x[m][bj][n] + g[bj][n] * acc[ai][bj][m][n];
            }
            __builtin_amdgcn_sched_barrier(0);
        }
    }
};

struct EpiWin {
    static constexpr bool PERM = true;
    bf16_t *GLU, *CH, *BG, *Q, *Kb, *Vb; const float *qg, *kg; float *newk, *newv; int layer;
    __device__ __forceinline__ void operator()(const Acc& acc, const Unit& u, int wr, int wc, int fr, int fq) const {
        const int row0 = u.pm * BM + wr * 64 + fr, cw = wc * 32 + 8 * fq, pn = u.pn;
        if (pn < 8) {
            bf16_t* O = (pn < 4 ? GLU : CH); const int col0 = (pn & 3) * HALF + cw;
#pragma unroll
            for (int ai = 0; ai < 2; ++ai)
#pragma unroll
                for (int m = 0; m < 4; ++m) {
                    f32x4 h0, h1;
                    if (pn < 4) {
#pragma unroll
                        for (int j = 0; j < 4; ++j) { h0[j] = acc[ai][0][m][0][j] * sigmoidf_(acc[ai][1][m][0][j]); h1[j] = acc[ai][0][m][1][j] * sigmoidf_(acc[ai][1][m][1][j]); }
                    } else { h0 = acc[ai][0][m][0] * acc[ai][1][m][0]; h1 = acc[ai][0][m][1] * acc[ai][1][m][1]; }
                    *(u32x4*)(O + (size_t)(row0 + ai * HALF + m * 16) * 512 + col0) = pack8(h0, h1);
                    __builtin_amdgcn_sched_barrier(0);
                }
        } else if (pn < 10 || pn >= 14) {
            bf16_t* O = (pn < 10 ? BG : Vb); const int colt = (pn < 10 ? pn - 8 : pn - 14) * BM + cw;
            const bool wnew = (pn >= 14) && (u.pm < 32);
#pragma unroll
            for (int ai = 0; ai < 2; ++ai)
#pragma unroll
                for (int m = 0; m < 4; ++m) {
                    const int row = row0 + ai * HALF + m * 16;
#pragma unroll
                    for (int bj = 0; bj < 2; ++bj) {
                        *(u32x4*)(O + (size_t)row * 512 + colt + bj * HALF) = pack8(acc[ai][bj][m][0], acc[ai][bj][m][1]);
                        if (wnew) { float* p = newv + ((size_t)(u.pm * 2 + layer) * 256 + (row - u.pm * BM)) * 512 + colt + bj * HALF;
                            *(f32x4*)p = acc[ai][bj][m][0]; *(f32x4*)(p + 4) = acc[ai][bj][m][1]; }
                    }
                    __builtin_amdgcn_sched_barrier(0);
                }
        } else {
            const bool isk = pn >= 12; bf16_t* O = isk ? Kb : Q; const float* gn = isk ? kg : qg;
            const int head = 4 * ((pn - 10) & 1) + wc; const bool wnew = isk && (u.pm < 32);
            f32x4 gv[2][2];
#pragma unroll
            for (int bj = 0; bj < 2; ++bj)
#pragma unroll
                for (int n = 0; n < 2; ++n) gv[bj][n] = *(const f32x4*)(gn + 32 * bj + 8 * fq + 4 * n);
#pragma unroll
            for (int ai = 0; ai < 2; ++ai)
#pragma unroll
                for (int m = 0; m < 4; ++m) {
                    const int row = row0 + ai * HALF + m * 16;
                    float ss = 0.f;
#pragma unroll
                    for (int bj = 0; bj < 2; ++bj)
#pragma unroll
                        for (int n = 0; n < 2; ++n) { const f32x4 x = acc[ai][bj][m][n]; ss += (x[0] * x[0] + x[1] * x[1]) + (x[2] * x[2] + x[3] * x[3]); }
                    ss += __shfl_xor(ss, 16); ss += __shfl_xor(ss, 32);
                    const float rinv = __builtin_amdgcn_rsqf(ss * (1.f / 64.f) + EPS);
#pragma unroll
                    for (int bj = 0; bj < 2; ++bj) {
                        const f32x4 y0 = acc[ai][bj][m][0] * rinv * gv[bj][0], y1 = acc[ai][bj][m][1] * rinv * gv[bj][1];
                        const int col = head * 64 + 32 * bj + 8 * fq;
                        *(u32x4*)(O + (size_t)row * 512 + col) = pack8(y0, y1);
                        if (wnew) { float* p = newk + ((size_t)(u.pm * 2 + layer) * 256 + (row - u.pm * BM)) * 512 + col; *(f32x4*)p = y0; *(f32x4*)(p + 4) = y1; }
                    }
                    __builtin_amdgcn_sched_barrier(0);
                }
        }
    }
};

struct EpiGates {
    static constexpr bool PERM = true;
    bf16_t* GS;
    __device__ __forceinline__ void operator()(const Acc& acc, const Unit& u, int wr, int wc, int fr, int fq) const {
        const int gi = u.pn >> 2; const int bi = gi == 0 ? 2 : gi - 1; bf16_t* O = GS + (size_t)bi * GS_STRIDE;
        const int row0 = u.pm * BM + wr * 64 + fr, col0 = (u.pn & 3) * BM + wc * 32 + 8 * fq;
#pragma unroll
        for (int ai = 0; ai < 2; ++ai)
#pragma unroll
            for (int m = 0; m < 4; ++m)
#pragma unroll
                for (int bj = 0; bj < 2; ++bj) {
                    f32x4 h0, h1;
#pragma unroll
                    for (int j = 0; j < 4; ++j) { h0[j] = sigmoidf_(acc[ai][bj][m][0][j]); h1[j] = sigmoidf_(acc[ai][bj][m][1][j]); }
                    *(u32x4*)(O + (size_t)(row0 + ai * HALF + m * 16) * DM + col0 + bj * HALF) = pack8(h0, h1);
                    __builtin_amdgcn_sched_barrier(0);
                }
    }
};

struct EpiM {
    static constexpr bool PERM = true;
    const bf16_t* GS; bf16_t* Mo;
    __device__ __forceinline__ void operator()(const Acc& acc, const Unit& u, int wr, int wc, int fr, int fq) const {
        const bf16_t* Gs = GS + (size_t)u.seg * GS_STRIDE;
        const int row0 = u.pm * BM + wr * 64 + fr, col0 = u.pn * BM + wc * 32 + 8 * fq;
#pragma unroll
        for (int ai = 0; ai < 2; ++ai) {
            u32x4 gw[4][2], mw[4][2];
#pragma unroll
            for (int m = 0; m < 4; ++m)
#pragma unroll
                for (int bj = 0; bj < 2; ++bj) {
                    const size_t off = (size_t)(row0 + ai * HALF + m * 16) * DM + col0 + bj * HALF;
                    gw[m][bj] = *(const u32x4*)(Gs + off);
                    mw[m][bj] = (u32x4){0u, 0u, 0u, 0u};
                    if (u.seg != 0) mw[m][bj] = *(const u32x4*)(Mo + off);
                }
            __builtin_amdgcn_sched_barrier(0);
#pragma unroll
            for (int m = 0; m < 4; ++m)
#pragma unroll
                for (int bj = 0; bj < 2; ++bj) {
                    const size_t off = (size_t)(row0 + ai * HALF + m * 16) * DM + col0 + bj * HALF;
                    const u32x4 g4 = gw[m][bj], m4 = mw[m][bj];
                    f32x4 h0, h1;
                    h0[0] = bflo(g4.x) * acc[ai][bj][m][0][0] + bflo(m4.x); h0[1] = bfhi(g4.x) * acc[ai][bj][m][0][1] + bfhi(m4.x);
                    h0[2] = bflo(g4.y) * acc[ai][bj][m][0][2] + bflo(m4.y); h0[3] = bfhi(g4.y) * acc[ai][bj][m][0][3] + bfhi(m4.y);
                    h1[0] = bflo(g4.z) * acc[ai][bj][m][1][0] + bflo(m4.z); h1[1] = bfhi(g4.z) * acc[ai][bj][m][1][1] + bfhi(m4.z);
                    h1[2] = bflo(g4.w) * acc[ai][bj][m][1][2] + bflo(m4.w); h1[3] = bfhi(g4.w) * acc[ai][bj][m][1][3] + bfhi(m4.w);
                    *(u32x4*)(Mo + off) = pack8(h0, h1);
                }
            __builtin_amdgcn_sched_barrier(0);
        }
    }
};
}

struct Args { const float* in[32]; };
__device__ __forceinline__ const float* inp(const Args& a, int i) { return a.in[i + opaque_zero()]; }

__device__ __forceinline__ void cvt_block(const float* W, int N, int K, int k0, int n0, bf16_t* WT, int dst_row0, float* scr, int lane) {
    const int kq = lane >> 3, n4 = (lane & 7) * 4;
    f32x4 v[8];
#pragma unroll
    for (int i = 0; i < 8; ++i) v[i] = *(const f32x4*)(W + (size_t)(k0 + kq + 8 * i) * N + n0 + n4);
#pragma unroll
    for (int i = 0; i < 8; ++i) { float* d = scr + (kq + 8 * i) * 33 + n4; d[0] = v[i][0]; d[1] = v[i][1]; d[2] = v[i][2]; d[3] = v[i][3]; }
    LDS_WAIT();
    const int c = lane & 7;
#pragma unroll
    for (int j = 0; j < 4; ++j) { const int n = (lane >> 3) + 8 * j; const float* s = scr + (8 * c) * 33 + n;
        u32x4 o; o.x = pk2(s[0 * 33], s[1 * 33]); o.y = pk2(s[2 * 33], s[3 * 33]); o.z = pk2(s[4 * 33], s[5 * 33]); o.w = pk2(s[6 * 33], s[7 * 33]);
        *(u32x4*)(WT + (size_t)(dst_row0 + n) * K + k0 + 8 * c) = o; }
    LDS_WAIT();
}
__device__ __forceinline__ int win_dst(int n) {
    if (n < 512) return 256 * (n >> 7) + (n & 127);
    if (n < 1024) { const int s = n - 512; return 256 * (s >> 7) + 128 + (s & 127); }
    if (n < 1536) return 2048 + (n - 1024);
    if (n < 2048) { const int s = n - 1536; return 1024 + 256 * (s >> 7) + (s & 127); }
    if (n < 2560) { const int s = n - 2048; return 1024 + 256 * (s >> 7) + 128 + (s & 127); }
    if (n < 3584) { const int base = n < 3072 ? 2560 : 3072; const int s = n - base, head = s >> 6, dim = s & 63;
        return base + 256 * (head >> 2) + 128 * (dim >> 5) + 32 * (head & 3) + (dim & 31); }
    return n;
}
__device__ __forceinline__ void convert_weights(const Args& a, int l, unsigned char* lds, int gw, int ngw, int wave, int lane) {
    float* scr = (float*)(lds + wave * 8448);
    unsigned char* ws = (unsigned char*)inp(a, 31);
    constexpr int I_GU = 16 * 88, I_D = 44 * 32, I_IN = 16 * 224, I_O = 8 * 32, I_M = 16 * 32;
    constexpr int NIT = 6 * I_GU + I_IN + 3 * I_O + I_M;
    static_assert(I_GU == I_D, "");
    for (int it = gw; it < NIT; it += ngw) {
        int r = it;
        if (r < 6 * I_GU) {
            const int which = r / I_GU; r -= which * I_GU;
            const int ff = which / 3, kind = which % 3;
            if (kind < 2) {
                const float* W = inp(a, (ff ? 27 : 9) + kind) + (size_t)l * DM * DFF;
                const int kb = r / 88, nb = r % 88, n0 = nb * 32;
                cvt_block(W, DFF, DM, kb * 64, n0, (bf16_t*)(ws + (ff ? W_GU2 : W_GU1)), 256 * (n0 >> 7) + 128 * kind + (n0 & 127), scr, lane);
            } else {
                const float* W = inp(a, ff ? 29 : 11) + (size_t)l * DFF * DM;
                const int kb = r / 32, nb = r % 32;
                cvt_block(W, DM, DFF, kb * 64, nb * 32, (bf16_t*)(ws + (ff ? W_D2 : W_D1)), nb * 32, scr, lane);
            }
            continue;
        }
        r -= 6 * I_GU;
        if (r < I_IN) { const int kb = r / 224, nb = r % 224; cvt_block(inp(a, 13) + (size_t)l * DM * NIN, NIN, DM, kb * 64, nb * 32, (bf16_t*)(ws + W_IN), win_dst(nb * 32), scr, lane); continue; }
        r -= I_IN;
        if (r < 3 * I_O) { const int which = r / I_O; r -= which * I_O; const int kb = r / 32, nb = r % 32;
            const float* W = inp(a, which == 0 ? 18 : (which == 1 ? 20 : 24)) + (size_t)l * 512 * DM;
            cvt_block(W, DM, 512, kb * 64, nb * 32, (bf16_t*)(ws + (which == 0 ? W_A : (which == 1 ? W_B : W_C))), nb * 32, scr, lane); continue; }
        r -= 3 * I_O;
        { const int kb = r / 32, nb = r % 32; cvt_block(inp(a, 25) + (size_t)l * DM * DM, DM, DM, kb * 64, nb * 32, (bf16_t*)(ws + W_M), nb * 32, scr, lane); }
    }
}

__device__ __forceinline__ void compute_mods(const Args& a, unsigned char* lds, int tid, int wave, int lane) {
    float* sT = (float*)lds;
    float* red = (float*)(lds + 49152);
    const float* c = inp(a, 4); const float* cctx = inp(a, 5);
    for (int k = tid; k < DM; k += NTHR) {
        sT[k * 12 + 0] = siluf_(cctx[k]);
#pragma unroll
        for (int v = 1; v < 9; ++v) sT[k * 12 + v] = siluf_(c[(v - 1) * DM + k]);
        sT[k * 12 + 9] = 0.f; sT[k * 12 + 10] = 0.f; sT[k * 12 + 11] = 0.f;
    }
    __syncthreads();
    float* mods = (float*)((unsigned char*)inp(a, 31) + WS_MODS);
    for (int unit = blockIdx.x; unit < 288; unit += gridDim.x) {
        const int l = unit / 144, cb = unit % 144, col = cb * 64 + lane;
        const float* W = inp(a, 6) + (size_t)l * DM * MODW + col;
        float acc[9];
#pragma unroll
        for (int v = 0; v < 9; ++v) acc[v] = 0.f;
#pragma unroll 32
        for (int kk = 0; kk < 128; ++kk) {
            const int k = wave * 128 + kk;
            const float w = W[(size_t)k * MODW];
            const f32x4 s0 = *(const f32x4*)(sT + k * 12), s1 = *(const f32x4*)(sT + k * 12 + 4), s2 = *(const f32x4*)(sT + k * 12 + 8);
            acc[0] += s0[0] * w; acc[1] += s0[1] * w; acc[2] += s0[2] * w; acc[3] += s0[3] * w;
            acc[4] += s1[0] * w; acc[5] += s1[1] * w; acc[6] += s1[2] * w; acc[7] += s1[3] * w; acc[8] += s2[0] * w;
        }
#pragma unroll
        for (int v = 0; v < 9; ++v) red[(wave * 9 + v) * 64 + lane] = acc[v];
        __syncthreads();
        for (int idx = tid; idx < 576; idx += NTHR) {
            const int v = idx >> 6, ln = idx & 63; float s = inp(a, 7)[(size_t)l * MODW + cb * 64 + ln];
#pragma unroll
            for (int w = 0; w < 8; ++w) s += red[(w * 9 + v) * 64 + ln];
            mods[((size_t)l * 9 + v) * MODW + cb * 64 + ln] = s;
        }
        __syncthreads();
    }
}

__device__ __forceinline__ void adaln_phase(const float* in0, const float* in1, const float* g, const float* modl, int ish, bf16_t* U, int rb, int re, int gw, int ngw, int lane) {
    static_assert(MTOK % (2 * 256 * NWAVES) == 0, "row pairs");
    for (int row0 = rb + gw; row0 < re; row0 += 2 * ngw) {
        f32x4 x[2][4];
#pragma unroll
        for (int h = 0; h < 2; ++h) { const int row = min(row0 + h * ngw, re - 1); const float* xr = (row < NCTX ? in0 : in1) + (size_t)row * DM;
#pragma unroll
            for (int j = 0; j < 4; ++j) x[h][j] = *(const f32x4*)(xr + 256 * j + 4 * lane); }
#pragma unroll
        for (int h = 0; h < 2; ++h) {
            const int row = row0 + h * ngw; if (row >= re) break;
            const int v = row < NCTX ? 0 : 1 + ((row - NCTX) >> 12);
            const float* sh = modl + (size_t)v * MODW + ish * DM; const float* sc = sh + DM;
            float ss = 0.f;
#pragma unroll
            for (int j = 0; j < 4; ++j) ss += (x[h][j][0] * x[h][j][0] + x[h][j][1] * x[h][j][1]) + (x[h][j][2] * x[h][j][2] + x[h][j][3] * x[h][j][3]);
            const float rinv = __builtin_amdgcn_rsqf(wave_sum(ss) * (1.f / DM) + EPS);
#pragma unroll
            for (int j = 0; j < 4; ++j) {
                const int c = 256 * j + 4 * lane;
                const f32x4 gg = *(const f32x4*)(g + c), s1 = *(const f32x4*)(sc + c), s0 = *(const f32x4*)(sh + c);
                const f32x4 y = x[h][j] * rinv * gg * (s1 + 1.f) + s0;
                u32x2 w; w.x = pk2(y[0], y[1]); w.y = pk2(y[2], y[3]);
                *(u32x2*)(U + (size_t)row * DM + c) = w;
            }
        }
    }
}

namespace att {
constexpr int TK = 128, PITCH = 144, KS_OFF = 0, VS_OFF = TK * PITCH, RPB_OFF = 2 * TK * PITCH, CNT_OFF = RPB_OFF + 15 * 32 * 4, HALF_BYTES = 39936;
static_assert(CNT_OFF + 64 <= HALF_BYTES, "attention LDS map");
typedef short v4i16_t __attribute__((ext_vector_type(4)));
__device__ __forceinline__ s16x4 vtr(const LAS char* p) { return __builtin_bit_cast(s16x4, __builtin_amdgcn_ds_read_tr16_b64_v4i16((LAS v4i16_t*)p)); }

struct TileSrc { const bf16_t* k; const bf16_t* v; };

template <bool LOCAL>
__device__ __forceinline__ void tile_compute(const LAS char* ldsb, const bf16x8 (&qf)[2], f32x4 (&O)[4], float& mrun, float& lrun,
                                             int hl, int kbase, int koff, int fr, int fq, int lane, const float* rpbrow, const int (&dci)[8], unsigned vmask) {
    constexpr int NMT = LOCAL ? 2 : 4;
#define ATT_KEYOFF(mt) (kbase + (LOCAL ? koff : 0) + 16 * (mt))
    f32x4 s[NMT];
#pragma unroll
    for (int mt = 0; mt < NMT; ++mt) {
        s[mt] = (f32x4){0.f, 0.f, 0.f, 0.f};
#pragma unroll
        for (int ks = 0; ks < 2; ++ks) {
            const bf16x8 kf = *(const LAS bf16x8*)(ldsb + KS_OFF + (ATT_KEYOFF(mt) + fr) * PITCH + hl * 128 + ks * 64 + fq * 16);
            s[mt] = __builtin_amdgcn_mfma_f32_16x16x32_bf16(kf, qf[ks], s[mt], 0, 0, 0);
        }
    }
    constexpr float C1 = 0.125f * 1.4426950408889634f;
    float tmax = -1e30f;
    if (LOCAL) {
#pragma unroll
        for (int mt = 0; mt < NMT; ++mt)
#pragma unroll
            for (int j = 0; j < 4; ++j) {
                float v = __builtin_fmaf(s[mt][j], C1, rpbrow[dci[mt * 4 + j]]);
                if (!((vmask >> (mt * 4 + j)) & 1u)) v = -1e30f;
                s[mt][j] = v; tmax = fmaxf(tmax, v);
            }
    } else {
#pragma unroll
        for (int mt = 0; mt < NMT; ++mt)
#pragma unroll
            for (int j = 0; j < 4; ++j) tmax = fmaxf(tmax, s[mt][j]);
        tmax *= C1;
    }
    tmax = fmaxf(tmax, __shfl_xor(tmax, 16)); tmax = fmaxf(tmax, __shfl_xor(tmax, 32));
    const float mnew = fmaxf(mrun, tmax), alpha = __builtin_amdgcn_exp2f(mrun - mnew);
    float psum = 0.f;
#pragma unroll
    for (int mt = 0; mt < NMT; ++mt)
#pragma unroll
        for (int j = 0; j < 4; ++j) { const float p = __builtin_amdgcn_exp2f(LOCAL ? s[mt][j] - mnew : __builtin_fmaf(s[mt][j], C1, -mnew)); s[mt][j] = p; psum += p; }
    lrun = lrun * alpha + psum; mrun = mnew;
#pragma unroll
    for (int dt = 0; dt < 4; ++dt) O[dt] = O[dt] * alpha;
    const int g = lane >> 4, q = (lane & 15) >> 2, p4 = lane & 3;
#pragma unroll
    for (int kk = 0; kk < NMT / 2; ++kk) {
        bf16x8 pb;
        { const u32x4 w = pg8::pack8(s[2 * kk], s[2 * kk + 1]); pb = __builtin_bit_cast(bf16x8, w); }
#pragma unroll
        for (int dt = 0; dt < 4; ++dt) {
            const LAS char* vb = ldsb + VS_OFF + hl * 128 + 32 * dt + 8 * p4;
            const s16x4 v0 = vtr(vb + (ATT_KEYOFF(2 * kk) + 4 * g + q) * PITCH);
            const s16x4 v1 = vtr(vb + (ATT_KEYOFF(2 * kk + 1) + 4 * g + q) * PITCH);
            bf16x8 vf; vf[0] = v0[0]; vf[1] = v0[1]; vf[2] = v0[2]; vf[3] = v0[3]; vf[4] = v1[0]; vf[5] = v1[1]; vf[6] = v1[2]; vf[7] = v1[3];
            O[dt] = __builtin_amdgcn_mfma_f32_16x16x32_bf16(vf, pb, O[dt], 0, 0, 0);
        }
    }
#undef ATT_KEYOFF
}

__device__ __forceinline__ void hbar(unsigned char* hl_lds, unsigned& target, int lane) {
    asm volatile("s_waitcnt lgkmcnt(0)" ::: "memory");
    target += 4u;
    volatile LAS unsigned* cnt = (volatile LAS unsigned*)(LAS unsigned char*)(hl_lds + CNT_OFF);
    if (lane == 0) (void)__hip_atomic_fetch_add((LAS unsigned*)(LAS unsigned char*)(hl_lds + CNT_OFF), 1u, __ATOMIC_RELAXED, __HIP_MEMORY_SCOPE_WORKGROUP);
    while ((int)(*cnt - target) < 0) __builtin_amdgcn_s_sleep(0);
    asm volatile("" ::: "memory");
}

template <bool LATENT>
__device__ __forceinline__ void unit(unsigned char* hlds, unsigned& btarget, bf16_t* QO, const bf16_t* Kb, const bf16_t* Vb, const bf16_t* CK, const bf16_t* CV, const float* rpb_l,
                                     int qrow0  , int keyrow0  , int head, int r  ,
                                     int ht, int J, int lane) {
    unsigned char* lds = hlds;
    const LAS char* ldsb = (const LAS char*)(LAS unsigned char*)hlds;
    const int fr = lane & 15, fq = lane >> 4;
    const int rs = LATENT ? min(max(r - 4, 0), 56) : 0;
    constexpr int NT = LATENT ? 8 : 2;
    int dci[8]; unsigned vmask = 0u; int koff = 0;
    if (LATENT) {
        const int qc = 16 * J + fr, wstart = min(max(qc - 8, 0), 48);
        koff = min(max(16 * J - 8, 0), 32);
#pragma unroll
        for (int mt = 0; mt < 2; ++mt)
#pragma unroll
            for (int j = 0; j < 4; ++j) { const int kc = koff + 16 * mt + 4 * fq + j;
                dci[mt * 4 + j] = min(max(kc - qc, -15), 15) + 15;
                if (kc >= wstart && kc < wstart + 16) vmask |= 1u << (mt * 4 + j); }
        float* tb = (float*)(lds + RPB_OFF);
        for (int i = ht; i < 15 * 32; i += 256) { const int dr = i >> 5, dc = i & 31; tb[i] = dc < 31 ? rpb_l[(head * 15 + dr) * 31 + dc] * 1.4426950408889634f : 0.f; }
    } else {
#pragma unroll
        for (int i = 0; i < 8; ++i) dci[i] = 0;
    }
    bf16x8 qf[2];
    { const bf16_t* qp = QO + (size_t)(qrow0 + 16 * J + fr) * 512 + head * 64 + 8 * fq;
      qf[0] = *(const bf16x8*)qp; qf[1] = *(const bf16x8*)(qp + 32); }
    f32x4 O[4], OB[4];
#pragma unroll
    for (int dt = 0; dt < 4; ++dt) { O[dt] = (f32x4){0.f, 0.f, 0.f, 0.f}; OB[dt] = (f32x4){0.f, 0.f, 0.f, 0.f}; }
    float mrun = -1e30f, lrun = 0.f, mrunB = -1e30f, lrunB = 0.f;
    const int key0 = ht >> 3, part = ht & 7;
    u32x4 kA[4], vA[4], kB[4], vB[4];
    auto tsrc = [&](int t) -> TileSrc {
        TileSrc s;
        if (LATENT) {
            if (t < 4) { s.k = CK + (size_t)(t * TK) * 512 + head * 64; s.v = CV + (size_t)(t * TK) * 512 + head * 64; }
            else { const size_t ro = (size_t)(keyrow0 + (rs + 2 * (t - 4)) * 64) * 512 + head * 64; s.k = Kb + ro; s.v = Vb + ro; }
        } else { const size_t ro = (size_t)(keyrow0 + t * TK) * 512 + head * 64; s.k = Kb + ro; s.v = Vb + ro; }
        return s;
    };
#define ATT_GLOAD(KR, VR, t) do { const TileSrc s_ = tsrc(t); _Pragma("unroll") for (int i = 0; i < 4; ++i) { const size_t o = (size_t)(key0 + 32 * i) * 512 + part * 8; \
        KR[i] = *(const u32x4*)(s_.k + o); VR[i] = *(const u32x4*)(s_.v + o); } } while (0)
#define ATT_BAR() hbar(hlds, btarget, lane)
#define ATT_LSTORE(KR, VR) do { _Pragma("unroll") for (int i = 0; i < 4; ++i) { const int lo = (key0 + 32 * i) * PITCH + part * 16; \
        *(u32x4*)(lds + KS_OFF + lo) = KR[i]; *(u32x4*)(lds + VS_OFF + lo) = VR[i]; } } while (0)
#define ATT_COMPUTE(t) do { if (LATENT && (t) >= 4) { const int dr = (rs + 2 * ((t) - 4)) - r + 7; \
            const float* rpbrow = (const float*)(lds + RPB_OFF) + dr * 32; \
            tile_compute<true>(ldsb, qf, O, mrun, lrun, 0, 0, koff, fr, fq, lane, rpbrow, dci, vmask); \
            tile_compute<true>(ldsb, qf, OB, mrunB, lrunB, 0, 64, koff, fr, fq, lane, rpbrow + 32, dci, vmask); \
        } else { tile_compute<false>(ldsb, qf, O, mrun, lrun, 0, 0, 0, fr, fq, lane, nullptr, dci, 0u); \
                 tile_compute<false>(ldsb, qf, OB, mrunB, lrunB, 0, 64, 0, fr, fq, lane, nullptr, dci, 0u); } } while (0)
    ATT_GLOAD(kA, vA, 0); ATT_GLOAD(kB, vB, 1);
    for (int t = 0; t < NT; t += 2) {
        ATT_BAR();
        ATT_LSTORE(kA, vA);
        ATT_BAR();
        if (t + 2 < NT) ATT_GLOAD(kA, vA, t + 2);
        ATT_COMPUTE(t);
        ATT_BAR();
        ATT_LSTORE(kB, vB);
        ATT_BAR();
        if (t + 3 < NT) ATT_GLOAD(kB, vB, t + 3);
        ATT_COMPUTE(t + 1);
    }
#undef ATT_GLOAD
#undef ATT_BAR
#undef ATT_LSTORE
#undef ATT_COMPUTE
    { const float mm = fmaxf(mrun, mrunB), aA = __builtin_amdgcn_exp2f(mrun - mm), aB = __builtin_amdgcn_exp2f(mrunB - mm);
      lrun = lrun * aA + lrunB * aB;
#pragma unroll
      for (int dt = 0; dt < 4; ++dt) O[dt] = O[dt] * aA + OB[dt] * aB; }
    lrun += __shfl_xor(lrun, 16); lrun += __shfl_xor(lrun, 32);
    const float linv = 1.f / lrun;
    bf16_t* op = QO + (size_t)(qrow0 + 16 * J + fr) * 512 + head * 64 + 4 * fq;
#pragma unroll
    for (int dt = 0; dt < 4; ++dt) { u32x2 w; w.x = cvt_pk_bf16(O[dt][0] * linv, O[dt][1] * linv); w.y = cvt_pk_bf16(O[dt][2] * linv, O[dt][3] * linv); *(u32x2*)(op + 16 * dt) = w; }
    hbar(hlds, btarget, lane);
}
}

__device__ __forceinline__ void conva_unit(unsigned char* lds, const bf16_t* GLU, bf16_t* AOUT, const float* cw, const float* cb, const float* lg, const float* lb,
                                           int rowbase, int len, int t0, int tid, int wave, int lane) {
    bf16_t* in_s = (bf16_t*)lds;
    float* hs = (float*)(lds + 62 * 512 * 2);
    for (int idx = tid; idx < 62 * 64; idx += NTHR) {
        const int i = idx >> 6, ch = idx & 63, p = t0 - 15 + i;
        u32x4 v = (u32x4){0u, 0u, 0u, 0u};
        if (p >= 0 && p < len) v = *(const u32x4*)(GLU + (size_t)(rowbase + p) * 512 + ch * 8);
        *(u32x4*)(in_s + i * 512 + ch * 8) = v;
    }
    float w[31];
#pragma unroll
    for (int j = 0; j < 31; ++j) w[j] = cw[j * 512 + tid];
    const float bias = cb[tid];
    __syncthreads();
    float col[62];
#pragma unroll
    for (int i = 0; i < 62; ++i) col[i] = __uint_as_float((unsigned)in_s[i * 512 + tid] << 16);
#pragma unroll
    for (int tt = 0; tt < 32; ++tt) {
        float acc = bias;
#pragma unroll
        for (int j = 0; j < 31; ++j) acc += col[tt + j] * w[j];
        hs[tt * 512 + tid] = acc;
    }
    __syncthreads();
#pragma unroll
    for (int q = 0; q < 4; ++q) {
        const int tt = wave * 4 + q;
        const f32x4 a = *(const f32x4*)(hs + tt * 512 + lane * 8), b = *(const f32x4*)(hs + tt * 512 + lane * 8 + 4);
        const float mean = wave_sum((a[0] + a[1]) + (a[2] + a[3]) + (b[0] + b[1]) + (b[2] + b[3])) * (1.f / 512.f);
        const f32x4 da = a - mean, db = b - mean;
        const float var = wave_sum((da[0] * da[0] + da[1] * da[1]) + (da[2] * da[2] + da[3] * da[3]) + (db[0] * db[0] + db[1] * db[1]) + (db[2] * db[2] + db[3] * db[3])) * (1.f / 512.f);
        const float rstd = __builtin_amdgcn_rsqf(var + EPS);
        const f32x4 g0 = *(const f32x4*)(lg + lane * 8), g1 = *(const f32x4*)(lg + lane * 8 + 4), b0 = *(const f32x4*)(lb + lane * 8), b1 = *(const f32x4*)(lb + lane * 8 + 4);
        f32x4 y0 = da * rstd * g0 + b0, y1 = db * rstd * g1 + b1;
#pragma unroll
        for (int j = 0; j < 4; ++j) { y0[j] = siluf_(y0[j]); y1[j] = siluf_(y1[j]); }
        *(u32x4*)(AOUT + (size_t)(rowbase + t0 + tt) * 512 + lane * 8) = pg8::pack8(y0, y1);
    }
    __syncthreads();
}

__device__ __forceinline__ f32x4 cb_lo(u32x4 v) { return (f32x4){bflo(v.x), bfhi(v.x), bflo(v.y), bfhi(v.y)}; }
__device__ __forceinline__ f32x4 cb_hi(u32x4 v) { return (f32x4){bflo(v.z), bfhi(v.z), bflo(v.w), bfhi(v.w)}; }
__device__ __forceinline__ void convb_phase(bf16_t* BG, const bf16_t* CH, const float* w3, int gtid, int nthreads) {
    const u32x4 z = (u32x4){0u, 0u, 0u, 0u};
    for (int idx = gtid; idx < (MTOK / 2) * 64; idx += nthreads) {
        const int row = (idx >> 6) * 2, ch = idx & 63;
        int pos, len; if (row < NCTX) { pos = row & 255; len = 256; } else { pos = (row - NCTX) & 4095; len = 4096; }
        const bf16_t* cp = CH + (size_t)row * 512 + ch * 8; bf16_t* bp = BG + (size_t)row * 512 + ch * 8;
        const u32x4 c1 = *(const u32x4*)cp, c2 = *(const u32x4*)(cp + 512);
        const u32x4 c0 = pos > 0 ? *(const u32x4*)(cp - 512) : z;
        const u32x4 c3 = pos + 2 < len ? *(const u32x4*)(cp + 1024) : z;
        const u32x4 b0 = *(const u32x4*)bp, b1 = *(const u32x4*)(bp + 512);
        f32x4 wa[3], wb[3];
#pragma unroll
        for (int j = 0; j < 3; ++j) { wa[j] = *(const f32x4*)(w3 + j * 512 + ch * 8); wb[j] = *(const f32x4*)(w3 + j * 512 + ch * 8 + 4); }
        const f32x4 y0a = cb_lo(b0) * (cb_lo(c0) * wa[0] + cb_lo(c1) * wa[1] + cb_lo(c2) * wa[2]), y0b = cb_hi(b0) * (cb_hi(c0) * wb[0] + cb_hi(c1) * wb[1] + cb_hi(c2) * wb[2]);
        const f32x4 y1a = cb_lo(b1) * (cb_lo(c1) * wa[0] + cb_lo(c2) * wa[1] + cb_lo(c3) * wa[2]), y1b = cb_hi(b1) * (cb_hi(c1) * wb[0] + cb_hi(c2) * wb[1] + cb_hi(c3) * wb[2]);
        *(u32x4*)bp = pg8::pack8(y0a, y0b); *(u32x4*)(bp + 512) = pg8::pack8(y1a, y1b);
    }
}

#define XB_TMO      128
#define XB_XCNT(j)  (256  + 64 * (j))
#define XB_XSUB(j)  (1280 + 64 * (j))
#define XB_XGEN(j)  (2304 + 64 * (j))
#define XB_TOP      3328
#define XB_TOPGEN   3392
#define XCD_BAR_WORDS 3456
#define XB_SPIN_CAP (1u << 18)

__device__ __forceinline__ unsigned xb_ld(unsigned* p)              { return __hip_atomic_load(p, __ATOMIC_RELAXED, __HIP_MEMORY_SCOPE_AGENT); }
__device__ __forceinline__ unsigned xb_add(unsigned* p, unsigned v) { return __hip_atomic_fetch_add(p, v, __ATOMIC_RELAXED, __HIP_MEMORY_SCOPE_AGENT); }
__device__ __forceinline__ unsigned xb_xcc_id() { return (unsigned)__builtin_amdgcn_s_getreg((3 << 11) | 20) & 0xFu; }
#define XB_SPIN(cond, bar) do { unsigned _sp = 0; while (cond) { __builtin_amdgcn_s_sleep(1); \
    if ((++_sp & 255u) == 0u) { if (xb_ld(&(bar)[XB_TMO])) break; if (_sp > XB_SPIN_CAP) { atomicAdd(&(bar)[XB_TMO], 1u); break; } } } } while (0)

struct XcdBarrier {
    unsigned* bar; unsigned x;
    volatile LAS unsigned* st;
};

__device__ __forceinline__ XcdBarrier xcd_barrier_post(unsigned* bar, volatile LAS unsigned* st) {
    XcdBarrier b; b.bar = bar; b.x = xb_xcc_id(); b.st = st;
    if (threadIdx.x == 0) (void)xb_add(&bar[XB_XCNT(b.x)], 1u);
    return b;
}
__device__ __forceinline__ void xcd_barrier_complete(unsigned* bar, unsigned x, unsigned& nloc, unsigned& nx) {
    const unsigned G = gridDim.x * gridDim.y * gridDim.z;
    unsigned sum, cnt, mine, sp = 0u;
    for (;;) {
        sum = 0u; cnt = 0u; mine = 0u;
#pragma unroll
        for (unsigned j = 0; j < 16; ++j) { const unsigned c = xb_ld(&bar[XB_XCNT(j)]); sum += c; cnt += (c > 0u) ? 1u : 0u; mine = (j == x) ? c : mine; }
        if (sum == G) break;
        __builtin_amdgcn_s_sleep(1);
        if ((++sp & 255u) == 0u) { if (xb_ld(&bar[XB_TMO])) break; if (sp > XB_SPIN_CAP) { atomicAdd(&bar[XB_TMO], 1u); break; } }
    }
    nloc = mine > 0u ? mine : 1u; nx = cnt > 0u ? cnt : 1u;
}

__device__ __forceinline__ void xcd_barrier(const XcdBarrier& b) {
    asm volatile("s_waitcnt vmcnt(0)" ::: "memory");
    __syncthreads();
    if (threadIdx.x == 0) {
        unsigned* bar = b.bar;
        __builtin_amdgcn_s_waitcnt(0);
        unsigned nloc = b.st[0], nx = b.st[1];
        if (nloc == 0u) { xcd_barrier_complete(bar, b.x, nloc, nx); b.st[0] = nloc; b.st[1] = nx; }
        const unsigned old = xb_add(&bar[XB_XSUB(b.x)], 1u);
        const unsigned gen = old / nloc;
        if (old + 1u == (gen + 1u) * nloc) {
            __builtin_amdgcn_fence(__ATOMIC_RELEASE, "agent");
            asm volatile("s_waitcnt vmcnt(0)" ::: "memory");
            const unsigned og = xb_add(&bar[XB_TOP], 1u);
            const unsigned tg = og / nx;
            if (og + 1u == (tg + 1u) * nx) xb_add(&bar[XB_TOPGEN], 1u);
            else XB_SPIN(xb_ld(&bar[XB_TOPGEN]) == tg, bar);
            __builtin_amdgcn_fence(__ATOMIC_ACQUIRE, "agent");
            xb_add(&bar[XB_XGEN(b.x)], 1u);
            asm volatile("s_waitcnt vmcnt(0)" ::: "memory");
        } else {
            XB_SPIN(xb_ld(&bar[XB_XGEN(b.x)]) == gen, bar);
            __builtin_amdgcn_fence(__ATOMIC_ACQUIRE, "agent");
            asm volatile("s_waitcnt vmcnt(0)" ::: "memory");
        }
    }
    __syncthreads();
}


constexpr int EARLY_ROWS = 128 * 256;
__device__ __forceinline__ bool tail_ok(int G) { return ((MTOK / 256 * 4) % G) * 2 == G && ((G / 2) % 4) == 0 && (MTOK / 256 - (G / 2) / 4) * 256 == EARLY_ROWS; }
__device__ __forceinline__ void handoff_signal(unsigned* ctr) {
    asm volatile("s_waitcnt vmcnt(0)" ::: "memory"); __syncthreads();
    if (threadIdx.x == 0) { __builtin_amdgcn_fence(__ATOMIC_RELEASE, "agent"); asm volatile("s_waitcnt vmcnt(0)" ::: "memory");
        (void)__hip_atomic_fetch_add(ctr, 1u, __ATOMIC_RELAXED, __HIP_MEMORY_SCOPE_AGENT); }
}
__device__ __forceinline__ void handoff_wait(unsigned* ctr, unsigned want) {
    if (threadIdx.x == 0) { unsigned sp = 0;
        while (__hip_atomic_load(ctr, __ATOMIC_RELAXED, __HIP_MEMORY_SCOPE_AGENT) < want && ++sp < (1u << 22)) __builtin_amdgcn_s_sleep(8);
        __builtin_amdgcn_fence(__ATOMIC_ACQUIRE, "agent"); asm volatile("s_waitcnt vmcnt(0)" ::: "memory"); }
    __syncthreads();
}

#ifndef PHASE_MASK
#define PHASE_MASK 0xFFFFF
#endif
#define PH_ON(n) ((PHASE_MASK >> (n)) & 1)
#ifndef LAST_PHASE
#define LAST_PHASE 99
#endif
#define PHX(n) if (l * 12 + (n) <= LAST_PHASE)

__global__ void __launch_bounds__(NTHR, 2) fwd_megakernel(Args a) {
    extern __shared__ __attribute__((aligned(16))) unsigned char lds[];
    cg::grid_group grid = cg::this_grid();
    const int G = gridDim.x, bx = blockIdx.x;
    PG8_LAS unsigned char* ldsg = (PG8_LAS unsigned char*)lds;
    grid.sync();
    volatile LAS unsigned* bst = (volatile LAS unsigned*)((LAS unsigned char*)lds + LDS_BYTES - 64);
    if (threadIdx.x < 16) bst[threadIdx.x] = 0u;
    __syncthreads();
    (void)xcd_barrier_post((unsigned*)inp(a, 31), bst);
#define GSYNC() do { XcdBarrier b_; b_.bar = (unsigned*)inp(a, 31); b_.x = xb_xcc_id(); b_.st = (volatile LAS unsigned*)((LAS unsigned char*)lds + LDS_BYTES - 64); xcd_barrier(b_); } while (0)
#define TIDS const int tid = threadIdx.x + opaque_vzero(), lane = tid & 63, wave = __builtin_amdgcn_readfirstlane(tid >> 6); \
             const int gw = bx * NWAVES + wave, ngw = G * NWAVES, gtid = bx * NTHR + tid, nthreads = G * NTHR; (void)gw; (void)ngw; (void)gtid; (void)nthreads; (void)lane;
#define BASES const int z_ = opaque_zero(); unsigned char* ws = (unsigned char*)inp(a, 31); float* out = (float*)inp(a, 30); const int lp = l + z_; const int bxp = bx + z_, Gp = G + z_; (void)bxp; (void)Gp; \
              const float* modl = (const float*)(ws + WS_MODS) + (size_t)lp * 9 * MODW; (void)modl; (void)out;

    {
        TIDS
#if PH_ON(0)
        compute_mods(a, lds, tid, wave, lane);
#endif
        unsigned char* ws = (unsigned char*)inp(a, 31);
        bf16_t* CK = (bf16_t*)(ws + WS_CK); bf16_t* CV = (bf16_t*)(ws + WS_CV);
        for (int i = gtid; i < 2 * 524288; i += nthreads) {
            const int which = i >= 524288; const int j = which ? i - 524288 : i;
            const float* src = inp(a, which ? 3 : 2) + (size_t)j * 8; bf16_t* dst = (which ? CV : CK) + (size_t)j * 8;
            const f32x4 x0 = *(const f32x4*)src, x1 = *(const f32x4*)(src + 4);
            u32x4 w; w.x = pk2(x0[0], x0[1]); w.y = pk2(x0[2], x0[3]); w.z = pk2(x1[0], x1[1]); w.w = pk2(x1[2], x1[3]);
            *(u32x4*)dst = w;
        }
    }
    GSYNC();

    for (int l = 0; l < 2; ++l) {
        PHX(1) {
            TIDS BASES
#if PH_ON(1)
            convert_weights(a, lp, lds, gw, ngw, wave, lane);
#endif
#if PH_ON(2)
            const float* xin0 = lp == 0 ? inp(a, 0) : out;
            const float* xin1 = lp == 0 ? inp(a, 1) - (size_t)NCTX * DM : out;
            adaln_phase(xin0, xin1, inp(a, 8) + lp * DM, modl, 0, (bf16_t*)(ws + WS_U), (lp != 0 && tail_ok(Gp)) ? EARLY_ROWS : 0, MTOK, gw, ngw, lane);
#endif
        }
        GSYNC();
#if PH_ON(3)
        PHX(2) { BASES
          pg8::Gemm g{(const bf16_t*)(ws + WS_U), (const bf16_t*)(ws + W_GU1), 0, 0, MTOK, 2 * DFF, DM}; pg8::Order S; S.init(MTOK, 2 * DFF, Gp, bxp, 1);
          pg8::EpiSwiGLU E{(bf16_t*)(ws + WS_H)}; pg8::gemm_phase<pg8::EpiSwiGLU, true, true>(ldsg, g, S, E); }
#endif
        GSYNC();
#if PH_ON(4)
        PHX(3) { BASES
          const float* xin0 = lp == 0 ? inp(a, 0) : out;
          const float* xin1 = lp == 0 ? inp(a, 1) - (size_t)NCTX * DM : out;
          pg8::Gemm g{(const bf16_t*)(ws + WS_H), (const bf16_t*)(ws + W_D1), 0, 0, MTOK, DM, DFF}; pg8::Order S; S.init(MTOK, DM, Gp, bxp, 1);
          pg8::EpiResid E{xin0, xin1, out, modl + 2 * DM, 0.5f};
          unsigned* hctr = (unsigned*)ws + 3600 + 64 * (lp * 2);
#pragma nounroll
          for (int pass = 0; pass < 2; ++pass) {
              S.window(pass * 2, pass ? (1 << 30) : 2, 1);
              pg8::gemm_phase<pg8::EpiResid, true, true>(ldsg, g, S, E);
              if (pass == 0) handoff_signal(hctr);
          }
          if (S.tail && bxp >= Gp / 2) {
              TIDS
              handoff_wait(hctr, (unsigned)Gp);
              adaln_phase(out, out, inp(a, 12) + lp * DM, modl, 3, (bf16_t*)(ws + WS_U), 0, EARLY_ROWS, (bxp - Gp / 2) * NWAVES + wave, (Gp / 2) * NWAVES, lane);
          } }
#endif
        GSYNC();
#if PH_ON(14)
        PHX(4) { TIDS BASES
          adaln_phase(out, out, inp(a, 12) + lp * DM, modl, 3, (bf16_t*)(ws + WS_U), tail_ok(Gp) ? EARLY_ROWS : 0, MTOK, gw, ngw, lane); }
#endif
        GSYNC();
#if PH_ON(5)
        PHX(5) { BASES
          float* newk = out + (size_t)MTOK * DM; float* newv = newk + (size_t)32 * 2 * 256 * 512;
          pg8::Gemm g{(const bf16_t*)(ws + WS_U), (const bf16_t*)(ws + W_IN), 0, 0, MTOK, 4096, DM}; pg8::Order S; S.init(MTOK, 4096, Gp, bxp, 1);
          pg8::EpiWin E{(bf16_t*)(ws + WS_GLU), (bf16_t*)(ws + WS_CH), (bf16_t*)(ws + WS_BG), (bf16_t*)(ws + WS_Q), (bf16_t*)(ws + WS_K), (bf16_t*)(ws + WS_V),
                        inp(a, 21) + lp * 64, inp(a, 22) + lp * 64, newk, newv, lp};
          pg8::gemm_phase<pg8::EpiWin, true, true>(ldsg, g, S, E); }
#endif
        GSYNC();
        PHX(6) {
            TIDS BASES
            bf16_t* Q = (bf16_t*)(ws + WS_Q); const bf16_t* Kb = (const bf16_t*)(ws + WS_K); const bf16_t* Vb = (const bf16_t*)(ws + WS_V);
#if PH_ON(11)
            {
            const bf16_t* CK = (const bf16_t*)(ws + WS_CK); const bf16_t* CV = (const bf16_t*)(ws + WS_CV);
            const float* rpb_l = inp(a, 23) + (size_t)lp * 8 * 15 * 31;
            {
                const int half = wave >> 2, ht = tid & 255, J = wave & 3;
                unsigned char* hlds = lds + half * att::HALF_BYTES;
                if (ht == 0) *(volatile LAS unsigned*)(LAS unsigned char*)(hlds + att::CNT_OFF) = 0u;
                __syncthreads();
                unsigned btarget = 0u;
                const int hw = bxp * 2 + half, nhw = Gp * 2;
                if (Gp == 256) {
                    const int xcd = bxp & 7, w = (bxp >> 3) * 2 + half;
                    for (int j = 0; j < 8; ++j) {
                        const int idx = w + 64 * j, b = xcd, head = idx >> 6, r = idx & 63;
                        const size_t co = (size_t)((b * 2 + lp) * 512) * 512;
                        att::unit<true>(hlds, btarget, Q, Kb, Vb, CK + co, CV + co, rpb_l, NCTX + b * 4096 + r * 64, NCTX + b * 4096, head, r, ht, J, lane);
                    }
                    for (int j = 0; j < 2; ++j) {
                        const int idx = w + 64 * j, b = xcd * 4 + (idx >> 5), head = (idx >> 2) & 7, qb = idx & 3;
                        att::unit<false>(hlds, btarget, Q, Kb, Vb, nullptr, nullptr, nullptr, b * 256 + qb * 64, b * 256, head, 0, ht, J, lane);
                    }
                } else {
                for (int u = hw; u < 4096; u += nhw) {
                    const int b = u >> 9, head = (u >> 6) & 7, r = u & 63;
                    const size_t co = (size_t)((b * 2 + lp) * 512) * 512;
                    att::unit<true>(hlds, btarget, Q, Kb, Vb, CK + co, CV + co, rpb_l, NCTX + b * 4096 + r * 64, NCTX + b * 4096, head, r, ht, J, lane);
                }
                for (int u = hw; u < 1024; u += nhw) {
                    const int b = u >> 5, head = (u >> 2) & 7, qb = u & 3;
                    att::unit<false>(hlds, btarget, Q, Kb, Vb, nullptr, nullptr, nullptr, b * 256 + qb * 64, b * 256, head, 0, ht, J, lane);
                }
                }
                __syncthreads();
            }
            }
#endif
#if PH_ON(12)
            {
            const float* cw = inp(a, 14) + (size_t)lp * 31 * 512; const float* cb = inp(a, 15) + lp * 512; const float* lg = inp(a, 16) + lp * 512; const float* lb = inp(a, 17) + lp * 512;
            for (int u = bxp; u < 1280; u += Gp) {
                int rowbase, len, t0;
                if (u < 256) { rowbase = (u >> 3) * 256; len = 256; t0 = (u & 7) * 32; }
                else { const int v = u - 256; rowbase = NCTX + (v >> 7) * 4096; len = 4096; t0 = (v & 127) * 32; }
                conva_unit(lds, (const bf16_t*)(ws + WS_GLU), (bf16_t*)(ws + WS_AOUT), cw, cb, lg, lb, rowbase, len, t0, tid, wave, lane);
            }
            }
#endif
#if PH_ON(13)
            convb_phase((bf16_t*)(ws + WS_BG), (const bf16_t*)(ws + WS_CH), inp(a, 19) + (size_t)lp * 3 * 512, gtid, nthreads);
#endif
        }
        GSYNC();
#if PH_ON(6)
        PHX(7) { BASES
          const bf16_t* Wg = (const bf16_t*)(ws + W_IN) + (size_t)4096 * DM;
          pg8::Gemm g{(const bf16_t*)(ws + WS_U), Wg, 0, 0, MTOK, 3072, DM}; pg8::Order S; S.init(MTOK, 3072, Gp, bxp, 1);
          pg8::EpiGates E{(bf16_t*)(ws + WS_GS)}; pg8::gemm_phase<pg8::EpiGates, true, true>(ldsg, g, S, E); }
#endif
        GSYNC();
#if PH_ON(7)
        PHX(8) { BASES
          pg8::Gemm g{(const bf16_t*)(ws + WS_BG), (const bf16_t*)(ws + W_B), BR_STRIDE, WO_STRIDE, MTOK, DM, 512}; pg8::Order S; S.init(MTOK, DM, Gp, bxp, 3);
          pg8::EpiM E{(const bf16_t*)(ws + WS_GS), (bf16_t*)(ws + WS_U)}; pg8::gemm_phase<pg8::EpiM, true, true>(ldsg, g, S, E); }
#endif
        GSYNC();
#if PH_ON(8)
        PHX(9) { BASES
          pg8::Gemm g{(const bf16_t*)(ws + WS_U), (const bf16_t*)(ws + W_M), 0, 0, MTOK, DM, DM}; pg8::Order S; S.init(MTOK, DM, Gp, bxp, 1);
          pg8::EpiResid E{out, out, out, modl + 5 * DM, 1.0f}; pg8::gemm_phase<pg8::EpiResid, true, true>(ldsg, g, S, E); }
#endif
        GSYNC();
#if PH_ON(14)
        PHX(10) { TIDS BASES
          adaln_phase(out, out, inp(a, 26) + lp * DM, modl, 6, (bf16_t*)(ws + WS_U), 0, MTOK, gw, ngw, lane); }
#endif
        GSYNC();
#if PH_ON(9)
        PHX(11) { BASES
          pg8::Gemm g{(const bf16_t*)(ws + WS_U), (const bf16_t*)(ws + W_GU2), 0, 0, MTOK, 2 * DFF, DM}; pg8::Order S; S.init(MTOK, 2 * DFF, Gp, bxp, 1);
          pg8::EpiSwiGLU E{(bf16_t*)(ws + WS_H)}; pg8::gemm_phase<pg8::EpiSwiGLU, true, true>(ldsg, g, S, E); }
#endif
        GSYNC();
#if PH_ON(10)
        PHX(12) { BASES
          pg8::Gemm g{(const bf16_t*)(ws + WS_H), (const bf16_t*)(ws + W_D2), 0, 0, MTOK, DM, DFF}; pg8::Order S; S.init(MTOK, DM, Gp, bxp, 1);
          pg8::EpiResid E{out, out, out, modl + 8 * DM, 0.5f};
          unsigned* hctr = (unsigned*)ws + 3600 + 64 * (lp * 2 + 1);
          const int npass = lp == 0 ? 2 : 1;
#pragma nounroll
          for (int pass = 0; pass < npass; ++pass) {
              S.window(pass * 2, (npass == 2 && pass == 0) ? 2 : (1 << 30), npass == 2);
              pg8::gemm_phase<pg8::EpiResid, true, true>(ldsg, g, S, E);
              if (npass == 2 && pass == 0) handoff_signal(hctr);
          }
          if (npass == 2 && S.tail && bxp >= Gp / 2) {
              TIDS
              handoff_wait(hctr, (unsigned)Gp);
              adaln_phase(out, out, inp(a, 8) + (lp + 1) * DM, modl + 9 * MODW, 0, (bf16_t*)(ws + WS_U), 0, EARLY_ROWS, (bxp - Gp / 2) * NWAVES + wave, (Gp / 2) * NWAVES, lane);
          } }
#endif
        if (l == 0) GSYNC();
    }
}

extern "C" void kernel_launch(void* const* d_in, const int* in_sizes, int n_in, void* d_out, int out_size, void* d_ws, size_t ws_size, hipStream_t stream) {
    static int grid = 0;
    if (grid == 0) {
        if (n_in != 30 || ws_size < WS_END) { fprintf(stderr, "kernel_launch: unexpected inputs (n_in %d, ws %zu)\n", n_in, ws_size); grid = -1; return; }
        int dev = 0, cus = 0, per_cu = 0;
        hipGetDevice(&dev);
        hipDeviceGetAttribute(&cus, hipDeviceAttributeMultiprocessorCount, dev);
        hipFuncSetAttribute((const void*)fwd_megakernel, hipFuncAttributeMaxDynamicSharedMemorySize, LDS_BYTES);
        hipOccupancyMaxActiveBlocksPerMultiprocessor(&per_cu, (const void*)fwd_megakernel, NTHR, LDS_BYTES);
        if (per_cu < 1) per_cu = 1;
        (void)hipGetLastError();
        grid = cus;
        if (grid > 256) grid = 256;
    }
    if (grid < 0) return;
    Args a{};
    for (int i = 0; i < 30; ++i) a.in[i] = (const float*)d_in[i];
    a.in[30] = (const float*)d_out; a.in[31] = (const float*)d_ws;
    (void)hipMemsetAsync(d_ws, 0, 16384, stream);
    void* args[] = {&a};
    hipError_t e = hipLaunchCooperativeKernel((const void*)fwd_megakernel, dim3(grid), dim3(NTHR), args, LDS_BYTES, stream);
    if (e != hipSuccess) fprintf(stderr, "cooperative launch failed: %s (grid %d)\n", hipGetErrorString(e), grid);
}
```

```cpp
#include <hip/hip_runtime.h>
#include <hip/hip_cooperative_groups.h>
#include <cstdio>
#include <cstdint>
namespace cg = cooperative_groups;

#define LAS __attribute__((address_space(3)))
typedef unsigned short bf16_t;
typedef short bf16x8 __attribute__((ext_vector_type(8)));
typedef short s16x4 __attribute__((ext_vector_type(4)));
typedef float f32x4 __attribute__((ext_vector_type(4)));
typedef unsigned u32x4 __attribute__((ext_vector_type(4)));
typedef unsigned u32x2 __attribute__((ext_vector_type(2)));

constexpr int DM = 1024, NCTX = 8192, NLAT = 32768, MTOK = NCTX + NLAT;
constexpr int DFF = 2816, NIN = 7168, NMODV = 9, MODW = 9 * 1024;
constexpr int NWAVES = 8, NTHR = 512;
constexpr float EPS = 1e-6f;

constexpr size_t MiB = 1u << 20;
constexpr size_t WS_MODS = 1 * MiB;
constexpr size_t WS_W = 2 * MiB;
constexpr size_t W_GU1 = WS_W, W_D1 = W_GU1 + 11 * MiB, W_IN = W_D1 + 11 * MiB / 2, W_B = W_IN + 14 * MiB, W_C = W_B + MiB, W_A = W_C + MiB,
                 W_M = W_A + MiB, W_GU2 = W_M + 2 * MiB, W_D2 = W_GU2 + 11 * MiB;
constexpr size_t WS_U = 54 * MiB, WS_H = 134 * MiB;
constexpr size_t WS_BG = 134 * MiB, WS_Q = 174 * MiB, WS_AOUT = 214 * MiB, WS_GLU = 254 * MiB, WS_CH = 294 * MiB, WS_K = 334 * MiB, WS_V = 374 * MiB;
constexpr size_t WS_GS = 254 * MiB;
constexpr size_t GS_STRIDE = 80 * MiB / 2, BR_STRIDE = 40 * MiB / 2, WO_STRIDE = MiB / 2;
constexpr size_t WS_CK = 494 * MiB, WS_CV = 502 * MiB, WS_END = 510 * MiB;
static_assert(W_D2 + 11 * MiB / 2 <= WS_U, "weights fit");
constexpr int LDS_BYTES = 147456;

__device__ __forceinline__ unsigned f2bf(float f) { unsigned u = __builtin_bit_cast(unsigned, f); return (u + 0x7fffu + ((u >> 16) & 1u)) >> 16; }
__device__ __forceinline__ unsigned pk2(float lo, float hi) { return f2bf(lo) | (f2bf(hi) << 16); }
typedef float f32x2_t __attribute__((ext_vector_type(2))); typedef __bf16 bf16x2_t __attribute__((ext_vector_type(2)));
__device__ __forceinline__ unsigned cvt_pk_bf16(float lo, float hi) { f32x2_t v = {lo, hi}; bf16x2_t b = __builtin_convertvector(v, bf16x2_t); return __builtin_bit_cast(unsigned, b); }
__device__ __forceinline__ float bflo(unsigned w) { return __uint_as_float(w << 16); }
__device__ __forceinline__ float bfhi(unsigned w) { return __uint_as_float(w & 0xffff0000u); }
__device__ __forceinline__ float sigmoidf_(float x) { return __builtin_amdgcn_rcpf(1.f + __expf(-x)); }
__device__ __forceinline__ float siluf_(float x) { return x * sigmoidf_(x); }
__device__ __forceinline__ float wave_sum(float v) {
#pragma unroll
    for (int o = 1; o < 64; o <<= 1) v += __shfl_xor(v, o);
    return v;
}
__device__ __forceinline__ int opaque_zero() { int z; asm volatile("s_mov_b32 %0, 0" : "=s"(z)); return z; }
__device__ __forceinline__ int opaque_vzero() { int z; asm volatile("v_mov_b32 %0, 0" : "=v"(z)); return z; }
template <class T> __device__ __forceinline__ T* launder_ptr(T* p) { T* r; asm volatile("s_mov_b64 %0, %1" : "=s"(r) : "s"(p)); return r; }
#define LDS_WAIT() asm volatile("s_waitcnt lgkmcnt(0)" ::: "memory")

namespace pg8 {
#define PG8_LAS __attribute__((address_space(3)))
constexpr int BM = 256, BK = 64, HALF = 128, HTB = HALF * BK * 2, STAGE_BYTES = 8 * HTB, NXCD = 8, WGM = 8;
__device__ __forceinline__ int lds_byte(int r, int c) { const int st = (r >> 4) * 2 + (c >> 5), rr = r & 15, cc = c & 31, ob = rr * 64 + cc * 2; return st * 1024 + (ob ^ (((ob >> 9) & 1) << 5)); }
__device__ __forceinline__ void stage_rc(int b, int& R, int& C) { const int st = b / 1024, sb = b % 1024, swz = sb ^ (((sb >> 9) & 1) << 5); R = (st >> 1) * 16 + swz / 64; C = (st & 1) * 32 + (swz % 64) / 2; }
__device__ __forceinline__ int perm32(int rho) { const int n = rho >> 4, i = rho & 15; return 8 * (i >> 2) + 4 * n + (i & 3); }

struct Unit { int pm, pn, seg; };
struct Gemm { const bf16_t* A; const bf16_t* Bt; size_t segA, segB; int M, N, K; };

struct Order {
    int nM, nN, nwg, G, c, nseg, tail, nMf, i0, imax;
    __device__ void init(int M, int N, int G_, int c_, int nseg_) { nM = M / BM; nN = N / BM; nwg = nM * nN; G = G_; c = c_; nseg = nseg_; tail = 0; nMf = nM; i0 = 0; imax = 1 << 30; }
    __device__ void window(int i0_, int imax_, int want_tail) {
        if (want_tail && nseg == 1 && (nwg % G) * 2 == G && ((G / 2) % nN) == 0) { tail = 1; nMf = nM - (G / 2) / nN; }
        i0 = i0_; imax = imax_; }
    __device__ bool next(int i, Unit& u) const {
        i += i0; if (i >= imax) return false;
        const int tile = i / nseg, seg = i - tile * nseg;
        const int nwf = nMf * nN;
        if (tail && tile == nwf / G) { if (c >= G / 2) return false; u.pm = nMf + c / nN; u.pn = c % nN; u.seg = 0; return true; }
        const long L = (long)tile * G + c; if (L >= nwf) return false;
        int wgid = (int)L; { const int q = nwf / NXCD, r = nwf % NXCD, xcd = wgid % NXCD, off = wgid / NXCD; wgid = (xcd < r ? xcd * (q + 1) : r * (q + 1) + (xcd - r) * q) + off; }
        const int nig = WGM * nN, gid = wgid / nig, fm = gid * WGM, gsz = (nMf - fm) < WGM ? (nMf - fm) : WGM;
        u.pm = fm + ((wgid % nig) % gsz); u.pn = (wgid % nig) / gsz; u.seg = seg; return true;
    }
};

template <class Epi, bool ALIGN_EPI, bool SP2>
__device__ __forceinline__ void gemm_phase(PG8_LAS unsigned char* lds, const Gemm g, const Order& S, const Epi& E) {
    const int tid = threadIdx.x + opaque_vzero(), wid = __builtin_amdgcn_readfirstlane(tid >> 6), lane = tid & 63, wr = wid >> 2, wc = wid & 3, fr = lane & 15, fq = lane >> 4;
    const int K = g.K, nt = K / BK;
    unsigned voffA[2], voffB[2];
#pragma unroll
    for (int i = 0; i < 2; ++i) { int R, C; stage_rc(tid * 16 + i * 8192, R, C); const int Rb = Epi::PERM ? ((R & ~31) + perm32(R & 31)) : R;
        voffA[i] = (unsigned)(R * K + C) * 2u; voffB[i] = (unsigned)(Rb * K + C) * 2u; }
    const size_t kstep = (size_t)(BK * 2);
    const size_t hstep = (size_t)HALF * K * 2;
    const size_t tstep = 2 * hstep;
    const unsigned ldsw = (unsigned)wid * 1024u;
    const int aoff = lds_byte(wr * 64 + fr, fq * 8), boff = lds_byte(wc * 32 + fr, fq * 8);
#define PG8_SA(b, h) (((b) * 2 + (h)) * HTB)
#define PG8_SB(b, h) ((4 + (b) * 2 + (h)) * HTB)
#define PG8_STAGE(bufoff, gbase, voff) do { _Pragma("unroll") for (int _i = 0; _i < 2; ++_i) \
        __builtin_amdgcn_global_load_lds((const unsigned*)((const char*)(gbase) + (voff)[_i]), (PG8_LAS unsigned*)(lds + (bufoff) + ldsw + _i * 8192), 16, 0, 0); } while (0)
#define PG8_LDA(dst, b, h) do { _Pragma("unroll") for (int m = 0; m < 4; ++m) _Pragma("unroll") for (int k = 0; k < 2; ++k) dst[m][k] = *(const PG8_LAS bf16x8*)(lds + PG8_SA(b, h) + aoff + m * 2048 + k * 1024); } while (0)
#define PG8_LDB(dst, b, h) do { _Pragma("unroll") for (int n = 0; n < 2; ++n) _Pragma("unroll") for (int k = 0; k < 2; ++k) dst[n][k] = *(const PG8_LAS bf16x8*)(lds + PG8_SB(b, h) + boff + n * 2048 + k * 1024); } while (0)
#define PG8_MMA(ai, bj, At, Bt) do { __builtin_amdgcn_s_setprio(1); _Pragma("unroll") for (int m = 0; m < 4; ++m) _Pragma("unroll") for (int n = 0; n < 2; ++n) _Pragma("unroll") for (int k = 0; k < 2; ++k) \
        acc[ai][bj][m][n] = __builtin_amdgcn_mfma_f32_16x16x32_bf16(Bt[n][k], At[m][k], acc[ai][bj][m][n], 0, 0, 0); __builtin_amdgcn_s_setprio(0); } while (0)
#define PG8_WAIT_V(n) asm volatile("s_waitcnt vmcnt(" #n ")" ::: "memory")
#define PG8_WAIT_L(n) asm volatile("s_waitcnt lgkmcnt(" #n ")" ::: "memory")
#define PG8_BAR __builtin_amdgcn_s_barrier()
#define PG8_SCHED __builtin_amdgcn_sched_barrier(0)
    Unit cur, nxt; int ui = 0;
    if (!S.next(0, cur)) return;
    f32x4 acc[2][2][4][2];
#pragma unroll
    for (int a = 0; a < 2; ++a)
#pragma unroll
        for (int b = 0; b < 2; ++b)
#pragma unroll
            for (int m = 0; m < 4; ++m)
#pragma unroll
                for (int n = 0; n < 2; ++n) acc[a][b][m][n] = (f32x4){0.f, 0.f, 0.f, 0.f};
    bf16x8 At[4][2], B0[2][2], B1[2][2];
    const char* cA = (const char*)(g.A + cur.seg * g.segA) + (size_t)cur.pm * tstep; const char* cB = (const char*)(g.Bt + cur.seg * g.segB) + (size_t)cur.pn * tstep;
    if constexpr (SP2) {
        PG8_STAGE(PG8_SB(0, 0), cB, voffB); PG8_STAGE(PG8_SB(0, 1), cB + hstep, voffB); PG8_STAGE(PG8_SA(0, 0), cA, voffA); PG8_STAGE(PG8_SA(0, 1), cA + hstep, voffA);
        if (wr == 1) PG8_BAR;
        PG8_WAIT_V(2); PG8_BAR;
        PG8_STAGE(PG8_SB(1, 0), cB + kstep, voffB); PG8_STAGE(PG8_SA(1, 0), cA + kstep, voffA); PG8_STAGE(PG8_SB(1, 1), cB + hstep + kstep, voffB);
        PG8_WAIT_V(6); PG8_BAR;
    } else {
        PG8_STAGE(PG8_SB(0, 0), cB, voffB); PG8_STAGE(PG8_SA(0, 0), cA, voffA); PG8_STAGE(PG8_SB(0, 1), cB + hstep, voffB); PG8_STAGE(PG8_SA(0, 1), cA + hstep, voffA);
        if (wr == 1) PG8_BAR;
        PG8_WAIT_V(4); PG8_BAR;
        PG8_STAGE(PG8_SB(1, 0), cB + kstep, voffB); PG8_STAGE(PG8_SA(1, 0), cA + kstep, voffA); PG8_STAGE(PG8_SB(1, 1), cB + hstep + kstep, voffB);
        PG8_WAIT_V(6); PG8_BAR;
    }
    for (;;) {
        const bool has_next = S.next(ui + 1, nxt);
        const char* nA = has_next ? (const char*)(g.A + nxt.seg * g.segA) + (size_t)nxt.pm * tstep : cA; const char* nB = has_next ? (const char*)(g.Bt + nxt.seg * g.segB) + (size_t)nxt.pn * tstep : cB;
        for (int t = 0; t < nt; t += 2) {
            const bool last = (t == nt - 2);
            const char* a1 = cA + (size_t)(t + 1) * kstep;
            const char* a2 = last ? nA : cA + (size_t)(t + 2) * kstep; const char* b2 = last ? nB : cB + (size_t)(t + 2) * kstep;
            const char* a3 = a2 + kstep; const char* b3 = b2 + kstep;
            if constexpr (SP2) {
            PG8_LDB(B0, 0, 0); PG8_LDB(B1, 0, 1); PG8_SCHED; PG8_LDA(At, 0, 0); PG8_STAGE(PG8_SA(1, 1), a1 + hstep, voffA);
            PG8_WAIT_V(8); PG8_WAIT_L(0); PG8_BAR; PG8_MMA(0, 0, At, B0); PG8_MMA(0, 1, At, B1); PG8_BAR; PG8_SCHED;
            PG8_LDA(At, 0, 1); PG8_STAGE(PG8_SB(0, 0), b2, voffB); PG8_STAGE(PG8_SB(0, 1), b2 + hstep, voffB); PG8_STAGE(PG8_SA(0, 0), a2, voffA);
            PG8_WAIT_V(8); PG8_WAIT_L(0); PG8_BAR; PG8_MMA(1, 0, At, B0); PG8_MMA(1, 1, At, B1); PG8_BAR; PG8_SCHED;
            PG8_LDB(B0, 1, 0); PG8_LDB(B1, 1, 1); PG8_SCHED; PG8_LDA(At, 1, 0); PG8_STAGE(PG8_SA(0, 1), a2 + hstep, voffA);
            PG8_WAIT_V(8); PG8_WAIT_L(0); PG8_BAR; PG8_MMA(0, 0, At, B0); PG8_MMA(0, 1, At, B1); PG8_BAR; PG8_SCHED;
            PG8_LDA(At, 1, 1); PG8_STAGE(PG8_SB(1, 0), b3, voffB); PG8_STAGE(PG8_SB(1, 1), b3 + hstep, voffB); PG8_STAGE(PG8_SA(1, 0), a3, voffA);
            PG8_WAIT_V(8); PG8_WAIT_L(0); PG8_BAR; PG8_MMA(1, 0, At, B0); PG8_MMA(1, 1, At, B1); PG8_BAR; PG8_SCHED;
            } else {
            PG8_LDB(B0, 0, 0); PG8_SCHED; PG8_LDA(At, 0, 0); PG8_STAGE(PG8_SA(1, 1), a1 + hstep, voffA);
            PG8_WAIT_L(8); PG8_BAR; PG8_WAIT_L(0); PG8_MMA(0, 0, At, B0); PG8_BAR; PG8_SCHED;
            PG8_LDB(B1, 0, 1); PG8_STAGE(PG8_SB(0, 0), b2, voffB);
            PG8_BAR; PG8_WAIT_L(0); PG8_MMA(0, 1, At, B1); PG8_BAR;
            PG8_LDA(At, 0, 1); PG8_STAGE(PG8_SA(0, 0), a2, voffA);
            PG8_BAR; PG8_WAIT_L(0); PG8_MMA(1, 0, At, B0); PG8_BAR; PG8_SCHED;
            PG8_STAGE(PG8_SB(0, 1), b2 + hstep, voffB);
            PG8_WAIT_V(6); PG8_BAR; PG8_MMA(1, 1, At, B1); PG8_BAR;
            PG8_LDB(B0, 1, 0); PG8_SCHED; PG8_LDA(At, 1, 0); PG8_STAGE(PG8_SA(0, 1), a2 + hstep, voffA);
            PG8_WAIT_L(8); PG8_BAR; PG8_WAIT_L(0); PG8_MMA(0, 0, At, B0); PG8_BAR; PG8_SCHED;
            PG8_LDB(B1, 1, 1); PG8_STAGE(PG8_SB(1, 0), b3, voffB);
            PG8_BAR; PG8_WAIT_L(0); PG8_MMA(0, 1, At, B1); PG8_BAR;
            PG8_LDA(At, 1, 1); PG8_STAGE(PG8_SA(1, 0), a3, voffA);
            PG8_BAR; PG8_WAIT_L(0); PG8_MMA(1, 0, At, B0); PG8_BAR; PG8_SCHED;
            PG8_STAGE(PG8_SB(1, 1), b3 + hstep, voffB);
            PG8_WAIT_V(6); PG8_BAR; PG8_MMA(1, 1, At, B1); PG8_BAR;
            }
        }
        if constexpr (ALIGN_EPI) { if (wr == 0) PG8_BAR; }
        E(acc, cur, wr, wc, fr, fq);
        if (!has_next) break;
#pragma unroll
        for (int a = 0; a < 2; ++a)
#pragma unroll
            for (int b = 0; b < 2; ++b)
#pragma unroll
                for (int m = 0; m < 4; ++m)
#pragma unroll
                    for (int n = 0; n < 2; ++n) acc[a][b][m][n] = (f32x4){0.f, 0.f, 0.f, 0.f};
        cur = nxt; cA = nA; cB = nB; ++ui;
        if constexpr (ALIGN_EPI) { if (wr == 1) PG8_BAR; }
    }
    PG8_WAIT_V(0);
    if constexpr (!ALIGN_EPI) { if (wr == 0) PG8_BAR; }
    PG8_BAR;
#undef PG8_SA
#undef PG8_SB
#undef PG8_STAGE
#undef PG8_LDA
#undef PG8_LDB
#undef PG8_MMA
#undef PG8_WAIT_V
#undef PG8_WAIT_L
#undef PG8_BAR
#undef PG8_SCHED
}

typedef f32x4 Acc[2][2][4][2];

__device__ __forceinline__ u32x4 pack8(const f32x4 a, const f32x4 b) {
    u32x4 w; w.x = cvt_pk_bf16(a[0], a[1]); w.y = cvt_pk_bf16(a[2], a[3]); w.z = cvt_pk_bf16(b[0], b[1]); w.w = cvt_pk_bf16(b[2], b[3]); return w;
}

struct EpiSwiGLU {
    static constexpr bool PERM = true;
    bf16_t* H;
    __device__ __forceinline__ void operator()(const Acc& acc, const Unit& u, int wr, int wc, int fr, int fq) const {
        const int row0 = u.pm * BM + wr * 64 + fr, col0 = u.pn * HALF + wc * 32 + 8 * fq;
#pragma unroll
        for (int ai = 0; ai < 2; ++ai)
#pragma unroll
            for (int m = 0; m < 4; ++m) {
                bf16_t* rowp = H + (size_t)(row0 + ai * HALF + m * 16) * DFF + col0;
                f32x4 h0, h1;
#pragma unroll
                for (int j = 0; j < 4; ++j) { h0[j] = siluf_(acc[ai][0][m][0][j]) * acc[ai][1][m][0][j]; h1[j] = siluf_(acc[ai][0][m][1][j]) * acc[ai][1][m][1][j]; }
                *(u32x4*)rowp = pack8(h0, h1);
                __builtin_amdgcn_sched_barrier(0);
            }
    }
};

struct EpiResid {
    static constexpr bool PERM = false;
    const float* in0; const float* in1; float* out; const float* gate; float coef;
    __device__ __forceinline__ void operator()(const Acc& acc, const Unit& u, int wr, int wc, int fr, int fq) const {
        const int v = u.pm < 32 ? 0 : 1 + ((u.pm - 32) >> 4);
        const float* gv = gate + (size_t)v * MODW;
        const float* in = u.pm < 32 ? in0 : in1;
        const int col0 = u.pn * BM + wc * 32 + 4 * fq;
        f32x4 g[2][2];
#pragma unroll
        for (int bj = 0; bj < 2; ++bj)
#pragma unroll
            for (int n = 0; n < 2; ++n) g[bj][n] = *(const f32x4*)(gv + col0 + bj * HALF + n * 16) * coef;
#pragma unroll
        for (int ai = 0; ai < 2; ++ai) {
            f32x4 x[4][2][2];
#pragma unroll
            for (int m = 0; m < 4; ++m) {
                const size_t off = (size_t)(u.pm * BM + ai * HALF + wr * 64 + m * 16 + fr) * DM + col0;
#pragma unroll
                for (int bj = 0; bj < 2; ++bj)
#pragma unroll
                    for (int n = 0; n < 2; ++n) x[m][bj][n] = *(const f32x4*)(in + off + bj * HALF + n * 16);
            }
            __builtin_amdgcn_sched_barrier(0);
#pragma unroll
            for (int m = 0; m < 4; ++m) {
                const size_t off = (size_t)(u.pm * BM + ai * HALF + wr * 64 + m * 16 + fr) * DM + col0;
#pragma unroll
                for (int bj = 0; bj < 2; ++bj)
#pragma unroll
                    for (int n = 0; n < 2; ++n) *(f32x4*)(out + off + bj * HALF + n * 16) = x[m][bj][n] + g[bj][n] * acc[ai][bj][m][n];
            }
            __builtin_amdgcn_sched_barrier(0);
        }
    }
};

struct EpiWin {
    static constexpr bool PERM = true;
    bf16_t *GLU, *CH, *BG, *Q, *Kb, *Vb; const float *qg, *kg; float *newk, *newv; int layer;
    __device__ __forceinline__ void operator()(const Acc& acc, const Unit& u, int wr, int wc, int fr, int fq) const {
        const int row0 = u.pm * BM + wr * 64 + fr, cw = wc * 32 + 8 * fq, pn = u.pn;
        if (pn < 8) {
            bf16_t* O = (pn < 4 ? GLU : CH); const int col0 = (pn & 3) * HALF + cw;
#pragma unroll
            for (int ai = 0; ai < 2; ++ai)
#pragma unroll
                for (int m = 0; m < 4; ++m) {
                    f32x4 h0, h1;
                    if (pn < 4) {
#pragma unroll
                        for (int j = 0; j < 4; ++j) { h0[j] = acc[ai][0][m][0][j] * sigmoidf_(acc[ai][1][m][0][j]); h1[j] = acc[ai][0][m][1][j] * sigmoidf_(acc[ai][1][m][1][j]); }
                    } else { h0 = acc[ai][0][m][0] * acc[ai][1][m][0]; h1 = acc[ai][0][m][1] * acc[ai][1][m][1]; }
                    *(u32x4*)(O + (size_t)(row0 + ai * HALF + m * 16) * 512 + col0) = pack8(h0, h1);
                    __builtin_amdgcn_sched_barrier(0);
                }
        } else if (pn < 10 || pn >= 14) {
            bf16_t* O = (pn < 10 ? BG : Vb); const int colt = (pn < 10 ? pn - 8 : pn - 14) * BM + cw;
            const bool wnew = (pn >= 14) && (u.pm < 32);
#pragma unroll
            for (int ai = 0; ai < 2; ++ai)
#pragma unroll
                for (int m = 0; m < 4; ++m) {
                    const int row = row0 + ai * HALF + m * 16;
#pragma unroll
                    for (int bj = 0; bj < 2; ++bj) {
                        *(u32x4*)(O + (size_t)row * 512 + colt + bj * HALF) = pack8(acc[ai][bj][m][0], acc[ai][bj][m][1]);
                        if (wnew) { float* p = newv + ((size_t)(u.pm * 2 + layer) * 256 + (row - u.pm * BM)) * 512 + colt + bj * HALF;
                            *(f32x4*)p = acc[ai][bj][m][0]; *(f32x4*)(p + 4) = acc[ai][bj][m][1]; }
                    }
                    __builtin_amdgcn_sched_barrier(0);
                }
        } else {
            const bool isk = pn >= 12; bf16_t* O = isk ? Kb : Q; const float* gn = isk ? kg : qg;
            const int head = 4 * ((pn - 10) & 1) + wc; const bool wnew = isk && (u.pm < 32);
            f32x4 gv[2][2];
#pragma unroll
            for (int bj = 0; bj < 2; ++bj)
#pragma unroll
                for (int n = 0; n < 2; ++n) gv[bj][n] = *(const f32x4*)(gn + 32 * bj + 8 * fq + 4 * n);
#pragma unroll
            for (int ai = 0; ai < 2; ++ai)
#pragma unroll
                for (int m = 0; m < 4; ++m) {
                    const int row = row0 + ai * HALF + m * 16;
                    float ss = 0.f;
#pragma unroll
                    for (int bj = 0; bj < 2; ++bj)
#pragma unroll
                        for (int n = 0; n < 2; ++n) { const f32x4 x = acc[ai][bj][m][n]; ss += (x[0] * x[0] + x[1] * x[1]) + (x[2] * x[2] + x[3] * x[3]); }
                    ss += __shfl_xor(ss, 16); ss += __shfl_xor(ss, 32);
                    const float rinv = __builtin_amdgcn_rsqf(ss * (1.f / 64.f) + EPS);
#pragma unroll
                    for (int bj = 0; bj < 2; ++bj) {
                        const f32x4 y0 = acc[ai][bj][m][0] * rinv * gv[bj][0], y1 = acc[ai][bj][m][1] * rinv * gv[bj][1];
                        const int col = head * 64 + 32 * bj + 8 * fq;
                        *(u32x4*)(O + (size_t)row * 512 + col) = pack8(y0, y1);
                        if (wnew) { float* p = newk + ((size_t)(u.pm * 2 + layer) * 256 + (row - u.pm * BM)) * 512 + col; *(f32x4*)p = y0; *(f32x4*)(p + 4) = y1; }
                    }
                    __builtin_amdgcn_sched_barrier(0);
                }
        }
    }
};

struct EpiGates {
    static constexpr bool PERM = true;
    bf16_t* GS;
    __device__ __forceinline__ void operator()(const Acc& acc, const Unit& u, int wr, int wc, int fr, int fq) const {
        const int gi = u.pn >> 2; const int bi = gi == 0 ? 2 : gi - 1; bf16_t* O = GS + (size_t)bi * GS_STRIDE;
        const int row0 = u.pm * BM + wr * 64 + fr, col0 = (u.pn & 3) * BM + wc * 32 + 8 * fq;
#pragma unroll
        for (int ai = 0; ai < 2; ++ai)
#pragma unroll
            for (int m = 0; m < 4; ++m)
#pragma unroll
                for (int bj = 0; bj < 2; ++bj) {
                    unsigned q0 = 0u, q1 = 0u;
#pragma unroll
                    for (int j = 0; j < 4; ++j) { q0 = __builtin_amdgcn_cvt_pk_u8_f32(__builtin_rintf(sigmoidf_(acc[ai][bj][m][0][j]) * 255.f), j, q0); q1 = __builtin_amdgcn_cvt_pk_u8_f32(__builtin_rintf(sigmoidf_(acc[ai][bj][m][1][j]) * 255.f), j, q1); }
                    { u32x2 w; w.x = q0; w.y = q1; *(u32x2*)((unsigned char*)O + (size_t)(row0 + ai * HALF + m * 16) * DM + col0 + bj * HALF) = w; }
                    __builtin_amdgcn_sched_barrier(0);
                }
    }
};

struct EpiM {
    static constexpr bool PERM = true;
    const bf16_t* GS; bf16_t* Mo;
    __device__ __forceinline__ void operator()(const Acc& acc, const Unit& u, int wr, int wc, int fr, int fq) const {
        const bf16_t* Gs = GS + (size_t)u.seg * GS_STRIDE;
        const int row0 = u.pm * BM + wr * 64 + fr, col0 = u.pn * BM + wc * 32 + 8 * fq;
#pragma unroll
        for (int ai = 0; ai < 2; ++ai) {
            u32x2 gw[4][2]; u32x4 mw[4][2];
#pragma unroll
            for (int m = 0; m < 4; ++m)
#pragma unroll
                for (int bj = 0; bj < 2; ++bj) {
                    const size_t off = (size_t)(row0 + ai * HALF + m * 16) * DM + col0 + bj * HALF;
                    gw[m][bj] = *(const u32x2*)((const unsigned char*)Gs + off);
                    mw[m][bj] = (u32x4){0u, 0u, 0u, 0u};
                    if (u.seg != 0) mw[m][bj] = *(const u32x4*)(Mo + off);
                }
            __builtin_amdgcn_sched_barrier(0);
#pragma unroll
            for (int m = 0; m < 4; ++m)
#pragma unroll
                for (int bj = 0; bj < 2; ++bj) {
                    const size_t off = (size_t)(row0 + ai * HALF + m * 16) * DM + col0 + bj * HALF;
                    const u32x2 g8 = gw[m][bj]; const u32x4 m4 = mw[m][bj]; constexpr float S8 = 1.f / 255.f;
                    f32x4 h0, h1;
                    h0[0] = (float)(g8.x & 255u) * S8 * acc[ai][bj][m][0][0] + bflo(m4.x); h0[1] = (float)((g8.x >> 8) & 255u) * S8 * acc[ai][bj][m][0][1] + bfhi(m4.x);
                    h0[2] = (float)((g8.x >> 16) & 255u) * S8 * acc[ai][bj][m][0][2] + bflo(m4.y); h0[3] = (float)(g8.x >> 24) * S8 * acc[ai][bj][m][0][3] + bfhi(m4.y);
                    h1[0] = (float)(g8.y & 255u) * S8 * acc[ai][bj][m][1][0] + bflo(m4.z); h1[1] = (float)((g8.y >> 8) & 255u) * S8 * acc[ai][bj][m][1][1] + bfhi(m4.z);
                    h1[2] = (float)((g8.y >> 16) & 255u) * S8 * acc[ai][bj][m][1][2] + bflo(m4.w); h1[3] = (float)(g8.y >> 24) * S8 * acc[ai][bj][m][1][3] + bfhi(m4.w);
                    *(u32x4*)(Mo + off) = pack8(h0, h1);
                }
            __builtin_amdgcn_sched_barrier(0);
        }
    }
};
}

struct Args { const float* in[32]; };
__device__ __forceinline__ const float* inp(const Args& a, int i) { return a.in[i + opaque_zero()]; }

__device__ __forceinline__ void cvt_block(const float* W, int N, int K, int k0, int n0, bf16_t* WT, int dst_row0, float* scr, int lane) {
    const int kq = lane >> 3, n4 = (lane & 7) * 4;
    f32x4 v[8];
#pragma unroll
    for (int i = 0; i < 8; ++i) v[i] = *(const f32x4*)(W + (size_t)(k0 + kq + 8 * i) * N + n0 + n4);
#pragma unroll
    for (int i = 0; i < 8; ++i) { float* d = scr + (kq + 8 * i) * 33 + n4; d[0] = v[i][0]; d[1] = v[i][1]; d[2] = v[i][2]; d[3] = v[i][3]; }
    LDS_WAIT();
    const int c = lane & 7;
#pragma unroll
    for (int j = 0; j < 4; ++j) { const int n = (lane >> 3) + 8 * j; const float* s = scr + (8 * c) * 33 + n;
        u32x4 o; o.x = pk2(s[0 * 33], s[1 * 33]); o.y = pk2(s[2 * 33], s[3 * 33]); o.z = pk2(s[4 * 33], s[5 * 33]); o.w = pk2(s[6 * 33], s[7 * 33]);
        *(u32x4*)(WT + (size_t)(dst_row0 + n) * K + k0 + 8 * c) = o; }
    LDS_WAIT();
}
__device__ __forceinline__ int win_dst(int n) {
    if (n < 512) return 256 * (n >> 7) + (n & 127);
    if (n < 1024) { const int s = n - 512; return 256 * (s >> 7) + 128 + (s & 127); }
    if (n < 1536) return 2048 + (n - 1024);
    if (n < 2048) { const int s = n - 1536; return 1024 + 256 * (s >> 7) + (s & 127); }
    if (n < 2560) { const int s = n - 2048; return 1024 + 256 * (s >> 7) + 128 + (s & 127); }
    if (n < 3584) { const int base = n < 3072 ? 2560 : 3072; const int s = n - base, head = s >> 6, dim = s & 63;
        return base + 256 * (head >> 2) + 128 * (dim >> 5) + 32 * (head & 3) + (dim & 31); }
    return n;
}
__device__ __forceinline__ void convert_weights(const Args& a, int l, unsigned char* lds, int gw, int ngw, int wave, int lane) {
    float* scr = (float*)(lds + wave * 8448);
    unsigned char* ws = (unsigned char*)inp(a, 31);
    constexpr int I_GU = 16 * 88, I_D = 44 * 32, I_IN = 16 * 224, I_O = 8 * 32, I_M = 16 * 32;
    constexpr int NIT = 6 * I_GU + I_IN + 3 * I_O + I_M;
    static_assert(I_GU == I_D, "");
    for (int it = gw; it < NIT; it += ngw) {
        int r = it;
        if (r < 6 * I_GU) {
            const int which = r / I_GU; r -= which * I_GU;
            const int ff = which / 3, kind = which % 3;
            if (kind < 2) {
                const float* W = inp(a, (ff ? 27 : 9) + kind) + (size_t)l * DM * DFF;
                const int kb = r / 88, nb = r % 88, n0 = nb * 32;
                cvt_block(W, DFF, DM, kb * 64, n0, (bf16_t*)(ws + (ff ? W_GU2 : W_GU1)), 256 * (n0 >> 7) + 128 * kind + (n0 & 127), scr, lane);
            } else {
                const float* W = inp(a, ff ? 29 : 11) + (size_t)l * DFF * DM;
                const int kb = r / 32, nb = r % 32;
                cvt_block(W, DM, DFF, kb * 64, nb * 32, (bf16_t*)(ws + (ff ? W_D2 : W_D1)), nb * 32, scr, lane);
            }
            continue;
        }
        r -= 6 * I_GU;
        if (r < I_IN) { const int kb = r / 224, nb = r % 224; cvt_block(inp(a, 13) + (size_t)l * DM * NIN, NIN, DM, kb * 64, nb * 32, (bf16_t*)(ws + W_IN), win_dst(nb * 32), scr, lane); continue; }
        r -= I_IN;
        if (r < 3 * I_O) { const int which = r / I_O; r -= which * I_O; const int kb = r / 32, nb = r % 32;
            const float* W = inp(a, which == 0 ? 18 : (which == 1 ? 20 : 24)) + (size_t)l * 512 * DM;
            cvt_block(W, DM, 512, kb * 64, nb * 32, (bf16_t*)(ws + (which == 0 ? W_A : (which == 1 ? W_B : W_C))), nb * 32, scr, lane); continue; }
        r -= 3 * I_O;
        { const int kb = r / 32, nb = r % 32; cvt_block(inp(a, 25) + (size_t)l * DM * DM, DM, DM, kb * 64, nb * 32, (bf16_t*)(ws + W_M), nb * 32, scr, lane); }
    }
}

__device__ __forceinline__ void compute_mods(const Args& a, unsigned char* lds, int tid, int wave, int lane) {
    float* sT = (float*)lds;
    float* red = (float*)(lds + 49152);
    const float* c = inp(a, 4); const float* cctx = inp(a, 5);
    for (int k = tid; k < DM; k += NTHR) {
        sT[k * 12 + 0] = siluf_(cctx[k]);
#pragma unroll
        for (int v = 1; v < 9; ++v) sT[k * 12 + v] = siluf_(c[(v - 1) * DM + k]);
        sT[k * 12 + 9] = 0.f; sT[k * 12 + 10] = 0.f; sT[k * 12 + 11] = 0.f;
    }
    __syncthreads();
    float* mods = (float*)((unsigned char*)inp(a, 31) + WS_MODS);
    for (int unit = blockIdx.x; unit < 288; unit += gridDim.x) {
        const int l = unit / 144, cb = unit % 144, col = cb * 64 + lane;
        const float* W = inp(a, 6) + (size_t)l * DM * MODW + col;
        float acc[9];
#pragma unroll
        for (int v = 0; v < 9; ++v) acc[v] = 0.f;
#pragma unroll 32
        for (int kk = 0; kk < 128; ++kk) {
            const int k = wave * 128 + kk;
            const float w = W[(size_t)k * MODW];
            const f32x4 s0 = *(const f32x4*)(sT + k * 12), s1 = *(const f32x4*)(sT + k * 12 + 4), s2 = *(const f32x4*)(sT + k * 12 + 8);
            acc[0] += s0[0] * w; acc[1] += s0[1] * w; acc[2] += s0[2] * w; acc[3] += s0[3] * w;
            acc[4] += s1[0] * w; acc[5] += s1[1] * w; acc[6] += s1[2] * w; acc[7] += s1[3] * w; acc[8] += s2[0] * w;
        }
#pragma unroll
        for (int v = 0; v < 9; ++v) red[(wave * 9 + v) * 64 + lane] = acc[v];
        __syncthreads();
        for (int idx = tid; idx < 576; idx += NTHR) {
            const int v = idx >> 6, ln = idx & 63; float s = inp(a, 7)[(size_t)l * MODW + cb * 64 + ln];
#pragma unroll
            for (int w = 0; w < 8; ++w) s += red[(w * 9 + v) * 64 + ln];
            mods[((size_t)l * 9 + v) * MODW + cb * 64 + ln] = s;
        }
        __syncthreads();
    }
}

__device__ __forceinline__ void adaln_phase(const float* in0, const float* in1, const float* g, const float* modl, int ish, bf16_t* U, int rb, int re, int gw, int ngw, int lane) {
    static_assert(MTOK % (2 * 256 * NWAVES) == 0, "row pairs");
    for (int row0 = rb + gw; row0 < re; row0 += 2 * ngw) {
        f32x4 x[2][4];
#pragma unroll
        for (int h = 0; h < 2; ++h) { const int row = min(row0 + h * ngw, re - 1); const float* xr = (row < NCTX ? in0 : in1) + (size_t)row * DM;
#pragma unroll
            for (int j = 0; j < 4; ++j) x[h][j] = *(const f32x4*)(xr + 256 * j + 4 * lane); }
#pragma unroll
        for (int h = 0; h < 2; ++h) {
            const int row = row0 + h * ngw; if (row >= re) break;
            const int v = row < NCTX ? 0 : 1 + ((row - NCTX) >> 12);
            const float* sh = modl + (size_t)v * MODW + ish * DM; const float* sc = sh + DM;
            float ss = 0.f;
#pragma unroll
            for (int j = 0; j < 4; ++j) ss += (x[h][j][0] * x[h][j][0] + x[h][j][1] * x[h][j][1]) + (x[h][j][2] * x[h][j][2] + x[h][j][3] * x[h][j][3]);
            const float rinv = __builtin_amdgcn_rsqf(wave_sum(ss) * (1.f / DM) + EPS);
#pragma unroll
            for (int j = 0; j < 4; ++j) {
                const int c = 256 * j + 4 * lane;
                const f32x4 gg = *(const f32x4*)(g + c), s1 = *(const f32x4*)(sc + c), s0 = *(const f32x4*)(sh + c);
                const f32x4 y = x[h][j] * rinv * gg * (s1 + 1.f) + s0;
                u32x2 w; w.x = pk2(y[0], y[1]); w.y = pk2(y[2], y[3]);
                *(u32x2*)(U + (size_t)row * DM + c) = w;
            }
        }
    }
}

namespace att {
constexpr int TK = 128, PITCH = 144, KS_OFF = 0, VS_OFF = TK * PITCH, RPB_OFF = 2 * TK * PITCH, CNT_OFF = RPB_OFF + 15 * 32 * 4, HALF_BYTES = 39936;
static_assert(CNT_OFF + 64 <= HALF_BYTES, "attention LDS map");
typedef short v4i16_t __attribute__((ext_vector_type(4)));
__device__ __forceinline__ s16x4 vtr(const LAS char* p) { return __builtin_bit_cast(s16x4, __builtin_amdgcn_ds_read_tr16_b64_v4i16((LAS v4i16_t*)p)); }

struct TileSrc { const bf16_t* k; const bf16_t* v; };

template <bool LOCAL>
__device__ __forceinline__ void tile_compute(const LAS char* ldsb, const bf16x8 (&qf)[2], f32x4 (&O)[4], float& mrun, float& lrun,
                                             int hl, int kbase, int koff, int fr, int fq, int lane, const float* rpbrow, const int (&dci)[8], unsigned vmask) {
    constexpr int NMT = LOCAL ? 2 : 4;
#define ATT_KEYOFF(mt) (kbase + (LOCAL ? koff : 0) + 16 * (mt))
    f32x4 s[NMT];
#pragma unroll
    for (int mt = 0; mt < NMT; ++mt) {
        s[mt] = (f32x4){0.f, 0.f, 0.f, 0.f};
#pragma unroll
        for (int ks = 0; ks < 2; ++ks) {
            const bf16x8 kf = *(const LAS bf16x8*)(ldsb + KS_OFF + (ATT_KEYOFF(mt) + fr) * PITCH + hl * 128 + ks * 64 + fq * 16);
            s[mt] = __builtin_amdgcn_mfma_f32_16x16x32_bf16(kf, qf[ks], s[mt], 0, 0, 0);
        }
    }
    constexpr float C1 = 0.125f * 1.4426950408889634f;
    float tmax = -1e30f;
    if (LOCAL) {
#pragma unroll
        for (int mt = 0; mt < NMT; ++mt)
#pragma unroll
            for (int j = 0; j < 4; ++j) {
                float v = __builtin_fmaf(s[mt][j], C1, rpbrow[dci[mt * 4 + j]]);
                if (!((vmask >> (mt * 4 + j)) & 1u)) v = -1e30f;
                s[mt][j] = v; tmax = fmaxf(tmax, v);
            }
    } else {
#pragma unroll
        for (int mt = 0; mt < NMT; ++mt)
#pragma unroll
            for (int j = 0; j < 4; ++j) tmax = fmaxf(tmax, s[mt][j]);
        tmax *= C1;
    }
    tmax = fmaxf(tmax, __shfl_xor(tmax, 16)); tmax = fmaxf(tmax, __shfl_xor(tmax, 32));
    const float mnew = fmaxf(mrun, tmax), alpha = __builtin_amdgcn_exp2f(mrun - mnew);
    float psum = 0.f;
#pragma unroll
    for (int mt = 0; mt < NMT; ++mt)
#pragma unroll
        for (int j = 0; j < 4; ++j) { const float p = __builtin_amdgcn_exp2f(LOCAL ? s[mt][j] - mnew : __builtin_fmaf(s[mt][j], C1, -mnew)); s[mt][j] = p; psum += p; }
    lrun = lrun * alpha + psum; mrun = mnew;
#pragma unroll
    for (int dt = 0; dt < 4; ++dt) O[dt] = O[dt] * alpha;
    const int g = lane >> 4, q = (lane & 15) >> 2, p4 = lane & 3;
#pragma unroll
    for (int kk = 0; kk < NMT / 2; ++kk) {
        bf16x8 pb;
        { const u32x4 w = pg8::pack8(s[2 * kk], s[2 * kk + 1]); pb = __builtin_bit_cast(bf16x8, w); }
#pragma unroll
        for (int dt = 0; dt < 4; ++dt) {
            const LAS char* vb = ldsb + VS_OFF + hl * 128 + 32 * dt + 8 * p4;
            const s16x4 v0 = vtr(vb + (ATT_KEYOFF(2 * kk) + 4 * g + q) * PITCH);
            const s16x4 v1 = vtr(vb + (ATT_KEYOFF(2 * kk + 1) + 4 * g + q) * PITCH);
            bf16x8 vf; vf[0] = v0[0]; vf[1] = v0[1]; vf[2] = v0[2]; vf[3] = v0[3]; vf[4] = v1[0]; vf[5] = v1[1]; vf[6] = v1[2]; vf[7] = v1[3];
            O[dt] = __builtin_amdgcn_mfma_f32_16x16x32_bf16(vf, pb, O[dt], 0, 0, 0);
        }
    }
#undef ATT_KEYOFF
}

__device__ __forceinline__ void hbar(unsigned char* hl_lds, unsigned& target, int lane) {
    asm volatile("s_waitcnt lgkmcnt(0)" ::: "memory");
    target += 4u;
    volatile LAS unsigned* cnt = (volatile LAS unsigned*)(LAS unsigned char*)(hl_lds + CNT_OFF);
    if (lane == 0) (void)__hip_atomic_fetch_add((LAS unsigned*)(LAS unsigned char*)(hl_lds + CNT_OFF), 1u, __ATOMIC_RELAXED, __HIP_MEMORY_SCOPE_WORKGROUP);
    while ((int)(*cnt - target) < 0) __builtin_amdgcn_s_sleep(0);
    asm volatile("" ::: "memory");
}

template <bool LATENT>
__device__ __forceinline__ void unit(unsigned char* hlds, unsigned& btarget, bf16_t* QO, const bf16_t* Kb, const bf16_t* Vb, const bf16_t* CK, const bf16_t* CV, const float* rpb_l,
                                     int qrow0  , int keyrow0  , int head, int r  ,
                                     int ht, int J, int lane) {
    unsigned char* lds = hlds;
    const LAS char* ldsb = (const LAS char*)(LAS unsigned char*)hlds;
    const int fr = lane & 15, fq = lane >> 4;
    const int rs = LATENT ? min(max(r - 4, 0), 56) : 0;
    constexpr int NT = LATENT ? 8 : 2;
    int dci[8]; unsigned vmask = 0u; int koff = 0;
    if (LATENT) {
        const int qc = 16 * J + fr, wstart = min(max(qc - 8, 0), 48);
        koff = min(max(16 * J - 8, 0), 32);
#pragma unroll
        for (int mt = 0; mt < 2; ++mt)
#pragma unroll
            for (int j = 0; j < 4; ++j) { const int kc = koff + 16 * mt + 4 * fq + j;
                dci[mt * 4 + j] = min(max(kc - qc, -15), 15) + 15;
                if (kc >= wstart && kc < wstart + 16) vmask |= 1u << (mt * 4 + j); }
        float* tb = (float*)(lds + RPB_OFF);
        for (int i = ht; i < 15 * 32; i += 256) { const int dr = i >> 5, dc = i & 31; tb[i] = dc < 31 ? rpb_l[(head * 15 + dr) * 31 + dc] * 1.4426950408889634f : 0.f; }
    } else {
#pragma unroll
        for (int i = 0; i < 8; ++i) dci[i] = 0;
    }
    bf16x8 qf[2];
    { const bf16_t* qp = QO + (size_t)(qrow0 + 16 * J + fr) * 512 + head * 64 + 8 * fq;
      qf[0] = *(const bf16x8*)qp; qf[1] = *(const bf16x8*)(qp + 32); }
    f32x4 O[4], OB[4];
#pragma unroll
    for (int dt = 0; dt < 4; ++dt) { O[dt] = (f32x4){0.f, 0.f, 0.f, 0.f}; OB[dt] = (f32x4){0.f, 0.f, 0.f, 0.f}; }
    float mrun = -1e30f, lrun = 0.f, mrunB = -1e30f, lrunB = 0.f;
    const int key0 = ht >> 3, part = ht & 7;
    u32x4 kA[4], vA[4], kB[4], vB[4];
    auto tsrc = [&](int t) -> TileSrc {
        TileSrc s;
        if (LATENT) {
            if (t < 4) { s.k = CK + (size_t)(t * TK) * 512 + head * 64; s.v = CV + (size_t)(t * TK) * 512 + head * 64; }
            else { const size_t ro = (size_t)(keyrow0 + (rs + 2 * (t - 4)) * 64) * 512 + head * 64; s.k = Kb + ro; s.v = Vb + ro; }
        } else { const size_t ro = (size_t)(keyrow0 + t * TK) * 512 + head * 64; s.k = Kb + ro; s.v = Vb + ro; }
        return s;
    };
#define ATT_GLOAD(KR, VR, t) do { const TileSrc s_ = tsrc(t); _Pragma("unroll") for (int i = 0; i < 4; ++i) { const size_t o = (size_t)(key0 + 32 * i) * 512 + part * 8; \
        KR[i] = *(const u32x4*)(s_.k + o); VR[i] = *(const u32x4*)(s_.v + o); } } while (0)
#define ATT_BAR() hbar(hlds, btarget, lane)
#define ATT_LSTORE(KR, VR) do { _Pragma("unroll") for (int i = 0; i < 4; ++i) { const int lo = (key0 + 32 * i) * PITCH + part * 16; \
        *(u32x4*)(lds + KS_OFF + lo) = KR[i]; *(u32x4*)(lds + VS_OFF + lo) = VR[i]; } } while (0)
#define ATT_COMPUTE(t) do { if (LATENT && (t) >= 4) { const int dr = (rs + 2 * ((t) - 4)) - r + 7; \
            const float* rpbrow = (const float*)(lds + RPB_OFF) + dr * 32; \
            tile_compute<true>(ldsb, qf, O, mrun, lrun, 0, 0, koff, fr, fq, lane, rpbrow, dci, vmask); \
            tile_compute<true>(ldsb, qf, OB, mrunB, lrunB, 0, 64, koff, fr, fq, lane, rpbrow + 32, dci, vmask); \
        } else { tile_compute<false>(ldsb, qf, O, mrun, lrun, 0, 0, 0, fr, fq, lane, nullptr, dci, 0u); \
                 tile_compute<false>(ldsb, qf, OB, mrunB, lrunB, 0, 64, 0, fr, fq, lane, nullptr, dci, 0u); } } while (0)
    ATT_GLOAD(kA, vA, 0); ATT_GLOAD(kB, vB, 1);
    for (int t = 0; t < NT; t += 2) {
        ATT_BAR();
        ATT_LSTORE(kA, vA);
        ATT_BAR();
        if (t + 2 < NT) ATT_GLOAD(kA, vA, t + 2);
        ATT_COMPUTE(t);
        ATT_BAR();
        ATT_LSTORE(kB, vB);
        ATT_BAR();
        if (t + 3 < NT) ATT_GLOAD(kB, vB, t + 3);
        ATT_COMPUTE(t + 1);
    }
#undef ATT_GLOAD
#undef ATT_BAR
#undef ATT_LSTORE
#undef ATT_COMPUTE
    { const float mm = fmaxf(mrun, mrunB), aA = __builtin_amdgcn_exp2f(mrun - mm), aB = __builtin_amdgcn_exp2f(mrunB - mm);
      lrun = lrun * aA + lrunB * aB;
#pragma unroll
      for (int dt = 0; dt < 4; ++dt) O[dt] = O[dt] * aA + OB[dt] * aB; }
    lrun += __shfl_xor(lrun, 16); lrun += __shfl_xor(lrun, 32);
    const float linv = 1.f / lrun;
    bf16_t* op = QO + (size_t)(qrow0 + 16 * J + fr) * 512 + head * 64 + 4 * fq;
#pragma unroll
    for (int dt = 0; dt < 4; ++dt) { u32x2 w; w.x = cvt_pk_bf16(O[dt][0] * linv, O[dt][1] * linv); w.y = cvt_pk_bf16(O[dt][2] * linv, O[dt][3] * linv); *(u32x2*)(op + 16 * dt) = w; }
    hbar(hlds, btarget, lane);
}
}

__device__ __forceinline__ void conva_unit(unsigned char* lds, const bf16_t* GLU, bf16_t* AOUT, const float* cw, const float* cb, const float* lg, const float* lb,
                                           int rowbase, int len, int t0, int tid, int wave, int lane) {
    bf16_t* in_s = (bf16_t*)lds;
    float* hs = (float*)(lds + 62 * 512 * 2);
    for (int idx = tid; idx < 62 * 64; idx += NTHR) {
        const int i = idx >> 6, ch = idx & 63, p = t0 - 15 + i;
        u32x4 v = (u32x4){0u, 0u, 0u, 0u};
        if (p >= 0 && p < len) v = *(const u32x4*)(GLU + (size_t)(rowbase + p) * 512 + ch * 8);
        *(u32x4*)(in_s + i * 512 + ch * 8) = v;
    }
    float w[31];
#pragma unroll
    for (int j = 0; j < 31; ++j) w[j] = cw[j * 512 + tid];
    const float bias = cb[tid];
    __syncthreads();
    float col[62];
#pragma unroll
    for (int i = 0; i < 62; ++i) col[i] = __uint_as_float((unsigned)in_s[i * 512 + tid] << 16);
#pragma unroll
    for (int tt = 0; tt < 32; ++tt) {
        float acc = bias;
#pragma unroll
        for (int j = 0; j < 31; ++j) acc += col[tt + j] * w[j];
        hs[tt * 512 + tid] = acc;
    }
    __syncthreads();
#pragma unroll
    for (int q = 0; q < 4; ++q) {
        const int tt = wave * 4 + q;
        const f32x4 a = *(const f32x4*)(hs + tt * 512 + lane * 8), b = *(const f32x4*)(hs + tt * 512 + lane * 8 + 4);
        const float mean = wave_sum((a[0] + a[1]) + (a[2] + a[3]) + (b[0] + b[1]) + (b[2] + b[3])) * (1.f / 512.f);
        const f32x4 da = a - mean, db = b - mean;
        const float var = wave_sum((da[0] * da[0] + da[1] * da[1]) + (da[2] * da[2] + da[3] * da[3]) + (db[0] * db[0] + db[1] * db[1]) + (db[2] * db[2] + db[3] * db[3])) * (1.f / 512.f);
        const float rstd = __builtin_amdgcn_rsqf(var + EPS);
        const f32x4 g0 = *(const f32x4*)(lg + lane * 8), g1 = *(const f32x4*)(lg + lane * 8 + 4), b0 = *(const f32x4*)(lb + lane * 8), b1 = *(const f32x4*)(lb + lane * 8 + 4);
        f32x4 y0 = da * rstd * g0 + b0, y1 = db * rstd * g1 + b1;
#pragma unroll
        for (int j = 0; j < 4; ++j) { y0[j] = siluf_(y0[j]); y1[j] = siluf_(y1[j]); }
        *(u32x4*)(AOUT + (size_t)(rowbase + t0 + tt) * 512 + lane * 8) = pg8::pack8(y0, y1);
    }
    __syncthreads();
}

__device__ __forceinline__ f32x4 cb_lo(u32x4 v) { return (f32x4){bflo(v.x), bfhi(v.x), bflo(v.y), bfhi(v.y)}; }
__device__ __forceinline__ f32x4 cb_hi(u32x4 v) { return (f32x4){bflo(v.z), bfhi(v.z), bflo(v.w), bfhi(v.w)}; }
__device__ __forceinline__ void convb_phase(bf16_t* BG, const bf16_t* CH, const float* w3, int gtid, int nthreads) {
    const u32x4 z = (u32x4){0u, 0u, 0u, 0u};
    for (int idx = gtid; idx < (MTOK / 2) * 64; idx += nthreads) {
        const int row = (idx >> 6) * 2, ch = idx & 63;
        int pos, len; if (row < NCTX) { pos = row & 255; len = 256; } else { pos = (row - NCTX) & 4095; len = 4096; }
        const bf16_t* cp = CH + (size_t)row * 512 + ch * 8; bf16_t* bp = BG + (size_t)row * 512 + ch * 8;
        const u32x4 c1 = *(const u32x4*)cp, c2 = *(const u32x4*)(cp + 512);
        const u32x4 c0 = pos > 0 ? *(const u32x4*)(cp - 512) : z;
        const u32x4 c3 = pos + 2 < len ? *(const u32x4*)(cp + 1024) : z;
        const u32x4 b0 = *(const u32x4*)bp, b1 = *(const u32x4*)(bp + 512);
        f32x4 wa[3], wb[3];
#pragma unroll
        for (int j = 0; j < 3; ++j) { wa[j] = *(const f32x4*)(w3 + j * 512 + ch * 8); wb[j] = *(const f32x4*)(w3 + j * 512 + ch * 8 + 4); }
        const f32x4 y0a = cb_lo(b0) * (cb_lo(c0) * wa[0] + cb_lo(c1) * wa[1] + cb_lo(c2) * wa[2]), y0b = cb_hi(b0) * (cb_hi(c0) * wb[0] + cb_hi(c1) * wb[1] + cb_hi(c2) * wb[2]);
        const f32x4 y1a = cb_lo(b1) * (cb_lo(c1) * wa[0] + cb_lo(c2) * wa[1] + cb_lo(c3) * wa[2]), y1b = cb_hi(b1) * (cb_hi(c1) * wb[0] + cb_hi(c2) * wb[1] + cb_hi(c3) * wb[2]);
        *(u32x4*)bp = pg8::pack8(y0a, y0b); *(u32x4*)(bp + 512) = pg8::pack8(y1a, y1b);
    }
}

#define XB_TMO      128
#define XB_XCNT(j)  (256  + 64 * (j))
#define XB_XSUB(j)  (1280 + 64 * (j))
#define XB_XGEN(j)  (2304 + 64 * (j))
#define XB_TOP      3328
#define XB_TOPGEN   3392
#define XCD_BAR_WORDS 3456
#define XB_SPIN_CAP (1u << 18)

__device__ __forceinline__ unsigned xb_ld(unsigned* p)              { return __hip_atomic_load(p, __ATOMIC_RELAXED, __HIP_MEMORY_SCOPE_AGENT); }
__device__ __forceinline__ unsigned xb_add(unsigned* p, unsigned v) { return __hip_atomic_fetch_add(p, v, __ATOMIC_RELAXED, __HIP_MEMORY_SCOPE_AGENT); }
__device__ __forceinline__ unsigned xb_xcc_id() { return (unsigned)__builtin_amdgcn_s_getreg((3 << 11) | 20) & 0xFu; }
#define XB_SPIN(cond, bar) do { unsigned _sp = 0; while (cond) { __builtin_amdgcn_s_sleep(1); \
    if ((++_sp & 255u) == 0u) { if (xb_ld(&(bar)[XB_TMO])) break; if (_sp > XB_SPIN_CAP) { atomicAdd(&(bar)[XB_TMO], 1u); break; } } } } while (0)

struct XcdBarrier {
    unsigned* bar; unsigned x;
    volatile LAS unsigned* st;
};

__device__ __forceinline__ XcdBarrier xcd_barrier_post(unsigned* bar, volatile LAS unsigned* st) {
    XcdBarrier b; b.bar = bar; b.x = xb_xcc_id(); b.st = st;
    if (threadIdx.x == 0) (void)xb_add(&bar[XB_XCNT(b.x)], 1u);
    return b;
}
__device__ __forceinline__ void xcd_barrier_complete(unsigned* bar, unsigned x, unsigned& nloc, unsigned& nx) {
    const unsigned G = gridDim.x * gridDim.y * gridDim.z;
    unsigned sum, cnt, mine, sp = 0u;
    for (;;) {
        sum = 0u; cnt = 0u; mine = 0u;
#pragma unroll
        for (unsigned j = 0; j < 16; ++j) { const unsigned c = xb_ld(&bar[XB_XCNT(j)]); sum += c; cnt += (c > 0u) ? 1u : 0u; mine = (j == x) ? c : mine; }
        if (sum == G) break;
        __builtin_amdgcn_s_sleep(1);
        if ((++sp & 255u) == 0u) { if (xb_ld(&bar[XB_TMO])) break; if (sp > XB_SPIN_CAP) { atomicAdd(&bar[XB_TMO], 1u); break; } }
    }
    nloc = mine > 0u ? mine : 1u; nx = cnt > 0u ? cnt : 1u;
}

__device__ __forceinline__ void xcd_barrier(const XcdBarrier& b) {
    asm volatile("s_waitcnt vmcnt(0)" ::: "memory");
    __syncthreads();
    if (threadIdx.x == 0) {
        unsigned* bar = b.bar;
        __builtin_amdgcn_s_waitcnt(0);
        unsigned nloc = b.st[0], nx = b.st[1];
        if (nloc == 0u) { xcd_barrier_complete(bar, b.x, nloc, nx); b.st[0] = nloc; b.st[1] = nx; }
        const unsigned old = xb_add(&bar[XB_XSUB(b.x)], 1u);
        const unsigned gen = old / nloc;
        if (old + 1u == (gen + 1u) * nloc) {
            __builtin_amdgcn_fence(__ATOMIC_RELEASE, "agent");
            asm volatile("s_waitcnt vmcnt(0)" ::: "memory");
            const unsigned og = xb_add(&bar[XB_TOP], 1u);
            const unsigned tg = og / nx;
            if (og + 1u == (tg + 1u) * nx) xb_add(&bar[XB_TOPGEN], 1u);
            else XB_SPIN(xb_ld(&bar[XB_TOPGEN]) == tg, bar);
            __builtin_amdgcn_fence(__ATOMIC_ACQUIRE, "agent");
            xb_add(&bar[XB_XGEN(b.x)], 1u);
            asm volatile("s_waitcnt vmcnt(0)" ::: "memory");
        } else {
            XB_SPIN(xb_ld(&bar[XB_XGEN(b.x)]) == gen, bar);
            __builtin_amdgcn_fence(__ATOMIC_ACQUIRE, "agent");
            asm volatile("s_waitcnt vmcnt(0)" ::: "memory");
        }
    }
    __syncthreads();
}


constexpr int EARLY_ROWS = 128 * 256;
__device__ __forceinline__ bool tail_ok(int G) { return ((MTOK / 256 * 4) % G) * 2 == G && ((G / 2) % 4) == 0 && (MTOK / 256 - (G / 2) / 4) * 256 == EARLY_ROWS; }
__device__ __forceinline__ void handoff_signal(unsigned* ctr) {
    asm volatile("s_waitcnt vmcnt(0)" ::: "memory"); __syncthreads();
    if (threadIdx.x == 0) { __builtin_amdgcn_fence(__ATOMIC_RELEASE, "agent"); asm volatile("s_waitcnt vmcnt(0)" ::: "memory");
        (void)__hip_atomic_fetch_add(ctr, 1u, __ATOMIC_RELAXED, __HIP_MEMORY_SCOPE_AGENT); }
}
__device__ __forceinline__ void handoff_wait(unsigned* ctr, unsigned want) {
    if (threadIdx.x == 0) { unsigned sp = 0;
        while (__hip_atomic_load(ctr, __ATOMIC_RELAXED, __HIP_MEMORY_SCOPE_AGENT) < want && ++sp < (1u << 22)) __builtin_amdgcn_s_sleep(8);
        __builtin_amdgcn_fence(__ATOMIC_ACQUIRE, "agent"); asm volatile("s_waitcnt vmcnt(0)" ::: "memory"); }
    __syncthreads();
}

#ifndef PHASE_MASK
#define PHASE_MASK 0xFFFFF
#endif
#define PH_ON(n) ((PHASE_MASK >> (n)) & 1)
#ifndef LAST_PHASE
#define LAST_PHASE 99
#endif
#define PHX(n) if (l * 12 + (n) <= LAST_PHASE)

__global__ void __launch_bounds__(NTHR, 2) fwd_megakernel(Args a) {
    extern __shared__ __attribute__((aligned(16))) unsigned char lds[];
    cg::grid_group grid = cg::this_grid();
    const int G = gridDim.x, bx = blockIdx.x;
    PG8_LAS unsigned char* ldsg = (PG8_LAS unsigned char*)lds;
    grid.sync();
    volatile LAS unsigned* bst = (volatile LAS unsigned*)((LAS unsigned char*)lds + LDS_BYTES - 64);
    if (threadIdx.x < 16) bst[threadIdx.x] = 0u;
    __syncthreads();
    (void)xcd_barrier_post((unsigned*)inp(a, 31), bst);
#define GSYNC() do { XcdBarrier b_; b_.bar = (unsigned*)inp(a, 31); b_.x = xb_xcc_id(); b_.st = (volatile LAS unsigned*)((LAS unsigned char*)lds + LDS_BYTES - 64); xcd_barrier(b_); } while (0)
#define TIDS const int tid = threadIdx.x + opaque_vzero(), lane = tid & 63, wave = __builtin_amdgcn_readfirstlane(tid >> 6); \
             const int gw = bx * NWAVES + wave, ngw = G * NWAVES, gtid = bx * NTHR + tid, nthreads = G * NTHR; (void)gw; (void)ngw; (void)gtid; (void)nthreads; (void)lane;
#define BASES const int z_ = opaque_zero(); unsigned char* ws = (unsigned char*)inp(a, 31); float* out = (float*)inp(a, 30); const int lp = l + z_; const int bxp = bx + z_, Gp = G + z_; (void)bxp; (void)Gp; \
              const float* modl = (const float*)(ws + WS_MODS) + (size_t)lp * 9 * MODW; (void)modl; (void)out;

    {
        TIDS
#if PH_ON(0)
        compute_mods(a, lds, tid, wave, lane);
#endif
        unsigned char* ws = (unsigned char*)inp(a, 31);
        bf16_t* CK = (bf16_t*)(ws + WS_CK); bf16_t* CV = (bf16_t*)(ws + WS_CV);
        for (int i = gtid; i < 2 * 524288; i += nthreads) {
            const int which = i >= 524288; const int j = which ? i - 524288 : i;
            const float* src = inp(a, which ? 3 : 2) + (size_t)j * 8; bf16_t* dst = (which ? CV : CK) + (size_t)j * 8;
            const f32x4 x0 = *(const f32x4*)src, x1 = *(const f32x4*)(src + 4);
            u32x4 w; w.x = pk2(x0[0], x0[1]); w.y = pk2(x0[2], x0[3]); w.z = pk2(x1[0], x1[1]); w.w = pk2(x1[2], x1[3]);
            *(u32x4*)dst = w;
        }
    }
    GSYNC();

    for (int l = 0; l < 2; ++l) {
        PHX(1) {
            TIDS BASES
#if PH_ON(1)
            convert_weights(a, lp, lds, gw, ngw, wave, lane);
#endif
#if PH_ON(2)
            const float* xin0 = lp == 0 ? inp(a, 0) : out;
            const float* xin1 = lp == 0 ? inp(a, 1) - (size_t)NCTX * DM : out;
            adaln_phase(xin0, xin1, inp(a, 8) + lp * DM, modl, 0, (bf16_t*)(ws + WS_U), (lp != 0 && tail_ok(Gp)) ? EARLY_ROWS : 0, MTOK, gw, ngw, lane);
#endif
        }
        GSYNC();
#if PH_ON(3)
        PHX(2) { BASES
          pg8::Gemm g{(const bf16_t*)(ws + WS_U), (const bf16_t*)(ws + W_GU1), 0, 0, MTOK, 2 * DFF, DM}; pg8::Order S; S.init(MTOK, 2 * DFF, Gp, bxp, 1);
          pg8::EpiSwiGLU E{(bf16_t*)(ws + WS_H)}; pg8::gemm_phase<pg8::EpiSwiGLU, true, true>(ldsg, g, S, E); }
#endif
        GSYNC();
#if PH_ON(4)
        PHX(3) { BASES
          const float* xin0 = lp == 0 ? inp(a, 0) : out;
          const float* xin1 = lp == 0 ? inp(a, 1) - (size_t)NCTX * DM : out;
          pg8::Gemm g{(const bf16_t*)(ws + WS_H), (const bf16_t*)(ws + W_D1), 0, 0, MTOK, DM, DFF}; pg8::Order S; S.init(MTOK, DM, Gp, bxp, 1);
          pg8::EpiResid E{xin0, xin1, out, modl + 2 * DM, 0.5f};
          unsigned* hctr = (unsigned*)ws + 3600 + 64 * (lp * 2);
#pragma nounroll
          for (int pass = 0; pass < 2; ++pass) {
              S.window(pass * 2, pass ? (1 << 30) : 2, 1);
              pg8::gemm_phase<pg8::EpiResid, true, true>(ldsg, g, S, E);
              if (pass == 0) handoff_signal(hctr);
          }
          if (S.tail && bxp >= Gp / 2) {
              TIDS
              handoff_wait(hctr, (unsigned)Gp);
              adaln_phase(out, out, inp(a, 12) + lp * DM, modl, 3, (bf16_t*)(ws + WS_U), 0, EARLY_ROWS, (bxp - Gp / 2) * NWAVES + wave, (Gp / 2) * NWAVES, lane);
          } }
#endif
        GSYNC();
#if PH_ON(14)
        PHX(4) { TIDS BASES
          adaln_phase(out, out, inp(a, 12) + lp * DM, modl, 3, (bf16_t*)(ws + WS_U), tail_ok(Gp) ? EARLY_ROWS : 0, MTOK, gw, ngw, lane); }
#endif
        GSYNC();
#if PH_ON(5)
        PHX(5) { BASES
          float* newk = out + (size_t)MTOK * DM; float* newv = newk + (size_t)32 * 2 * 256 * 512;
          pg8::Gemm g{(const bf16_t*)(ws + WS_U), (const bf16_t*)(ws + W_IN), 0, 0, MTOK, 4096, DM}; pg8::Order S; S.init(MTOK, 4096, Gp, bxp, 1);
          pg8::EpiWin E{(bf16_t*)(ws + WS_GLU), (bf16_t*)(ws + WS_CH), (bf16_t*)(ws + WS_BG), (bf16_t*)(ws + WS_Q), (bf16_t*)(ws + WS_K), (bf16_t*)(ws + WS_V),
                        inp(a, 21) + lp * 64, inp(a, 22) + lp * 64, newk, newv, lp};
          pg8::gemm_phase<pg8::EpiWin, true, true>(ldsg, g, S, E); }
#endif
        GSYNC();
        PHX(6) {
            TIDS BASES
            bf16_t* Q = (bf16_t*)(ws + WS_Q); const bf16_t* Kb = (const bf16_t*)(ws + WS_K); const bf16_t* Vb = (const bf16_t*)(ws + WS_V);
#if PH_ON(11)
            {
            const bf16_t* CK = (const bf16_t*)(ws + WS_CK); const bf16_t* CV = (const bf16_t*)(ws + WS_CV);
            const float* rpb_l = inp(a, 23) + (size_t)lp * 8 * 15 * 31;
            {
                const int half = wave >> 2, ht = tid & 255, J = wave & 3;
                unsigned char* hlds = lds + half * att::HALF_BYTES;
                if (ht == 0) *(volatile LAS unsigned*)(LAS unsigned char*)(hlds + att::CNT_OFF) = 0u;
                __syncthreads();
                unsigned btarget = 0u;
                const int hw = bxp * 2 + half, nhw = Gp * 2;
                if (Gp == 256) {
                    const int xcd = bxp & 7, w = (bxp >> 3) * 2 + half;
                    for (int j = 0; j < 8; ++j) {
                        const int idx = w + 64 * j, b = xcd, head = idx >> 6, r = idx & 63;
                        const size_t co = (size_t)((b * 2 + lp) * 512) * 512;
                        att::unit<true>(hlds, btarget, Q, Kb, Vb, CK + co, CV + co, rpb_l, NCTX + b * 4096 + r * 64, NCTX + b * 4096, head, r, ht, J, lane);
                    }
                    for (int j = 0; j < 2; ++j) {
                        const int idx = w + 64 * j, b = xcd * 4 + (idx >> 5), head = (idx >> 2) & 7, qb = idx & 3;
                        att::unit<false>(hlds, btarget, Q, Kb, Vb, nullptr, nullptr, nullptr, b * 256 + qb * 64, b * 256, head, 0, ht, J, lane);
                    }
                } else {
                for (int u = hw; u < 4096; u += nhw) {
                    const int b = u >> 9, head = (u >> 6) & 7, r = u & 63;
                    const size_t co = (size_t)((b * 2 + lp) * 512) * 512;
                    att::unit<true>(hlds, btarget, Q, Kb, Vb, CK + co, CV + co, rpb_l, NCTX + b * 4096 + r * 64, NCTX + b * 4096, head, r, ht, J, lane);
                }
                for (int u = hw; u < 1024; u += nhw) {
                    const int b = u >> 5, head = (u >> 2) & 7, qb = u & 3;
                    att::unit<false>(hlds, btarget, Q, Kb, Vb, nullptr, nullptr, nullptr, b * 256 + qb * 64, b * 256, head, 0, ht, J, lane);
                }
                }
                __syncthreads();
            }
            }
#endif
#if PH_ON(12)
            {
            const float* cw = inp(a, 14) + (size_t)lp * 31 * 512; const float* cb = inp(a, 15) + lp * 512; const float* lg = inp(a, 16) + lp * 512; const float* lb = inp(a, 17) + lp * 512;
            for (int u = bxp; u < 1280; u += Gp) {
                int rowbase, len, t0;
                if (u < 256) { rowbase = (u >> 3) * 256; len = 256; t0 = (u & 7) * 32; }
                else { const int v = u - 256; rowbase = NCTX + (v >> 7) * 4096; len = 4096; t0 = (v & 127) * 32; }
                conva_unit(lds, (const bf16_t*)(ws + WS_GLU), (bf16_t*)(ws + WS_AOUT), cw, cb, lg, lb, rowbase, len, t0, tid, wave, lane);
            }
            }
#endif
#if PH_ON(13)
            convb_phase((bf16_t*)(ws + WS_BG), (const bf16_t*)(ws + WS_CH), inp(a, 19) + (size_t)lp * 3 * 512, gtid, nthreads);
#endif
        }
        GSYNC();
#if PH_ON(6)
        PHX(7) { BASES
          const bf16_t* Wg = (const bf16_t*)(ws + W_IN) + (size_t)4096 * DM;
          pg8::Gemm g{(const bf16_t*)(ws + WS_U), Wg, 0, 0, MTOK, 3072, DM}; pg8::Order S; S.init(MTOK, 3072, Gp, bxp, 1);
          pg8::EpiGates E{(bf16_t*)(ws + WS_GS)}; pg8::gemm_phase<pg8::EpiGates, true, true>(ldsg, g, S, E); }
#endif
        GSYNC();
#if PH_ON(7)
        PHX(8) { BASES
          pg8::Gemm g{(const bf16_t*)(ws + WS_BG), (const bf16_t*)(ws + W_B), BR_STRIDE, WO_STRIDE, MTOK, DM, 512}; pg8::Order S; S.init(MTOK, DM, Gp, bxp, 3);
          pg8::EpiM E{(const bf16_t*)(ws + WS_GS), (bf16_t*)(ws + WS_U)}; pg8::gemm_phase<pg8::EpiM, true, true>(ldsg, g, S, E); }
#endif
        GSYNC();
#if PH_ON(8)
        PHX(9) { BASES
          pg8::Gemm g{(const bf16_t*)(ws + WS_U), (const bf16_t*)(ws + W_M), 0, 0, MTOK, DM, DM}; pg8::Order S; S.init(MTOK, DM, Gp, bxp, 1);
          pg8::EpiResid E{out, out, out, modl + 5 * DM, 1.0f}; pg8::gemm_phase<pg8::EpiResid, true, true>(ldsg, g, S, E); }
#endif
        GSYNC();
#if PH_ON(14)
        PHX(10) { TIDS BASES
          adaln_phase(out, out, inp(a, 26) + lp * DM, modl, 6, (bf16_t*)(ws + WS_U), 0, MTOK, gw, ngw, lane); }
#endif
        GSYNC();
#if PH_ON(9)
        PHX(11) { BASES
          pg8::Gemm g{(const bf16_t*)(ws + WS_U), (const bf16_t*)(ws + W_GU2), 0, 0, MTOK, 2 * DFF, DM}; pg8::Order S; S.init(MTOK, 2 * DFF, Gp, bxp, 1);
          pg8::EpiSwiGLU E{(bf16_t*)(ws + WS_H)}; pg8::gemm_phase<pg8::EpiSwiGLU, true, true>(ldsg, g, S, E); }
#endif
        GSYNC();
#if PH_ON(10)
        PHX(12) { BASES
          pg8::Gemm g{(const bf16_t*)(ws + WS_H), (const bf16_t*)(ws + W_D2), 0, 0, MTOK, DM, DFF}; pg8::Order S; S.init(MTOK, DM, Gp, bxp, 1);
          pg8::EpiResid E{out, out, out, modl + 8 * DM, 0.5f};
          unsigned* hctr = (unsigned*)ws + 3600 + 64 * (lp * 2 + 1);
          const int npass = lp == 0 ? 2 : 1;
#pragma nounroll
          for (int pass = 0; pass < npass; ++pass) {
              S.window(pass * 2, (npass == 2 && pass == 0) ? 2 : (1 << 30), npass == 2);
              pg8::gemm_phase<pg8::EpiResid, true, true>(ldsg, g, S, E);
              if (npass == 2 && pass == 0) handoff_signal(hctr);
          }
          if (npass == 2 && S.tail && bxp >= Gp / 2) {
              TIDS
              handoff_wait(hctr, (unsigned)Gp);
              adaln_phase(out, out, inp(a, 8) + (lp + 1) * DM, modl + 9 * MODW, 0, (bf16_t*)(ws + WS_U), 0, EARLY_ROWS, (bxp - Gp / 2) * NWAVES + wave, (Gp / 2) * NWAVES, lane);
          } }
#endif
        if (l == 0) GSYNC();
    }
}

extern "C" void kernel_launch(void* const* d_in, const int* in_sizes, int n_in, void* d_out, int out_size, void* d_ws, size_t ws_size, hipStream_t stream) {
    static int grid = 0;
    if (grid == 0) {
        if (n_in != 30 || ws_size < WS_END) { fprintf(stderr, "kernel_launch: unexpected inputs (n_in %d, ws %zu)\n", n_in, ws_size); grid = -1; return; }
        int dev = 0, cus = 0, per_cu = 0;
        hipGetDevice(&dev);
        hipDeviceGetAttribute(&cus, hipDeviceAttributeMultiprocessorCount, dev);
        hipFuncSetAttribute((const void*)fwd_megakernel, hipFuncAttributeMaxDynamicSharedMemorySize, LDS_BYTES);
        hipOccupancyMaxActiveBlocksPerMultiprocessor(&per_cu, (const void*)fwd_megakernel, NTHR, LDS_BYTES);
        if (per_cu < 1) per_cu = 1;
        (void)hipGetLastError();
        grid = cus;
        if (grid > 256) grid = 256;
    }
    if (grid < 0) return;
    Args a{};
    for (int i = 0; i < 30; ++i) a.in[i] = (const float*)d_in[i];
    a.in[30] = (const float*)d_out; a.in[31] = (const float*)d_ws;
    (void)hipMemsetAsync(d_ws, 0, 16384, stream);
    void* args[] = {&a};
    hipError_t e = hipLaunchCooperativeKernel((const void*)fwd_megakernel, dim3(grid), dim3(NTHR), args, LDS_BYTES, stream);
    if (e != hipSuccess) fprintf(stderr, "cooperative launch failed: %s (grid %d)\n", hipGetErrorString(e), grid);
}
```
